# Optimizing an MI355X kernel written in HIP

```python
import math
import jax, jax.numpy as jnp
from jax import lax
import numpy as np

D_MODEL = 1024
BATCH = 32
SEQ = 2048
DEPTH = 1

POOL_WINDOWS = (2, 4, 8, 16)
N_POOL_GROUPS = len(POOL_WINDOWS)
POOL_WIDTH = D_MODEL // 2
POOL_GROUP = POOL_WIDTH // N_POOL_GROUPS
N_HEADS = 4
HEAD_DIM = D_MODEL // 16
V_HEAD_DIM = 2 * HEAD_DIM
QK_WIDTH = N_HEADS * 2 * HEAD_DIM
ATTN_WIDTH = N_HEADS * V_HEAD_DIM
Q_BLOCK = 128
OFF_POOL = 0
OFF_Q = OFF_POOL + POOL_WIDTH
OFF_K = OFF_Q + QK_WIDTH
OFF_V = OFF_K + QK_WIDTH
OFF_GP = OFF_V + ATTN_WIDTH
OFF_GA = OFF_GP + D_MODEL
IN_WIDTH = OFF_GA + D_MODEL
N_GROUPS = 4
EXPERTS_PER_GROUP = 8
N_EXPERTS = N_GROUPS * EXPERTS_PER_GROUP
TOP_K = 2
D_EXPERT = D_MODEL // 2
ROW_BLOCK = 512
EPS = 1e-6

kernel_name = "hybrid_pool_diffattn_hmoe_block"


def rmsnorm(x, g):
    xf = x.astype(jnp.float32)
    y = xf * lax.rsqrt(jnp.mean(xf * xf, axis=-1, keepdims=True) + EPS)
    return (y * g.astype(jnp.float32)).astype(x.dtype)


def lambda_init(layer):
    return 0.8 - 0.6 * math.exp(-0.3 * layer)


def alibi_slopes():
    return jnp.asarray([2.0 ** (-8.0 * (h + 1) / N_HEADS) for h in range(N_HEADS)], jnp.float32)


def pool_mixer(u, w_grp, scale):
    B, S, C = u.shape
    uf = u.astype(jnp.float32)
    c0 = jnp.concatenate([jnp.zeros((B, 1, C), jnp.float32), jnp.cumsum(uf, axis=1)], axis=1)
    t = jnp.arange(S)
    outs = []
    for g, w in enumerate(POOL_WINDOWS):
        sl = slice(g * POOL_GROUP, (g + 1) * POOL_GROUP)
        cg = c0[:, :, sl]
        upper = cg[:, 1:]
        lower = jnp.pad(cg[:, :S + 1 - w], ((0, 0), (w - 1, 0), (0, 0)))
        cnt = jnp.minimum(t + 1, w).astype(jnp.float32)[None, :, None]
        outs.append((upper - lower) / cnt - uf[:, :, sl])
    d = jnp.stack(outs, axis=2).astype(u.dtype)
    y = jnp.einsum('bsgc,gcd->bsgd', d, w_grp).reshape(B, S, POOL_WIDTH)
    return y * scale


def diff_attention(q, k, v, q_g, k_g, lam, subln_g, lam_init):
    B, S = q.shape[0], q.shape[1]
    qf = rmsnorm(q.astype(jnp.float32), q_g) * (HEAD_DIM ** -0.5)
    kf = rmsnorm(k.astype(jnp.float32), k_g)
    slopes = alibi_slopes()
    nb = S // Q_BLOCK
    kpos = jnp.arange(S)
    qb = qf.reshape(B, nb, Q_BLOCK, N_HEADS, 2, HEAD_DIM).transpose(1, 0, 2, 3, 4, 5)

    def block(args):
        qblk, i = args
        qpos = i * Q_BLOCK + jnp.arange(Q_BLOCK)
        dist = (qpos[:, None] - kpos[None, :]).astype(jnp.float32)
        bias = jnp.where(dist[None] >= 0, -slopes[:, None, None] * dist[None], -jnp.inf)
        s = jnp.einsum('bqhmd,bkhmd->bhmqk', qblk, kf) + bias[None, :, None]
        p = jax.nn.softmax(s, axis=-1)
        a = p[:, :, 0] - lam * p[:, :, 1]
        return jnp.einsum('bhqk,bkhe->bqhe', a.astype(v.dtype), v)

    o = lax.map(block, (qb, jnp.arange(nb)))
    o = o.transpose(1, 0, 2, 3, 4).reshape(B, S, N_HEADS, V_HEAD_DIM)
    o = rmsnorm(o, subln_g) * (1.0 - lam_init)
    return o.reshape(B, S, ATTN_WIDTH)


def hier_moe(hn, w_rg, b_rg, w_re, b_re, w_gate, w_up, w_down):
    N, D = hn.shape
    pg = jax.nn.softmax((hn @ w_rg).astype(jnp.float32) + b_rg.astype(jnp.float32), axis=-1)
    p_top, g_idx = lax.top_k(pg, 1)
    le = ((hn @ w_re).astype(jnp.float32) + b_re.astype(jnp.float32)).reshape(N, N_GROUPS, EXPERTS_PER_GROUP)
    le_sel = jnp.take_along_axis(le, g_idx[:, :, None], axis=1)[:, 0]
    pe = jax.nn.softmax(le_sel, axis=-1)
    pv, e_idx = lax.top_k(pe, TOP_K)
    wts = p_top * pv / jnp.sum(pv, axis=-1, keepdims=True)
    eid = (g_idx * EXPERTS_PER_GROUP + e_idx).reshape(-1)
    tok = jnp.repeat(jnp.arange(N, dtype=jnp.int32), TOP_K)
    wflat = wts.reshape(-1)
    M = N * TOP_K
    order = jnp.argsort(eid)
    s_eid, s_tok, s_w = eid[order], tok[order], wflat[order]
    counts = jnp.bincount(eid, length=N_EXPERTS)
    padded = (counts + ROW_BLOCK - 1) // ROW_BLOCK * ROW_BLOCK
    pend = jnp.cumsum(padded)
    pstart = pend - padded
    start = jnp.cumsum(counts) - counts
    dest = pstart[s_eid] + jnp.arange(M) - start[s_eid]
    n_blocks = -(-M // ROW_BLOCK) + N_EXPERTS
    P = n_blocks * ROW_BLOCK
    slot_tok = jnp.zeros((P,), jnp.int32).at[dest].set(s_tok)
    slot_w = jnp.zeros((P,), jnp.float32).at[dest].set(s_w)
    block_eid = jnp.minimum(jnp.searchsorted(pend, jnp.arange(n_blocks) * ROW_BLOCK, side='right'), N_EXPERTS - 1)

    def expert_block(args):
        toks, wb, e = args
        xb = hn[toks]
        hdn = jax.nn.silu(xb @ w_gate[e]) * (xb @ w_up[e])
        return (hdn @ w_down[e]) * wb[:, None].astype(hn.dtype)

    yb = lax.map(expert_block, (slot_tok.reshape(n_blocks, ROW_BLOCK), slot_w.reshape(n_blocks, ROW_BLOCK), block_eid))
    return jnp.zeros((N, D), hn.dtype).at[slot_tok].add(yb.reshape(P, D))


def setup_inputs(seed: int = 0) -> dict:
    key = jax.random.key(seed)
    ks = jax.random.split(key, 24)
    f32 = jnp.float32
    nrm = lambda k, shape, fan: jax.random.normal(k, shape, f32) * (fan ** -0.5)
    gain = lambda k, shape: 1.0 + 0.02 * jax.random.normal(k, shape, f32)
    L = DEPTH
    return {
        "x": jax.random.normal(ks[0], (BATCH, SEQ, D_MODEL), f32),
        "norm1_g": gain(ks[1], (L, D_MODEL)),
        "w_in": nrm(ks[2], (L, D_MODEL, IN_WIDTH), D_MODEL),
        "pool_w": nrm(ks[3], (L, N_POOL_GROUPS, POOL_GROUP, POOL_GROUP), POOL_GROUP),
        "pool_scale": gain(ks[4], (L, POOL_WIDTH)),
        "w_pool_up": nrm(ks[5], (L, POOL_WIDTH, D_MODEL), POOL_WIDTH),
        "q_norm_g": gain(ks[6], (L, HEAD_DIM)),
        "k_norm_g": gain(ks[7], (L, HEAD_DIM)),
        "lambda_q1": 0.1 * jax.random.normal(ks[8], (L, HEAD_DIM), f32),
        "lambda_k1": 0.1 * jax.random.normal(ks[9], (L, HEAD_DIM), f32),
        "lambda_q2": 0.1 * jax.random.normal(ks[10], (L, HEAD_DIM), f32),
        "lambda_k2": 0.1 * jax.random.normal(ks[11], (L, HEAD_DIM), f32),
        "subln_g": gain(ks[12], (L, V_HEAD_DIM)),
        "w_attn_up": nrm(ks[13], (L, ATTN_WIDTH, D_MODEL), ATTN_WIDTH),
        "w_out": nrm(ks[14], (L, D_MODEL, D_MODEL), D_MODEL),
        "norm2_g": gain(ks[15], (L, D_MODEL)),
        "w_router_group": nrm(ks[16], (L, D_MODEL, N_GROUPS), D_MODEL),
        "b_router_group": 0.01 * jax.random.normal(ks[17], (L, N_GROUPS), f32),
        "w_router_expert": nrm(ks[18], (L, D_MODEL, N_EXPERTS), D_MODEL),
        "b_router_expert": 0.01 * jax.random.normal(ks[19], (L, N_EXPERTS), f32),
        "w_expert_gate": nrm(ks[20], (L, N_EXPERTS, D_MODEL, D_EXPERT), D_MODEL),
        "w_expert_up": nrm(ks[21], (L, N_EXPERTS, D_MODEL, D_EXPERT), D_MODEL),
        "w_expert_down": nrm(ks[22], (L, N_EXPERTS, D_EXPERT, D_MODEL), D_EXPERT),
    }


def reference(x, norm1_g, w_in, pool_w, pool_scale, w_pool_up, q_norm_g, k_norm_g, lambda_q1, lambda_k1,
              lambda_q2, lambda_k2, subln_g, w_attn_up, w_out, norm2_g, w_router_group, b_router_group,
              w_router_expert, b_router_expert, w_expert_gate, w_expert_up, w_expert_down):
    B, S, D = x.shape
    for l in range(DEPTH):
        lam_init = lambda_init(l)
        h = rmsnorm(x, norm1_g[l])
        proj = h @ w_in[l]
        u = proj[..., OFF_POOL:OFF_Q]
        q = proj[..., OFF_Q:OFF_K].reshape(B, S, N_HEADS, 2, HEAD_DIM)
        k = proj[..., OFF_K:OFF_V].reshape(B, S, N_HEADS, 2, HEAD_DIM)
        v = proj[..., OFF_V:OFF_GP].reshape(B, S, N_HEADS, V_HEAD_DIM)
        gate_p = jax.nn.sigmoid(proj[..., OFF_GP:OFF_GA])
        gate_a = jax.nn.sigmoid(proj[..., OFF_GA:IN_WIDTH])
        pool_out = pool_mixer(u, pool_w[l], pool_scale[l]) @ w_pool_up[l]
        lam = (jnp.exp(jnp.sum(lambda_q1[l].astype(jnp.float32) * lambda_k1[l].astype(jnp.float32)))
               - jnp.exp(jnp.sum(lambda_q2[l].astype(jnp.float32) * lambda_k2[l].astype(jnp.float32))) + lam_init)
        attn_out = diff_attention(q, k, v, q_norm_g[l], k_norm_g[l], lam, subln_g[l], lam_init) @ w_attn_up[l]
        x = x + (gate_p * pool_out + gate_a * attn_out) @ w_out[l]
        hn = rmsnorm(x, norm2_g[l]).reshape(B * S, D)
        x = x + hier_moe(hn, w_router_group[l], b_router_group[l], w_router_expert[l], b_router_expert[l],
                         w_expert_gate[l], w_expert_up[l], w_expert_down[l]).reshape(B, S, D)
    return x
```

```cpp
#include <hip/hip_runtime.h>
#include <hip/hip_bf16.h>
#include <cstdio>
#include <cstdint>

#define LAS __attribute__((address_space(3)))
#define GAS __attribute__((address_space(1)))
typedef unsigned short bf16_t;
typedef short bf16x8 __attribute__((ext_vector_type(8)));
typedef short s16x4 __attribute__((ext_vector_type(4)));
typedef float f32x2 __attribute__((ext_vector_type(2)));
typedef float f32x4 __attribute__((ext_vector_type(4)));
typedef float f32x16 __attribute__((ext_vector_type(16)));
typedef unsigned u32x4 __attribute__((ext_vector_type(4)));
typedef unsigned u32x2 __attribute__((ext_vector_type(2)));
typedef GAS unsigned gu32;
#define RLX_AGENT __ATOMIC_RELAXED, __HIP_MEMORY_SCOPE_AGENT
#define LDS_WAIT() asm volatile("s_waitcnt lgkmcnt(0)" ::: "memory")
#define VM_WAIT() asm volatile("s_waitcnt vmcnt(0)" ::: "memory")

#ifndef PHASE_MASK
#define PHASE_MASK 0x1ff
#endif

constexpr int NTOK = 65536, DM = 1024, SEQ = 2048;
constexpr float LOG2E = 1.4426950408889634f;
constexpr float EPS = 1e-6f;
constexpr int NCLS = 112, MAXT = 368;
constexpr int NWAVES = 8;

constexpr size_t MiB = 1u << 20;
constexpr size_t WS_CTL = 0, CTL_ZERO_BYTES = 1 * MiB;
constexpr size_t WS_RSTD = 1 * MiB, WS_TCLS = WS_RSTD + 256 * 1024, WS_TWLO = WS_TCLS + 256 * 1024, WS_TWHI = WS_TWLO + 256 * 1024;
constexpr size_t WS_STOK = 2 * MiB, WS_SWLO = WS_STOK + 512 * 1024, WS_SWHI = WS_SWLO + 512 * 1024, WS_SRSTD = WS_SWHI + 512 * 1024;
constexpr size_t WS_TILECLS = 4 * MiB;
constexpr size_t WS_WRH = 5 * MiB, WS_WRL = WS_WRH + 128 * 1024;
constexpr size_t WS_WIN = 16 * MiB, WS_WM = 24 * MiB, WS_WO = 26 * MiB;
constexpr size_t WS_WGU = 32 * MiB, WS_WD = 96 * MiB;
constexpr size_t WS_H = 128 * MiB;
constexpr size_t WS_U = 256 * MiB, WS_Q = 320 * MiB, WS_K = 384 * MiB, WS_V = 448 * MiB;
constexpr size_t WS_GP = 512 * MiB, WS_GA = 640 * MiB;
constexpr size_t WS_DO = 768 * MiB;
constexpr size_t WS_END = 896 * MiB;
constexpr size_t WS_MERGED = WS_H, WS_XG = WS_U, WS_HDN = WS_GP;
constexpr int CW_TMO = 0, CW_NTILES = 16, CW_BAR = 4096, CW_CNT = 8192, CW_CUR = 10240;

constexpr int RING_BYTES = 131072;
constexpr int LDSCTL_OFF = RING_BYTES, MISC_OFF = LDSCTL_OFF + 320, UTAB_OFF = LDSCTL_OFF + 1024;
constexpr int LDS_BYTES = 147456;

__device__ __forceinline__ unsigned f2bf(float f) { unsigned u = __builtin_bit_cast(unsigned, f); return (u + 0x7fffu + ((u >> 16) & 1u)) >> 16; }
__device__ __forceinline__ unsigned pk2(float lo, float hi) { return f2bf(lo) | (f2bf(hi) << 16); }
__device__ __forceinline__ float bf2f(unsigned short b) { return __builtin_bit_cast(float, (unsigned)b << 16); }
__device__ __forceinline__ float bflo(unsigned w) { return __builtin_bit_cast(float, w << 16); }
__device__ __forceinline__ float bfhi(unsigned w) { return __builtin_bit_cast(float, w & 0xffff0000u); }
__device__ __forceinline__ unsigned cvt_pk_bf16(float lo, float hi) { unsigned r; asm volatile("v_cvt_pk_bf16_f32 %0, %1, %2" : "=v"(r) : "v"(lo), "v"(hi)); return r; }

#define XB_TMO      128
#define XB_XCNT(j)  (256  + 64 * (j))
#define XB_XSUB(j)  (1280 + 64 * (j))
#define XB_XGEN(j)  (2304 + 64 * (j))
#define XB_TOP      3328
#define XB_TOPGEN   3392
#define XCD_BAR_WORDS 3456
#define XB_SPIN_CAP (1u << 18)
__device__ __forceinline__ unsigned xb_ld(unsigned* p)              { return __hip_atomic_load(p, __ATOMIC_RELAXED, __HIP_MEMORY_SCOPE_AGENT); }
__device__ __forceinline__ unsigned xb_add(unsigned* p, unsigned v) { return __hip_atomic_fetch_add(p, v, __ATOMIC_RELAXED, __HIP_MEMORY_SCOPE_AGENT); }
__device__ __forceinline__ unsigned xb_xcc_id() { return (unsigned)__builtin_amdgcn_s_getreg((3 << 11) | 20) & 0xFu; }
#define XB_SPIN(cond, bar) do { unsigned _sp = 0; while (cond) { __builtin_amdgcn_s_sleep(1); \
    if ((++_sp & 255u) == 0u) { if (xb_ld(&(bar)[XB_TMO])) break; if (_sp > XB_SPIN_CAP) { atomicAdd(&(bar)[XB_TMO], 1u); break; } } } } while (0)
struct XcdBarrier { unsigned* bar; unsigned x; volatile LAS unsigned* st; };
__device__ __forceinline__ XcdBarrier xcd_barrier_post(unsigned* bar, volatile LAS unsigned* st) {
    XcdBarrier b; b.bar = bar; b.x = xb_xcc_id(); b.st = st;
    if (threadIdx.x == 0) (void)xb_add(&bar[XB_XCNT(b.x)], 1u);
    return b;
}
__device__ __forceinline__ void xcd_barrier_complete(unsigned* bar, unsigned x, unsigned& nloc, unsigned& nx) {
    const unsigned G = gridDim.x * gridDim.y * gridDim.z;
    unsigned sum, cnt, mine, sp = 0u;
    for (;;) {
        sum = 0u; cnt = 0u; mine = 0u;
#pragma unroll
        for (unsigned j = 0; j < 16; ++j) { const unsigned c = xb_ld(&bar[XB_XCNT(j)]); sum += c; cnt += (c > 0u) ? 1u : 0u; mine = (j == x) ? c : mine; }
        if (sum == G) break;
        __builtin_amdgcn_s_sleep(1);
        if ((++sp & 255u) == 0u) { if (xb_ld(&bar[XB_TMO])) break; if (sp > XB_SPIN_CAP) { atomicAdd(&bar[XB_TMO], 1u); break; } }
    }
    nloc = mine > 0u ? mine : 1u; nx = cnt > 0u ? cnt : 1u;
}
__device__ __forceinline__ void xcd_barrier(const XcdBarrier& b) {
    asm volatile("s_waitcnt vmcnt(0)" ::: "memory");
    __syncthreads();
    if (threadIdx.x == 0) {
        unsigned* bar = b.bar;
        __builtin_amdgcn_s_waitcnt(0);
        unsigned nloc = b.st[0], nx = b.st[1];
        if (nloc == 0u) { xcd_barrier_complete(bar, b.x, nloc, nx); b.st[0] = nloc; b.st[1] = nx; }
        const unsigned old = xb_add(&bar[XB_XSUB(b.x)], 1u);
        const unsigned gen = old / nloc;
        if (old + 1u == (gen + 1u) * nloc) {
            __builtin_amdgcn_fence(__ATOMIC_RELEASE, "agent");
            asm volatile("s_waitcnt vmcnt(0)" ::: "memory");
            const unsigned og = xb_add(&bar[XB_TOP], 1u);
            const unsigned tg = og / nx;
            if (og + 1u == (tg + 1u) * nx) xb_add(&bar[XB_TOPGEN], 1u);
            else XB_SPIN(xb_ld(&bar[XB_TOPGEN]) == tg, bar);
            __builtin_amdgcn_fence(__ATOMIC_ACQUIRE, "agent");
            xb_add(&bar[XB_XGEN(b.x)], 1u);
            asm volatile("s_waitcnt vmcnt(0)" ::: "memory");
        } else {
            XB_SPIN(xb_ld(&bar[XB_XGEN(b.x)]) == gen, bar);
            __builtin_amdgcn_fence(__ATOMIC_ACQUIRE, "agent");
            asm volatile("s_waitcnt vmcnt(0)" ::: "memory");
        }
    }
    __syncthreads();
}

namespace gm {
constexpr int BM = 256, BK = 64, HALF = 128, HTB = HALF * BK * 2, NXCD = 8, WGM = 8, NT = 16;
__host__ __device__ __forceinline__ int lds_byte(int r, int c) { const int st = (r >> 4) * 2 + (c >> 5), rr = r & 15, cc = c & 31, ob = rr * 64 + cc * 2; return st * 1024 + (ob ^ (((ob >> 9) & 1) << 5)); }
__host__ __device__ __forceinline__ void stage_rc(int b, int& R, int& C) { const int st = b / 1024, sb = b % 1024, swz = sb ^ (((sb >> 9) & 1) << 5); R = (st >> 1) * 16 + swz / 64; C = (st & 1) * 32 + (swz % 64) / 2; }
__host__ __device__ __forceinline__ int perm32(int rho) { const int n = rho >> 4, i = rho & 15; return 8 * (i >> 2) + 4 * n + (i & 3); }

struct Unit { const char* a; const char* b0; const char* b1; int pm, pn, e0, e1; };

struct StaticOrder {
    const char* A; const char* Bt; int lda, ldb; int nM, nN, nwg, G, c;
    __device__ void init(const void* A_, const void* Bt_, int lda_, int ldb_, int M, int N, int G_, int c_) { A = (const char*)A_; Bt = (const char*)Bt_; lda = lda_; ldb = ldb_; nM = M / BM; nN = N / BM; nwg = nM * nN; G = G_; c = c_; }
    __device__ __forceinline__ bool next(int i, Unit& u) const {
        const long L = (long)i * G + c; if (L >= nwg) return false;
        int wgid = (int)L; { const int q = nwg / NXCD, r = nwg % NXCD, xcd = wgid % NXCD, off = wgid / NXCD; wgid = (xcd < r ? xcd * (q + 1) : r * (q + 1) + (xcd - r) * q) + off; }
        const int nig = WGM * nN, gid = wgid / nig, fm = gid * WGM, gsz = (nM - fm) < WGM ? (nM - fm) : WGM;
        u.pm = fm + ((wgid % nig) % gsz); u.pn = (wgid % nig) / gsz; u.e0 = 0; u.e1 = 0;
        u.a = A + (size_t)u.pm * BM * lda * 2; u.b0 = Bt + (size_t)u.pn * BM * ldb * 2; u.b1 = u.b0;
        return true;
    }
    __device__ __forceinline__ void offs(const Unit&, const int (&)[2], const int (&)[2], unsigned (&)[2][2]) const {}
};

template <class Epi, class Sched, int KS, bool GATHER, bool MID>
__device__ __forceinline__ void gemm_phase(LAS unsigned char* lds, const Sched& S, const Epi& E, const int lda, const int ldb) {
    int tid = threadIdx.x; asm volatile("" : "+v"(tid));
    const int wid = __builtin_amdgcn_readfirstlane(tid >> 6), lane = tid & 63, wr = wid >> 2, wc = wid & 3, fr = lane & 15, fq = lane >> 4;
    int Rr[2], Cc[2]; unsigned offA[2][2], offAn[2][2], voffB[2];
#pragma unroll
    for (int i = 0; i < 2; ++i) { int R, C; stage_rc(tid * 16 + i * 8192, R, C); Rr[i] = R; Cc[i] = C; const int Rb = Epi::PERM ? ((R & ~31) + perm32(R & 31)) : R;
        voffB[i] = (unsigned)(Rb * ldb + C) * 2u;
        offA[0][i] = (unsigned)(R * lda + C) * 2u; offA[1][i] = (unsigned)((R + HALF) * lda + C) * 2u; offAn[0][i] = offA[0][i]; offAn[1][i] = offA[1][i]; }
    const size_t kstep = (size_t)(BK * 2);
    const size_t hstepB = (size_t)HALF * ldb * 2;
    const unsigned ldsw = (unsigned)wid * 1024u;
    const int aoff = lds_byte(wr * 64 + fr, fq * 8), boff = lds_byte(wc * 32 + fr, fq * 8);
#define G_SA(b, h) (((b) * 2 + (h)) * HTB)
#define G_SB(b, h) ((4 + (b) * 2 + (h)) * HTB)
#define G_STAGE_A(bufoff, gbase, OFF, h) do { _Pragma("unroll") for (int _i = 0; _i < 2; ++_i) \
        __builtin_amdgcn_global_load_lds((const unsigned*)((const char*)(gbase) + (OFF)[h][_i]), (LAS unsigned*)(lds + (bufoff) + ldsw + _i * 8192), 16, 0, 0); } while (0)
#define G_STAGE_B(bufoff, gbase) do { _Pragma("unroll") for (int _i = 0; _i < 2; ++_i) \
        __builtin_amdgcn_global_load_lds((const unsigned*)((const char*)(gbase) + voffB[_i]), (LAS unsigned*)(lds + (bufoff) + ldsw + _i * 8192), 16, 0, 0); } while (0)
#define G_LDA(dst, b, h) do { _Pragma("unroll") for (int m = 0; m < 4; ++m) _Pragma("unroll") for (int k = 0; k < 2; ++k) dst[m][k] = *(const LAS bf16x8*)(lds + G_SA(b, h) + aoff + m * 2048 + k * 1024); } while (0)
#define G_LDB(dst, b, h) do { _Pragma("unroll") for (int n = 0; n < 2; ++n) _Pragma("unroll") for (int k = 0; k < 2; ++k) dst[n][k] = *(const LAS bf16x8*)(lds + G_SB(b, h) + boff + n * 2048 + k * 1024); } while (0)
#define G_MMA(ai, bj, At, Bt) do { __builtin_amdgcn_s_setprio(1); _Pragma("unroll") for (int m = 0; m < 4; ++m) _Pragma("unroll") for (int n = 0; n < 2; ++n) _Pragma("unroll") for (int k = 0; k < 2; ++k) \
        acc[ai][bj][m][n] = __builtin_amdgcn_mfma_f32_16x16x32_bf16(Bt[n][k], At[m][k], acc[ai][bj][m][n], 0, 0, 0); __builtin_amdgcn_s_setprio(0); } while (0)
#define G_WAIT_V(n) asm volatile("s_waitcnt vmcnt(" #n ")" ::: "memory")
#define G_WAIT_L(n) asm volatile("s_waitcnt lgkmcnt(" #n ")" ::: "memory")
#define G_BAR __builtin_amdgcn_s_barrier()
#define G_SCHED __builtin_amdgcn_sched_barrier(0)
#define G_BP(u, t) ((t) < KS ? (u).b0 + (size_t)(t) * kstep : (u).b1 + (size_t)((t) - KS) * kstep)
    Unit cur, nxt; int ui = 0;
    if (!S.next(0, cur)) return;
    if constexpr (GATHER) S.offs(cur, Rr, Cc, offA);
    f32x4 acc[2][2][4][2];
#pragma unroll
    for (int a = 0; a < 2; ++a)
#pragma unroll
        for (int b = 0; b < 2; ++b)
#pragma unroll
            for (int m = 0; m < 4; ++m)
#pragma unroll
                for (int n = 0; n < 2; ++n) acc[a][b][m][n] = (f32x4){0.f, 0.f, 0.f, 0.f};
    bf16x8 At[4][2], B0[2][2], B1[2][2];
    {
        const char* cA = cur.a; const char* cB = cur.b0; const char* cB1 = G_BP(cur, 1);
        G_STAGE_B(G_SB(0, 0), cB); G_STAGE_B(G_SB(0, 1), cB + hstepB); G_STAGE_A(G_SA(0, 0), cA, offA, 0); G_STAGE_A(G_SA(0, 1), cA, offA, 1);
        if (wr == 1) G_BAR;
        G_WAIT_V(2); G_BAR;
        G_STAGE_B(G_SB(1, 0), cB1); G_STAGE_A(G_SA(1, 0), cA + kstep, offA, 0); G_STAGE_B(G_SB(1, 1), cB1 + hstepB);
        G_WAIT_V(6); G_BAR;
    }
    for (;;) {
        const bool has_next = S.next(ui + 1, nxt);
        for (int t = 0; t < NT; t += 2) {
            const bool last = (t == NT - 2);
            if constexpr (MID) { if (t == NT / 2) E.mid(acc, cur, wr, wc, fr, fq); }
            if constexpr (GATHER) { if (t == NT - 4 && has_next) S.offs(nxt, Rr, Cc, offAn); }
            const char* a1 = cur.a + (size_t)(t + 1) * kstep;
            const bool sw = last && has_next;
            const int t2 = last ? 0 : t + 2;
            const char* ua = sw ? nxt.a : cur.a; const char* ub0 = sw ? nxt.b0 : cur.b0; const char* ub1 = sw ? nxt.b1 : cur.b1;
            const char* a2 = ua + (size_t)t2 * kstep; const char* a3 = a2 + kstep;
            const char* b2 = (t2 < KS) ? ub0 + (size_t)t2 * kstep : ub1 + (size_t)(t2 - KS) * kstep;
            const char* b3 = (t2 + 1 < KS) ? ub0 + (size_t)(t2 + 1) * kstep : ub1 + (size_t)(t2 + 1 - KS) * kstep;
            G_LDB(B0, 0, 0); G_LDB(B1, 0, 1); G_SCHED; G_LDA(At, 0, 0); G_STAGE_A(G_SA(1, 1), a1, offA, 1);
            G_WAIT_V(8); G_WAIT_L(0); G_BAR; G_MMA(0, 0, At, B0); G_MMA(0, 1, At, B1); G_BAR; G_SCHED;
            if constexpr (GATHER) { if (sw) {
#pragma unroll
                for (int h = 0; h < 2; ++h)
#pragma unroll
                    for (int i = 0; i < 2; ++i) offA[h][i] = offAn[h][i]; } }
            G_LDA(At, 0, 1); G_STAGE_B(G_SB(0, 0), b2); G_STAGE_B(G_SB(0, 1), b2 + hstepB); G_STAGE_A(G_SA(0, 0), a2, offA, 0);
            G_WAIT_V(8); G_WAIT_L(0); G_BAR; G_MMA(1, 0, At, B0); G_MMA(1, 1, At, B1); G_BAR; G_SCHED;
            G_LDB(B0, 1, 0); G_LDB(B1, 1, 1); G_SCHED; G_LDA(At, 1, 0); G_STAGE_A(G_SA(0, 1), a2, offA, 1);
            G_WAIT_V(8); G_WAIT_L(0); G_BAR; G_MMA(0, 0, At, B0); G_MMA(0, 1, At, B1); G_BAR; G_SCHED;
            G_LDA(At, 1, 1); G_STAGE_B(G_SB(1, 0), b3); G_STAGE_B(G_SB(1, 1), b3 + hstepB); G_STAGE_A(G_SA(1, 0), a3, offA, 0);
            G_WAIT_V(8); G_WAIT_L(0); G_BAR; G_MMA(1, 0, At, B0); G_MMA(1, 1, At, B1); G_BAR; G_SCHED;
        }
        if (wr == 0) G_BAR;
        E(acc, cur, wr, wc, fr, fq);
        if (!has_next) break;
#pragma unroll
        for (int a = 0; a < 2; ++a)
#pragma unroll
            for (int b = 0; b < 2; ++b)
#pragma unroll
                for (int m = 0; m < 4; ++m)
#pragma unroll
                    for (int n = 0; n < 2; ++n) acc[a][b][m][n] = (f32x4){0.f, 0.f, 0.f, 0.f};
        cur = nxt; ++ui;
        if (wr == 1) G_BAR;
    }
    G_WAIT_V(0);
    G_BAR;
#undef G_SA
#undef G_SB
#undef G_STAGE_A
#undef G_STAGE_B
#undef G_LDA
#undef G_LDB
#undef G_MMA
#undef G_WAIT_V
#undef G_WAIT_L
#undef G_BAR
#undef G_SCHED
#undef G_BP
}

__device__ __forceinline__ void st8(bf16_t* p, f32x4 v0, f32x4 v1) { u32x4 w; w.x = cvt_pk_bf16(v0[0], v0[1]); w.y = cvt_pk_bf16(v0[2], v0[3]); w.z = cvt_pk_bf16(v1[0], v1[1]); w.w = cvt_pk_bf16(v1[2], v1[3]); *(u32x4*)p = w; }
__device__ __forceinline__ float sigm(float z) { return __builtin_amdgcn_rcpf(1.0f + __builtin_amdgcn_exp2f(-z * LOG2E)); }

struct EpiProj {
    static constexpr bool PERM = true;
    bf16_t *U, *Q, *K, *V, *GP, *GA; const float *gq, *gk;
    __device__ __forceinline__ void mid(f32x4 (&)[2][2][4][2], const Unit&, int, int, int, int) const {}
    __device__ __forceinline__ void operator()(const f32x4 (&acc)[2][2][4][2], const Unit& u, int wr, int wc, int fr, int fq) const {
        const int pn = u.pn; const int row0 = u.pm * BM + wr * 64 + fr;
        if (pn < 2 || pn == 6 || pn == 7) {
            bf16_t* base = (pn < 2) ? U : V; const int col0 = (pn & 1) * 256 + wc * 32 + 8 * fq;
#pragma unroll
            for (int ai = 0; ai < 2; ++ai)
#pragma unroll
                for (int m = 0; m < 4; ++m) { bf16_t* rowp = base + (size_t)(row0 + ai * HALF + m * 16) * 512 + col0;
#pragma unroll
                    for (int bj = 0; bj < 2; ++bj) st8(rowp + bj * HALF, acc[ai][bj][m][0], acc[ai][bj][m][1]); }
        } else if (pn < 6) {
            const bool isq = pn < 4; bf16_t* base = isq ? Q : K; const float* g = isq ? gq : gk; const float sc = isq ? (0.125f * LOG2E) : 1.0f;
            f32x4 gv[2][2];
#pragma unroll
            for (int bj = 0; bj < 2; ++bj) { gv[bj][0] = *(const f32x4*)(g + 32 * bj + 8 * fq); gv[bj][1] = *(const f32x4*)(g + 32 * bj + 8 * fq + 4); }
            const int col0 = (pn & 1) * 256 + 64 * wc + 8 * fq;
#pragma unroll
            for (int ai = 0; ai < 2; ++ai)
#pragma unroll
                for (int m = 0; m < 4; ++m) {
                    float ss = 0.f;
#pragma unroll
                    for (int bj = 0; bj < 2; ++bj)
#pragma unroll
                        for (int n = 0; n < 2; ++n) { const f32x4 x = acc[ai][bj][m][n]; ss += (x[0] * x[0] + x[1] * x[1]) + (x[2] * x[2] + x[3] * x[3]); }
                    ss += __shfl_xor(ss, 16); ss += __shfl_xor(ss, 32);
                    const float rinv = __builtin_amdgcn_rsqf(ss * (1.0f / 64.0f) + EPS) * sc;
                    bf16_t* rowp = base + (size_t)(row0 + ai * HALF + m * 16) * 512 + col0;
#pragma unroll
                    for (int bj = 0; bj < 2; ++bj) st8(rowp + 32 * bj, acc[ai][bj][m][0] * rinv * gv[bj][0], acc[ai][bj][m][1] * rinv * gv[bj][1]);
                }
        } else {
            bf16_t* base = (pn < 12) ? GP : GA; const int col0 = ((pn - 8) & 3) * 256 + wc * 32 + 8 * fq;
#pragma unroll
            for (int ai = 0; ai < 2; ++ai)
#pragma unroll
                for (int m = 0; m < 4; ++m) { bf16_t* rowp = base + (size_t)(row0 + ai * HALF + m * 16) * 1024 + col0;
#pragma unroll
                    for (int bj = 0; bj < 2; ++bj) { f32x4 v0 = acc[ai][bj][m][0], v1 = acc[ai][bj][m][1];
#pragma unroll
                        for (int i = 0; i < 4; ++i) { v0[i] = sigm(v0[i]); v1[i] = sigm(v1[i]); }
                        st8(rowp + bj * HALF, v0, v1); } }
        }
    }
};

struct EpiMerge {
    static constexpr bool PERM = true;
    const bf16_t *GP, *GA; bf16_t* O;
    __device__ __forceinline__ void mid(f32x4 (&acc)[2][2][4][2], const Unit& u, int wr, int wc, int fr, int fq) const {
        int row0 = u.pm * BM + wr * 64 + fr; const int col0 = u.pn * BM + wc * 32 + 8 * fq;
        asm volatile("" : "+v"(row0));
#pragma unroll
        for (int ai = 0; ai < 2; ++ai)
#pragma unroll
            for (int m = 0; m < 4; ++m) { const size_t off = (size_t)(row0 + ai * HALF + m * 16) * 1024 + col0;
#pragma unroll
                for (int bj = 0; bj < 2; ++bj) { const u32x4 p = *(const u32x4*)(GP + off + bj * HALF), a = *(const u32x4*)(GA + off + bj * HALF);
                    f32x4 r0, r1;
                    r0[0] = bflo(p.x) * __builtin_amdgcn_rcpf(bflo(a.x)); r0[1] = bfhi(p.x) * __builtin_amdgcn_rcpf(bfhi(a.x)); r0[2] = bflo(p.y) * __builtin_amdgcn_rcpf(bflo(a.y)); r0[3] = bfhi(p.y) * __builtin_amdgcn_rcpf(bfhi(a.y));
                    r1[0] = bflo(p.z) * __builtin_amdgcn_rcpf(bflo(a.z)); r1[1] = bfhi(p.z) * __builtin_amdgcn_rcpf(bfhi(a.z)); r1[2] = bflo(p.w) * __builtin_amdgcn_rcpf(bflo(a.w)); r1[3] = bfhi(p.w) * __builtin_amdgcn_rcpf(bfhi(a.w));
                    acc[ai][bj][m][0] *= r0; acc[ai][bj][m][1] *= r1; }
                asm volatile("" ::: "memory"); }
    }
    __device__ __forceinline__ void operator()(const f32x4 (&acc)[2][2][4][2], const Unit& u, int wr, int wc, int fr, int fq) const {
        const int row0 = u.pm * BM + wr * 64 + fr, col0 = u.pn * BM + wc * 32 + 8 * fq;
#pragma unroll
        for (int ai = 0; ai < 2; ++ai)
#pragma unroll
            for (int m = 0; m < 4; ++m) { const size_t off = (size_t)(row0 + ai * HALF + m * 16) * 1024 + col0;
#pragma unroll
                for (int bj = 0; bj < 2; ++bj) { const u32x4 a = *(const u32x4*)(GA + off + bj * HALF);
                    const f32x4 g0 = {bflo(a.x), bfhi(a.x), bflo(a.y), bfhi(a.y)}, g1 = {bflo(a.z), bfhi(a.z), bflo(a.w), bfhi(a.w)};
                    st8(O + off + bj * HALF, acc[ai][bj][m][0] * g0, acc[ai][bj][m][1] * g1); } }
    }
};

struct EpiRes {
    static constexpr bool PERM = false;
    const float* X; float* O;
    __device__ __forceinline__ void mid(f32x4 (&)[2][2][4][2], const Unit&, int, int, int, int) const {}
    __device__ __forceinline__ void operator()(const f32x4 (&acc)[2][2][4][2], const Unit& u, int wr, int wc, int fr, int fq) const {
        const int row0 = u.pm * BM + wr * 64 + fr, col0 = u.pn * BM + wc * 32 + 4 * fq;
#pragma unroll
        for (int ai = 0; ai < 2; ++ai)
#pragma unroll
            for (int m = 0; m < 4; ++m) { const size_t off = (size_t)(row0 + ai * HALF + m * 16) * 1024 + col0;
#pragma unroll
                for (int bj = 0; bj < 2; ++bj)
#pragma unroll
                    for (int n = 0; n < 2; ++n) { const f32x4 xv = *(const f32x4*)(X + off + bj * HALF + n * 16); *(f32x4*)(O + off + bj * HALF + n * 16) = xv + acc[ai][bj][m][n]; } }
    }
};

struct EpiMoe1 {
    static constexpr bool PERM = true;
    const float *SR, *SWLO, *SWHI; bf16_t* HDN;
    __device__ __forceinline__ void mid(f32x4 (&)[2][2][4][2], const Unit&, int, int, int, int) const {}
    __device__ __forceinline__ void operator()(const f32x4 (&acc)[2][2][4][2], const Unit& u, int wr, int wc, int fr, int fq) const {
        const int slot0 = u.pm * BM + wr * 64 + fr; const float* SW = (u.pn < 4) ? SWLO : SWHI;
        const int col0 = (u.pn >> 2) * 512 + (u.pn & 3) * 128 + wc * 32 + 8 * fq;
#pragma unroll
        for (int ai = 0; ai < 2; ++ai)
#pragma unroll
            for (int m = 0; m < 4; ++m) { const int slot = slot0 + ai * HALF + m * 16; const float rs = SR[slot], w = SW[slot];
                f32x4 h0, h1;
#pragma unroll
                for (int i = 0; i < 4; ++i) { const float g0 = acc[ai][0][m][0][i] * rs, u0 = acc[ai][1][m][0][i] * rs, g1 = acc[ai][0][m][1][i] * rs, u1 = acc[ai][1][m][1][i] * rs;
                    h0[i] = g0 * sigm(g0) * u0 * w; h1[i] = g1 * sigm(g1) * u1 * w; }
                st8(HDN + (size_t)slot * 1024 + col0, h0, h1); }
    }
};

struct EpiMoe2 {
    static constexpr bool PERM = false;
    const int* STOK; float* O;
    __device__ __forceinline__ void mid(f32x4 (&)[2][2][4][2], const Unit&, int, int, int, int) const {}
    __device__ __forceinline__ void operator()(const f32x4 (&acc)[2][2][4][2], const Unit& u, int wr, int wc, int fr, int fq) const {
        const int slot0 = u.pm * BM + wr * 64 + fr, col0 = u.pn * BM + wc * 32 + 4 * fq;
#pragma unroll
        for (int ai = 0; ai < 2; ++ai)
#pragma unroll
            for (int m = 0; m < 4; ++m) { const int tok = STOK[slot0 + ai * HALF + m * 16];
                if (tok >= 0) { float* rowp = O + (size_t)tok * 1024 + col0;
#pragma unroll
                    for (int bj = 0; bj < 2; ++bj)
#pragma unroll
                        for (int n = 0; n < 2; ++n) { f32x4* p = (f32x4*)(rowp + bj * HALF + n * 16); *p = *p + acc[ai][bj][m][n]; } } }
    }
};

struct MoeSched {
    const LAS int* tab; const char* A; const char* B; const int* STOK; int mode;
    __device__ __forceinline__ bool next(int i, Unit& u) const {
        if (i >= 16) return false;
        const int tile = __builtin_amdgcn_readfirstlane(tab[i * 4 + 0]); if (tile < 0) return false;
        const int pn = __builtin_amdgcn_readfirstlane(tab[i * 4 + 1]), e0 = __builtin_amdgcn_readfirstlane(tab[i * 4 + 2]), e1 = __builtin_amdgcn_readfirstlane(tab[i * 4 + 3]);
        u.pm = tile; u.pn = pn; u.e0 = e0; u.e1 = e1;
        if (mode == 1) { const int e = (pn < 4) ? e0 : e1; u.a = A; u.b0 = B + ((size_t)e * 1024 * 1024 + (size_t)(pn & 3) * 256 * 1024) * 2; u.b1 = u.b0; }
        else { u.a = A + (size_t)tile * 256 * 1024 * 2; u.b0 = B + ((size_t)pn * 256 * 16384 + (size_t)e0 * 512) * 2; u.b1 = B + ((size_t)pn * 256 * 16384 + (size_t)e1 * 512) * 2; }
        return true;
    }
    __device__ __forceinline__ void offs(const Unit& u, const int (&Rr)[2], const int (&Cc)[2], unsigned (&off)[2][2]) const {
#pragma unroll
        for (int h = 0; h < 2; ++h)
#pragma unroll
            for (int i = 0; i < 2; ++i) { int tok = STOK[u.pm * 256 + h * 128 + Rr[i]]; tok = tok < 0 ? 0 : tok; off[h][i] = ((unsigned)tok * 1024u + (unsigned)Cc[i]) * 2u; }
    }
};
}

namespace att {
__device__ __forceinline__ int crow(int r, int hi) { return (r & 3) + 8 * (r >> 2) + 4 * hi; }
__device__ __forceinline__ void glds16(const void* gsrc, unsigned lds_dst) { unsigned keep;
    asm volatile("s_mov_b32 %0, m0\n\ts_mov_b32 m0, %2\n\ts_nop 0\n\tglobal_load_lds_dwordx4 %1, off\n\ts_mov_b32 m0, %0" : "=&s"(keep) : "v"(gsrc), "s"(lds_dst) : "memory"); }
#define ATT_WAIT_BAR() asm volatile("s_waitcnt vmcnt(0) lgkmcnt(0)\n\ts_barrier" ::: "memory")
constexpr int SLOT = 32768;
constexpr int WSF_OFF = 65536;
constexpr int XCH_OFF = 0;

__device__ __forceinline__ void attn_unit(int b, int h, int qb, const bf16_t* Q, const bf16_t* K, const bf16_t* V, bf16_t* DO, char* shm, float B2, float lam, const float* subg) {
    const int tid = threadIdx.x, lane = tid & 63, r32 = lane & 31, hi = lane >> 5; const int wid = __builtin_amdgcn_readfirstlane(tid >> 6);
    const int mm = wid >> 2, wq = wid & 3;
    const long rowbase = (long)b * SEQ; const int q0 = qb * 128, i0 = q0 + wq * 32;
    const float aslope = LOG2E * __builtin_amdgcn_exp2f(-2.0f * (float)(h + 1));
    const unsigned lds0 = (unsigned)(uintptr_t)shm;
    float* wsf = (float*)(shm + WSF_OFF) + wid * 64;
    const bf16_t* Qw = Q + (rowbase + i0 + r32) * 512 + h * 128 + mm * 64 + hi * 8;
    bf16x8 qr[4];
#pragma unroll
    for (int ks = 0; ks < 4; ++ks) qr[ks] = *(const bf16x8*)(Qw + ks * 16);
    const bf16_t* ksrc0 = K + (rowbase + lane) * 512 + h * 128 + wid * 8;
    const bf16_t* ksrc1 = ksrc0 + 64;
    const int p0i = 2 * wid, p1i = 2 * wid + 1;
    const bf16_t* vsrc0 = V + (rowbase + 16 * (p0i & 3) + (lane >> 2)) * 512 + h * 128 + 32 * (p0i >> 2) + 8 * (lane & 3);
    const bf16_t* vsrc1 = V + (rowbase + 16 * (p1i & 3) + (lane >> 2)) * 512 + h * 128 + 32 * (p1i >> 2) + 8 * (lane & 3);
    const int NTL = 2 * qb + 2;
#define ATT_DMA(t, slot) do { const long _o = (long)(t) * 64 * 512; const unsigned _s = lds0 + (unsigned)(slot) * SLOT; \
        glds16(ksrc0 + _o, (unsigned)__builtin_amdgcn_readfirstlane(_s + wid * 1024)); glds16(ksrc1 + _o, (unsigned)__builtin_amdgcn_readfirstlane(_s + 8192 + wid * 1024)); \
        glds16(vsrc0 + _o, (unsigned)__builtin_amdgcn_readfirstlane(_s + 16384 + p0i * 1024)); glds16(vsrc1 + _o, (unsigned)__builtin_amdgcn_readfirstlane(_s + 16384 + p1i * 1024)); } while (0)
    ATT_DMA(0, 0);
    f32x16 o[4]; o[0] = f32x16{}; o[1] = f32x16{}; o[2] = f32x16{}; o[3] = f32x16{};
    float l_reg = 0.f;
    const int irow = i0 + r32;
    for (int t = 0; t < NTL; ++t) {
        ATT_WAIT_BAR();
        if (t + 1 < NTL) ATT_DMA(t + 1, (t + 1) & 1);
        const int j0 = 64 * t;
        if (j0 <= i0 + 31) {
            const char* Kslot = shm + (t & 1) * SLOT + mm * 8192;
            const char* kb = Kslot + hi * 1024 + r32 * 16;
            f32x16 p0 = f32x16{}, p1 = f32x16{};
#pragma unroll
            for (int d0 = 0; d0 < 4; ++d0) {
                const bf16x8 b0 = *(const bf16x8*)(kb + d0 * 2048), b1 = *(const bf16x8*)(kb + d0 * 2048 + 512);
                p0 = __builtin_amdgcn_mfma_f32_32x32x16_bf16(b0, qr[d0], p0, 0, 0, 0); p1 = __builtin_amdgcn_mfma_f32_32x32x16_bf16(b1, qr[d0], p1, 0, 0, 0); }
            const float base = aslope * (float)(j0 + 4 * hi - irow) - B2;
#pragma unroll
            for (int r = 0; r < 16; ++r) { const int kk = (r & 3) + 8 * (r >> 2); p0[r] += base + aslope * (float)kk; p1[r] += base + aslope * (float)(kk + 32); }
            if (j0 + 63 > i0) {
                const int jb = j0 + 4 * hi;
#pragma unroll
                for (int r = 0; r < 16; ++r) { const int j = jb + (r & 3) + 8 * (r >> 2); if (j > irow) p0[r] = -1.0e30f; if (j + 32 > irow) p1[r] = -1.0e30f; }
            }
            float sacc = 0.f;
#pragma unroll
            for (int r = 0; r < 16; ++r) { p0[r] = __builtin_amdgcn_exp2f(p0[r]); p1[r] = __builtin_amdgcn_exp2f(p1[r]); sacc += p0[r] + p1[r]; }
            l_reg += sacc;
            u32x4 pw[4];
            pw[0] = (u32x4){cvt_pk_bf16(p0[0], p0[1]), cvt_pk_bf16(p0[2], p0[3]), cvt_pk_bf16(p0[4], p0[5]), cvt_pk_bf16(p0[6], p0[7])};
            pw[1] = (u32x4){cvt_pk_bf16(p0[8], p0[9]), cvt_pk_bf16(p0[10], p0[11]), cvt_pk_bf16(p0[12], p0[13]), cvt_pk_bf16(p0[14], p0[15])};
            pw[2] = (u32x4){cvt_pk_bf16(p1[0], p1[1]), cvt_pk_bf16(p1[2], p1[3]), cvt_pk_bf16(p1[4], p1[5]), cvt_pk_bf16(p1[6], p1[7])};
            pw[3] = (u32x4){cvt_pk_bf16(p1[8], p1[9]), cvt_pk_bf16(p1[10], p1[11]), cvt_pk_bf16(p1[12], p1[13]), cvt_pk_bf16(p1[14], p1[15])};
            const int vb = (int)(lds0 + (t & 1) * SLOT + 16384) + ((lane >> 4) & 1) * 32 + (lane & 3) * 8 + (4 * hi + ((lane & 15) >> 2)) * 64;
#pragma unroll
            for (int d0 = 0; d0 < 4; ++d0) { s16x4 lo[4], hh[4];
#pragma unroll
                for (int ks = 0; ks < 4; ++ks) {
                    asm volatile("ds_read_b64_tr_b16 %0,%1 offset:%c2" : "=&v"(lo[ks]) : "v"(vb), "i"(d0 * 4096 + ks * 1024) : "memory");
                    asm volatile("ds_read_b64_tr_b16 %0,%1 offset:%c2" : "=&v"(hh[ks]) : "v"(vb), "i"(d0 * 4096 + ks * 1024 + 512) : "memory"); }
                asm volatile("s_waitcnt lgkmcnt(0)" ::: "memory"); __builtin_amdgcn_sched_barrier(0);
#pragma unroll
                for (int ks = 0; ks < 4; ++ks) { const bf16x8 vf = (bf16x8){lo[ks][0], lo[ks][1], lo[ks][2], lo[ks][3], hh[ks][0], hh[ks][1], hh[ks][2], hh[ks][3]};
                    o[d0] = __builtin_amdgcn_mfma_f32_32x32x16_bf16(__builtin_bit_cast(bf16x8, pw[ks]), vf, o[d0], 0, 0, 0); }
            }
        }
    }
    { auto rr = __builtin_amdgcn_permlane32_swap(__float_as_uint(l_reg), __float_as_uint(l_reg), false, false); l_reg = __uint_as_float(rr[0]) + __uint_as_float(rr[1]); }
    if (hi == 0) wsf[r32] = l_reg;
    asm volatile("s_waitcnt lgkmcnt(0)" ::: "memory");
    const float fac = (mm == 0) ? 1.0f : lam;
#pragma unroll
    for (int r = 0; r < 16; ++r) { const float rl = fac * __builtin_amdgcn_rcpf(wsf[crow(r, hi)]);
#pragma unroll
        for (int d0 = 0; d0 < 4; ++d0) o[d0][r] *= rl; }
    ATT_WAIT_BAR();
    float* xch = (float*)(shm + XCH_OFF) + (size_t)wq * 32 * 128;
    if (mm == 1) {
#pragma unroll
        for (int r = 0; r < 16; ++r)
#pragma unroll
            for (int d0 = 0; d0 < 4; ++d0) xch[crow(r, hi) * 128 + 32 * d0 + r32] = o[d0][r];
    }
    ATT_WAIT_BAR();
    if (mm == 0) {
        float gsub[4];
#pragma unroll
        for (int d0 = 0; d0 < 4; ++d0) gsub[d0] = subg[32 * d0 + r32] * 0.8f;
#pragma unroll
        for (int r = 0; r < 16; ++r) {
            float ss = 0.f;
#pragma unroll
            for (int d0 = 0; d0 < 4; ++d0) { o[d0][r] -= xch[crow(r, hi) * 128 + 32 * d0 + r32]; ss += o[d0][r] * o[d0][r]; }
            ss += __shfl_xor(ss, 1); ss += __shfl_xor(ss, 2); ss += __shfl_xor(ss, 4); ss += __shfl_xor(ss, 8); ss += __shfl_xor(ss, 16);
            const float rinv = __builtin_amdgcn_rsqf(ss * (1.0f / 128.0f) + EPS);
            bf16_t* orow = DO + (size_t)(rowbase + i0 + crow(r, hi)) * 1024 + 512 + h * 128 + r32;
#pragma unroll
            for (int d0 = 0; d0 < 4; ++d0) orow[32 * d0] = (bf16_t)f2bf(o[d0][r] * rinv * gsub[d0]);
        }
    }
    ATT_WAIT_BAR();
#undef ATT_DMA
}
}

struct Args { const float* in[23]; float* out; unsigned char* ws; };

__device__ __forceinline__ float wave_sum(float v) {
#pragma unroll
    for (int o = 1; o < 64; o <<= 1) v += __shfl_xor(v, o);
    return v;
}
__device__ __forceinline__ float wave_max(float v) {
#pragma unroll
    for (int o = 1; o < 64; o <<= 1) v = fmaxf(v, __shfl_xor(v, o));
    return v;
}

template <class DstF>
__device__ __forceinline__ void transpose_item(const float* W, int N, int k0, int n0, LAS float* scr, int lane, DstF dst) {
#pragma unroll 8
    for (int i = 0; i < 32; ++i) { const int kk = 2 * i + (lane >> 5); scr[kk * 33 + (lane & 31)] = W[(size_t)(k0 + kk) * N + n0 + (lane & 31)]; }
    LDS_WAIT(); asm volatile("" ::: "memory");
    const int c = lane & 7;
#pragma unroll
    for (int j = 0; j < 4; ++j) { const int n = (lane >> 3) + 8 * j; const LAS float* s = scr + (8 * c) * 33 + n;
        u32x4 o; o.x = pk2(s[0 * 33], s[1 * 33]); o.y = pk2(s[2 * 33], s[3 * 33]); o.z = pk2(s[4 * 33], s[5 * 33]); o.w = pk2(s[6 * 33], s[7 * 33]);
        *(GAS u32x4*)(dst(n0 + n) + k0 + 8 * c) = o; }
    LDS_WAIT(); asm volatile("" ::: "memory");
}

#define PH_BEGIN() unsigned char* ws = args.ws; asm volatile("" : "+s"(ws)); int tid = threadIdx.x; asm volatile("" : "+v"(tid)); \
    const int lane = tid & 63, wave = __builtin_amdgcn_readfirstlane(tid >> 6); const int G = gridDim.x, bx = blockIdx.x; \
    const int vcu = (G % 8 == 0) ? (bx % 8) * (G / 8) + bx / 8 : bx; const int gw = vcu * NWAVES + wave, NGW = G * NWAVES; \
    gu32* ctl = (gu32*)(ws + WS_CTL); (void)lane; (void)wave; (void)gw; (void)NGW; (void)ctl; (void)vcu
#define WSP(T, off) ((T*)(ws + (off)))

__global__ void __launch_bounds__(NWAVES * 64, 2) hybrid_fwd(Args args) {
    extern __shared__ __attribute__((aligned(16))) unsigned char lds[];
    LAS unsigned char* L = (LAS unsigned char*)lds;
    volatile LAS unsigned* MISC = (volatile LAS unsigned*)(L + MISC_OFF);
    for (int u = threadIdx.x; u < (LDS_BYTES - LDSCTL_OFF) / 4; u += NWAVES * 64) ((LAS unsigned*)(L + LDSCTL_OFF))[u] = 0u;
    __syncthreads();
    XcdBarrier bar = xcd_barrier_post((unsigned*)((gu32*)(args.ws + WS_CTL) + CW_BAR), MISC + 8);

    if (PHASE_MASK & 1) {
        PH_BEGIN();
        bf16_t* WinT = WSP(bf16_t, WS_WIN); bf16_t* WmT = WSP(bf16_t, WS_WM); bf16_t* WoT = WSP(bf16_t, WS_WO); bf16_t* WguT = WSP(bf16_t, WS_WGU); bf16_t* WdT = WSP(bf16_t, WS_WD);
        bf16_t* WrH = WSP(bf16_t, WS_WRH); bf16_t* WrL = WSP(bf16_t, WS_WRL); bf16_t* Hb = WSP(bf16_t, WS_H);
        LAS float* scr = (LAS float*)(L + wave * 16384);
        constexpr int I_IN = 16 * 128, I_AU = 8 * 32, I_OUT = 16 * 32, I_G = 32 * 256, I_U = 32 * 256, I_D = 32 * 256;
        constexpr int NITEMS = I_IN + I_AU + I_OUT + I_G + I_U + I_D;
        for (int it = gw; it < NITEMS; it += NGW) {
            int r = it;
            if (r < I_IN) { const int kb = r / 128, nb = r % 128;
                transpose_item(args.in[2], 4096, kb * 64, nb * 32, scr, lane, [&](int n) -> bf16_t* {
                    int v = n; if (n >= 512 && n < 1536) { const int l = n & 255; v = (n & ~255) + 128 * ((l >> 5) & 1) + 32 * (l >> 6) + (l & 31); }
                    return WinT + (size_t)v * 1024; });
                continue; } r -= I_IN;
            if (r < I_AU) { const int kb = r / 32, nb = r % 32;
                transpose_item(args.in[13], 1024, kb * 64, nb * 32, scr, lane, [&](int n) -> bf16_t* { return WmT + (size_t)n * 1024 + 512; }); continue; } r -= I_AU;
            if (r < I_OUT) { const int kb = r / 32, nb = r % 32;
                transpose_item(args.in[14], 1024, kb * 64, nb * 32, scr, lane, [&](int n) -> bf16_t* { return WoT + (size_t)n * 1024; }); continue; } r -= I_OUT;
            if (r < I_G) { const int e = r / 256, q = r % 256, kb = q / 16, nb = q % 16;
                transpose_item(args.in[20] + (size_t)e * 1024 * 512, 512, kb * 64, nb * 32, scr, lane, [&](int n) -> bf16_t* { return WguT + (size_t)e * 1024 * 1024 + (size_t)(256 * (n >> 7) + (n & 127)) * 1024; }); continue; } r -= I_G;
            if (r < I_U) { const int e = r / 256, q = r % 256, kb = q / 16, nb = q % 16;
                transpose_item(args.in[21] + (size_t)e * 1024 * 512, 512, kb * 64, nb * 32, scr, lane, [&](int n) -> bf16_t* { return WguT + (size_t)e * 1024 * 1024 + (size_t)(256 * (n >> 7) + 128 + (n & 127)) * 1024; }); continue; } r -= I_U;
            { const int e = r / 256, q = r % 256, kb = q / 32, nb = q % 32;
                transpose_item(args.in[22] + (size_t)e * 512 * 1024, 1024, kb * 64, nb * 32, scr, lane, [&](int n) -> bf16_t* { return WdT + (size_t)n * 16384 + (size_t)e * 512; }); }
        }
        for (int it = gw; it < 2048; it += NGW) {
            const int kq = it >> 4, nb = it & 15, n = 64 * nb + lane, k = 4 * kq, g = k >> 7, kl = k & 127;
            const float* pw = args.in[3] + (size_t)(g * 128 + kl) * 128; const float* sc = args.in[4] + g * 128; const float* wu = args.in[5] + (size_t)(g * 128) * 1024 + n;
            float a0 = 0.f, a1 = 0.f, a2 = 0.f, a3 = 0.f;
            for (int c = 0; c < 128; ++c) { const float wv = wu[(size_t)c * 1024] * sc[c]; a0 += pw[c] * wv; a1 += pw[128 + c] * wv; a2 += pw[256 + c] * wv; a3 += pw[384 + c] * wv; }
            u32x2 o; o.x = pk2(a0, a1); o.y = pk2(a2, a3);
            *(u32x2*)(WmT + (size_t)n * 1024 + k) = o;
        }
        for (int it = gw * 64 + lane; it < 48 * 1024; it += NGW * 64) {
            const int n = it >> 10, k = it & 1023; float w = 0.f;
            if (n < 4) w = args.in[16][k * 4 + n]; else if (n < 36) w = args.in[18][k * 32 + (n - 4)];
            const unsigned hb = f2bf(w); const float lo = w - __builtin_bit_cast(float, hb << 16);
            WrH[it] = (bf16_t)hb; WrL[it] = (bf16_t)f2bf(lo);
        }
        { const float* x = args.in[0]; const GAS f32x4* g4 = (const GAS f32x4*)args.in[1] + lane; f32x4 gg[4];
#pragma unroll
          for (int j = 0; j < 4; ++j) gg[j] = g4[64 * j];
          for (int m = gw; m < NTOK; m += NGW) {
            const GAS f32x4* xr = (const GAS f32x4*)(x + (size_t)m * DM) + lane;
            f32x4 v[4]; float s = 0.f;
#pragma unroll
            for (int j = 0; j < 4; ++j) { v[j] = xr[64 * j]; s += (v[j].x * v[j].x + v[j].y * v[j].y) + (v[j].z * v[j].z + v[j].w * v[j].w); }
            const float rstd = __builtin_amdgcn_rsqf(wave_sum(s) * (1.f / DM) + EPS);
            GAS unsigned long long* o8 = (GAS unsigned long long*)(Hb + (size_t)m * DM) + lane;
#pragma unroll
            for (int j = 0; j < 4; ++j) { const f32x4 y = v[j] * rstd * gg[j]; o8[64 * j] = (unsigned long long)pk2(y.x, y.y) | ((unsigned long long)pk2(y.z, y.w) << 32); }
          } }
    }
    xcd_barrier(bar);

    if (PHASE_MASK & 2) {
        PH_BEGIN();
        gm::StaticOrder S; S.init(WSP(bf16_t, WS_H), WSP(bf16_t, WS_WIN), 1024, 1024, NTOK, 4096, G, bx);
        gm::EpiProj E{WSP(bf16_t, WS_U), WSP(bf16_t, WS_Q), WSP(bf16_t, WS_K), WSP(bf16_t, WS_V), WSP(bf16_t, WS_GP), WSP(bf16_t, WS_GA), args.in[6], args.in[7]};
        gm::gemm_phase<gm::EpiProj, gm::StaticOrder, gm::NT, false, false>(L, S, E, 1024, 1024);
    }
    xcd_barrier(bar);

    if (PHASE_MASK & 4) {
        PH_BEGIN();
        bf16_t* Ub = WSP(bf16_t, WS_U); bf16_t* DOb = WSP(bf16_t, WS_DO);
        float lam, B2;
        { const float a1 = args.in[8][lane] * args.in[9][lane], a2 = args.in[10][lane] * args.in[11][lane];
          lam = __expf(wave_sum(a1)) - __expf(wave_sum(a2)) + 0.2f;
          const float mq = wave_max(fabsf(args.in[6][lane])), mk = wave_max(fabsf(args.in[7][lane]));
          B2 = 8.0f * mq * mk * LOG2E * 1.02f + 0.5f; }
        for (int i = 0; i < 8; ++i) {
            const int bh = vcu >> 1, j = vcu & 1; const int s = 2 * (i >> 1) + j; const int qb = (i & 1) ? 15 - s : s;
            att::attn_unit(bh >> 2, bh & 3, qb, WSP(bf16_t, WS_Q), WSP(bf16_t, WS_K), WSP(bf16_t, WS_V), DOb, (char*)lds, B2, lam, args.in[12]);
        }
        { const int w = 2 << (lane >> 4);
          for (int blk = gw; blk < NTOK / 8; blk += NGW) {
            for (int tt = 0; tt < 8; ++tt) {
                const int tok = blk * 8 + tt, t = tok & (SEQ - 1);
                float sacc[8];
#pragma unroll
                for (int c = 0; c < 8; ++c) sacc[c] = 0.f;
                f32x4 cur0 = {0.f, 0.f, 0.f, 0.f}, cur1 = {0.f, 0.f, 0.f, 0.f};
                for (int s = 0; s < 16; ++s) {
                    if (s < w && t - s >= 0) {
                        const u32x4 v = *(const u32x4*)(Ub + (size_t)(tok - s) * 512 + lane * 8);
                        const float f0 = bflo(v.x), f1 = bfhi(v.x), f2 = bflo(v.y), f3 = bfhi(v.y), f4 = bflo(v.z), f5 = bfhi(v.z), f6 = bflo(v.w), f7 = bfhi(v.w);
                        sacc[0] += f0; sacc[1] += f1; sacc[2] += f2; sacc[3] += f3; sacc[4] += f4; sacc[5] += f5; sacc[6] += f6; sacc[7] += f7;
                        if (s == 0) { cur0 = (f32x4){f0, f1, f2, f3}; cur1 = (f32x4){f4, f5, f6, f7}; }
                    }
                }
                const float inv = 1.0f / (float)((t + 1 < w) ? t + 1 : w);
                u32x4 o; o.x = pk2(sacc[0] * inv - cur0[0], sacc[1] * inv - cur0[1]); o.y = pk2(sacc[2] * inv - cur0[2], sacc[3] * inv - cur0[3]);
                o.z = pk2(sacc[4] * inv - cur1[0], sacc[5] * inv - cur1[1]); o.w = pk2(sacc[6] * inv - cur1[2], sacc[7] * inv - cur1[3]);
                *(u32x4*)(DOb + (size_t)tok * 1024 + lane * 8) = o;
            }
          } }
    }
    xcd_barrier(bar);

    if (PHASE_MASK & 8) {
        PH_BEGIN();
        gm::StaticOrder S; S.init(WSP(bf16_t, WS_DO), WSP(bf16_t, WS_WM), 1024, 1024, NTOK, 1024, G, bx);
        gm::EpiMerge E{WSP(bf16_t, WS_GP), WSP(bf16_t, WS_GA), WSP(bf16_t, WS_MERGED)};
        gm::gemm_phase<gm::EpiMerge, gm::StaticOrder, gm::NT, false, true>(L, S, E, 1024, 1024);
    }
    xcd_barrier(bar);

    if (PHASE_MASK & 16) {
        PH_BEGIN();
        gm::StaticOrder S; S.init(WSP(bf16_t, WS_MERGED), WSP(bf16_t, WS_WO), 1024, 1024, NTOK, 1024, G, bx);
        gm::EpiRes E{args.in[0], args.out};
        gm::gemm_phase<gm::EpiRes, gm::StaticOrder, gm::NT, false, false>(L, S, E, 1024, 1024);
    }
    xcd_barrier(bar);

    if (PHASE_MASK & 32) {
        PH_BEGIN();
        float* rstd2 = WSP(float, WS_RSTD); int* tcls = WSP(int, WS_TCLS); float* twlo = WSP(float, WS_TWLO); float* twhi = WSP(float, WS_TWHI);
        int* stok = WSP(int, WS_STOK); float* swlo = WSP(float, WS_SWLO); float* swhi = WSP(float, WS_SWHI); float* srstd = WSP(float, WS_SRSTD);
        bf16_t* XGb = WSP(bf16_t, WS_XG); const bf16_t* WrH = WSP(bf16_t, WS_WRH); const bf16_t* WrL = WSP(bf16_t, WS_WRL);
        const float* out = args.out;
        for (int i = gw * 64 + lane; i < MAXT * 256; i += NGW * 64) { stok[i] = -1; swlo[i] = 0.f; swhi[i] = 0.f; srstd[i] = 0.f; }
        LAS float* lg = (LAS float*)(L + wave * 4096);
        const float* g2 = args.in[15];
        const int row = lane & 15, kg = lane >> 4;
        for (int blk = gw; blk < NTOK / 16; blk += NGW) {
            const int tok = blk * 16 + row;
            const float* xr = out + (size_t)tok * 1024 + kg * 8;
            f32x4 acc[3]; acc[0] = (f32x4){0.f, 0.f, 0.f, 0.f}; acc[1] = acc[0]; acc[2] = acc[0];
            float ss = 0.f;
#pragma unroll 2
            for (int k0 = 0; k0 < 1024; k0 += 32) {
                f32x4 a = *(const f32x4*)(xr + k0), b = *(const f32x4*)(xr + k0 + 4);
                const f32x4 ga = *(const f32x4*)(g2 + k0 + kg * 8), gb = *(const f32x4*)(g2 + k0 + kg * 8 + 4);
                ss += (a[0] * a[0] + a[1] * a[1]) + (a[2] * a[2] + a[3] * a[3]) + (b[0] * b[0] + b[1] * b[1]) + (b[2] * b[2] + b[3] * b[3]);
                a = a * ga; b = b * gb;
                unsigned hw[4], lw[4];
#pragma unroll
                for (int p = 0; p < 4; ++p) { const float v0 = (p < 2) ? a[2 * p] : b[2 * p - 4], v1 = (p < 2) ? a[2 * p + 1] : b[2 * p - 3];
                    const unsigned h0 = f2bf(v0), h1 = f2bf(v1); hw[p] = h0 | (h1 << 16);
                    lw[p] = pk2(v0 - __builtin_bit_cast(float, h0 << 16), v1 - __builtin_bit_cast(float, h1 << 16)); }
                const u32x4 H4 = {hw[0], hw[1], hw[2], hw[3]}, L4 = {lw[0], lw[1], lw[2], lw[3]};
                *(u32x4*)(XGb + (size_t)tok * 1024 + k0 + kg * 8) = H4;
                const bf16x8 Ah = __builtin_bit_cast(bf16x8, H4), Al = __builtin_bit_cast(bf16x8, L4);
#pragma unroll
                for (int nf = 0; nf < 3; ++nf) {
                    const bf16x8 Bh = *(const bf16x8*)(WrH + (size_t)(nf * 16 + row) * 1024 + k0 + kg * 8), Bl = *(const bf16x8*)(WrL + (size_t)(nf * 16 + row) * 1024 + k0 + kg * 8);
                    acc[nf] = __builtin_amdgcn_mfma_f32_16x16x32_bf16(Ah, Bh, acc[nf], 0, 0, 0);
                    acc[nf] = __builtin_amdgcn_mfma_f32_16x16x32_bf16(Al, Bh, acc[nf], 0, 0, 0);
                    acc[nf] = __builtin_amdgcn_mfma_f32_16x16x32_bf16(Ah, Bl, acc[nf], 0, 0, 0);
                }
            }
            ss += __shfl_xor(ss, 16); ss += __shfl_xor(ss, 32);
            const float rstd = __builtin_amdgcn_rsqf(ss * (1.0f / 1024.0f) + EPS);
#pragma unroll
            for (int nf = 0; nf < 3; ++nf)
#pragma unroll
                for (int r = 0; r < 4; ++r) lg[(4 * kg + r) * 48 + 16 * nf + row] = acc[nf][r];
            LDS_WAIT(); asm volatile("" ::: "memory");
            if (lane < 16) {
                const LAS float* my = lg + lane * 48;
                float gl[4]; int g = 0;
#pragma unroll
                for (int j = 0; j < 4; ++j) gl[j] = rstd * my[j] + args.in[17][j];
                float gmx = gl[0];
#pragma unroll
                for (int j = 1; j < 4; ++j) if (gl[j] > gmx) { gmx = gl[j]; g = j; }
                float den = 0.f;
#pragma unroll
                for (int j = 0; j < 4; ++j) den += __expf(gl[j] - gmx);
                const float ptop = 1.0f / den;
                float le[8];
#pragma unroll
                for (int e = 0; e < 8; ++e) le[e] = rstd * my[4 + g * 8 + e] + args.in[19][g * 8 + e];
                int e1 = 0; float v1 = le[0];
#pragma unroll
                for (int e = 1; e < 8; ++e) if (le[e] > v1) { v1 = le[e]; e1 = e; }
                int e2 = -1; float v2 = -3.0e38f;
#pragma unroll
                for (int e = 0; e < 8; ++e) if (e != e1 && le[e] > v2) { v2 = le[e]; e2 = e; }
                const float rr = __expf(v2 - v1), w1 = ptop / (1.0f + rr), w2 = ptop * rr / (1.0f + rr);
                const int lo = e1 < e2 ? e1 : e2, hi2 = e1 < e2 ? e2 : e1;
                const float wlo = e1 < e2 ? w1 : w2, whi = e1 < e2 ? w2 : w1;
                const int cls = g * 28 + lo * 8 - (lo * (lo + 1)) / 2 + (hi2 - lo - 1);
                tcls[tok] = cls; twlo[tok] = wlo; twhi[tok] = whi; rstd2[tok] = rstd;
                atomicAdd((unsigned*)(ctl + CW_CNT) + cls * 16, 1u);
            }
            LDS_WAIT(); asm volatile("" ::: "memory");
        }
    }
    xcd_barrier(bar);

    if (PHASE_MASK & 64) {
        PH_BEGIN();
        float* rstd2 = WSP(float, WS_RSTD); int* tcls = WSP(int, WS_TCLS); float* twlo = WSP(float, WS_TWLO); float* twhi = WSP(float, WS_TWHI);
        int* stok = WSP(int, WS_STOK); float* swlo = WSP(float, WS_SWLO); float* swhi = WSP(float, WS_SWHI); float* srstd = WSP(float, WS_SRSTD);
        int* tilecls = WSP(int, WS_TILECLS);
        LAS int* tstart = (LAS int*)(L);
        LAS int* cntl = (LAS int*)(L + 1024);
        if (tid < NCLS) cntl[tid] = (int)__hip_atomic_load((unsigned*)(ctl + CW_CNT) + tid * 16, RLX_AGENT);
        __syncthreads();
        if (tid == 0) { int s = 0; for (int c = 0; c < NCLS; ++c) { tstart[c] = s; s += (cntl[c] + 255) >> 8; } tstart[128] = s; }
        __syncthreads();
        if (bx == 0) {
            if (tid < NCLS) { const int t0 = tstart[tid], nt = (cntl[tid] + 255) >> 8; for (int t = 0; t < nt; ++t) tilecls[t0 + t] = tid; }
            if (tid == 0) __hip_atomic_store((unsigned*)(ctl + CW_NTILES), (unsigned)tstart[128], RLX_AGENT);
        }
        for (int tok = bx * 512 + tid; tok < NTOK; tok += G * 512) {
            const int c = tcls[tok];
            const unsigned pos = atomicAdd((unsigned*)(ctl + CW_CUR) + c * 16, 1u);
            const int slot = tstart[c] * 256 + (int)pos;
            stok[slot] = tok; swlo[slot] = twlo[tok]; swhi[slot] = twhi[tok]; srstd[slot] = rstd2[tok];
        }
    }
    xcd_barrier(bar);

    if (PHASE_MASK & 128) {
        PH_BEGIN();
        LAS int* utab = (LAS int*)(L + UTAB_OFF); const int* tilecls = WSP(int, WS_TILECLS);
        const int ntiles = (int)__hip_atomic_load((unsigned*)(ctl + CW_NTILES), RLX_AGENT);
        if (tid < 16) { const int Lx = tid * G + vcu; const int tile = Lx >> 3, pn = Lx & 7; int e0 = 0, e1 = 0, tl = -1;
            if (tile < ntiles) { const int cls = tilecls[tile]; const int g = cls / 28; int rem = cls % 28, lo = 0; while (rem >= 7 - lo) { rem -= 7 - lo; ++lo; } e0 = g * 8 + lo; e1 = g * 8 + lo + 1 + rem; tl = tile; }
            utab[tid * 4 + 0] = tl; utab[tid * 4 + 1] = pn; utab[tid * 4 + 2] = e0; utab[tid * 4 + 3] = e1; }
        __syncthreads();
        gm::MoeSched S{utab, (const char*)WSP(bf16_t, WS_XG), (const char*)WSP(bf16_t, WS_WGU), WSP(int, WS_STOK), 1};
        gm::EpiMoe1 E{WSP(float, WS_SRSTD), WSP(float, WS_SWLO), WSP(float, WS_SWHI), WSP(bf16_t, WS_HDN)};
        gm::gemm_phase<gm::EpiMoe1, gm::MoeSched, gm::NT, true, false>(L, S, E, 1024, 1024);
    }
    xcd_barrier(bar);
    if (PHASE_MASK & 256) {
        PH_BEGIN();
        LAS int* utab = (LAS int*)(L + UTAB_OFF); const int* tilecls = WSP(int, WS_TILECLS);
        const int ntiles = (int)__hip_atomic_load((unsigned*)(ctl + CW_NTILES), RLX_AGENT);
        if (tid < 16) { const int Lx = tid * G + vcu; const int tile = Lx >> 2, pn = Lx & 3; int e0 = 0, e1 = 0, tl = -1;
            if (tile < ntiles) { const int cls = tilecls[tile]; const int g = cls / 28; int rem = cls % 28, lo = 0; while (rem >= 7 - lo) { rem -= 7 - lo; ++lo; } e0 = g * 8 + lo; e1 = g * 8 + lo + 1 + rem; tl = tile; }
            utab[tid * 4 + 0] = tl; utab[tid * 4 + 1] = pn; utab[tid * 4 + 2] = e0; utab[tid * 4 + 3] = e1; }
        __syncthreads();
        gm::MoeSched S{utab, (const char*)WSP(bf16_t, WS_HDN), (const char*)WSP(bf16_t, WS_WD), WSP(int, WS_STOK), 2};
        gm::EpiMoe2 E{WSP(int, WS_STOK), args.out};
        gm::gemm_phase<gm::EpiMoe2, gm::MoeSched, 8, false, false>(L, S, E, 1024, 16384);
    }
}

extern "C" void kernel_launch(void* const* d_in, const int* in_sizes, int n_in, void* d_out, int out_size, void* d_ws, size_t ws_size, hipStream_t stream) {
    static int grid = 0;
    if (grid == 0) {
        if (n_in != 23 || out_size != NTOK * DM || ws_size < WS_END) { fprintf(stderr, "kernel_launch: unexpected shapes (n_in %d, out %d, ws %zu)\n", n_in, out_size, ws_size); grid = -1; return; }
        int dev = 0, cus = 0;
        if (hipGetDevice(&dev) != hipSuccess || hipDeviceGetAttribute(&cus, hipDeviceAttributeMultiprocessorCount, dev) != hipSuccess) { grid = -1; return; }
        if (hipFuncSetAttribute((const void*)hybrid_fwd, hipFuncAttributeMaxDynamicSharedMemorySize, LDS_BYTES) != hipSuccess) { fprintf(stderr, "kernel_launch: hipFuncSetAttribute failed\n"); grid = -1; return; }
        int per_cu = 0;
        if (hipOccupancyMaxActiveBlocksPerMultiprocessor(&per_cu, (const void*)hybrid_fwd, NWAVES * 64, LDS_BYTES) != hipSuccess || per_cu < 1) fprintf(stderr, "kernel_launch: occupancy query says %d\n", per_cu);
        (void)hipGetLastError();
        grid = cus;
        if (grid != 256) fprintf(stderr, "kernel_launch: %d CUs (built for 256)\n", grid);
    }
    if (grid < 0) return;
    if (hipMemsetAsync((char*)d_ws + WS_CTL, 0, CTL_ZERO_BYTES, stream) != hipSuccess) return;
    Args a{};
    for (int i = 0; i < 23; ++i) a.in[i] = (const float*)d_in[i];
    a.out = (float*)d_out; a.ws = (unsigned char*)d_ws;
    hipLaunchKernelGGL(hybrid_fwd, dim3(grid), dim3(NWAVES * 64), LDS_BYTES, stream, a);
}
```

```cpp
#include <hip/hip_runtime.h>
#include <hip/hip_bf16.h>
#include <cstdio>
#include <cstdint>

#define LAS __attribute__((address_space(3)))
#define GAS __attribute__((address_space(1)))
typedef unsigned short bf16_t;
typedef short bf16x8 __attribute__((ext_vector_type(8)));
typedef short s16x4 __attribute__((ext_vector_type(4)));
typedef float f32x2 __attribute__((ext_vector_type(2)));
typedef float f32x4 __attribute__((ext_vector_type(4)));
typedef float f32x16 __attribute__((ext_vector_type(16)));
typedef unsigned u32x4 __attribute__((ext_vector_type(4)));
typedef unsigned u32x2 __attribute__((ext_vector_type(2)));
typedef GAS unsigned gu32;
#define RLX_AGENT __ATOMIC_RELAXED, __HIP_MEMORY_SCOPE_AGENT
#define LDS_WAIT() asm volatile("s_waitcnt lgkmcnt(0)" ::: "memory")
#define VM_WAIT() asm volatile("s_waitcnt vmcnt(0)" ::: "memory")

#ifndef PHASE_MASK
#define PHASE_MASK 0x1ff
#endif
#ifndef DUP_MASK
#define DUP_MASK 0
#endif
#ifdef TPROBE
#ifndef TP_AMP
#define TP_AMP 4
#endif
#ifndef TP_WAVE
#define TP_WAVE 0
#endif
__device__ __forceinline__ unsigned long long tp_now() { unsigned long long t; __builtin_amdgcn_sched_barrier(0); asm volatile("s_memrealtime %0\n\ts_waitcnt lgkmcnt(0)" : "=s"(t) :: "memory"); __builtin_amdgcn_sched_barrier(0); return t; }
#define TP_DECL() unsigned long long tp_t0 = 0, tp_acc = 0; (void)tp_t0
#define TP_PARAMS , unsigned long long& tp_t0, unsigned long long& tp_acc
#define TP_ARGS , tp_t0, tp_acc
#define TP_BEGIN(k) do { if ((k) == TPROBE) tp_t0 = tp_now(); } while (0)
#define TP_END(k) do { if ((k) == TPROBE) tp_acc += tp_now() - tp_t0; } while (0)
#define TP_FINISH() do { if (blockIdx.x == 0 && threadIdx.x == TP_WAVE * 64) { const unsigned long long s0 = tp_now(); while (tp_now() - s0 < tp_acc * TP_AMP) __builtin_amdgcn_s_sleep(8); } } while (0)
#else
#define TP_DECL()
#define TP_PARAMS
#define TP_ARGS
#define TP_BEGIN(k)
#define TP_END(k)
#define TP_FINISH()
#endif
#define REPS(bit) for (int rep_ = 0; rep_ < ((DUP_MASK & (bit)) ? 2 : 1); ++rep_)

constexpr int NTOK = 65536, DM = 1024, SEQ = 2048;
constexpr float LOG2E = 1.4426950408889634f;
constexpr float EPS = 1e-6f;
constexpr int NCLS = 112, MAXT = 368;
constexpr int NWAVES = 8;

constexpr size_t MiB = 1u << 20;
constexpr size_t WS_CTL = 0, CTL_ZERO_BYTES = 1 * MiB;
constexpr size_t WS_RSTD = 1 * MiB, WS_TCLS = WS_RSTD + 256 * 1024, WS_TWLO = WS_TCLS + 256 * 1024, WS_TWHI = WS_TWLO + 256 * 1024;
constexpr size_t WS_STOK = 2 * MiB, WS_SWLO = WS_STOK + 512 * 1024, WS_SWHI = WS_SWLO + 512 * 1024, WS_SRSTD = WS_SWHI + 512 * 1024;
constexpr size_t WS_TILECLS = 4 * MiB;
constexpr size_t WS_WRH = 5 * MiB, WS_WRL = WS_WRH + 128 * 1024;
constexpr size_t WS_WIN = 16 * MiB, WS_WM = 24 * MiB, WS_WO = 26 * MiB;
constexpr size_t WS_WGU = 32 * MiB, WS_WD = 96 * MiB;
constexpr size_t WS_H = 128 * MiB;
constexpr size_t WS_U = 256 * MiB, WS_Q = 320 * MiB, WS_K = 384 * MiB, WS_V = 448 * MiB;
constexpr size_t WS_GP = 512 * MiB, WS_GA = 640 * MiB;
constexpr size_t WS_DO = 768 * MiB;
constexpr size_t WS_END = 896 * MiB;
constexpr size_t WS_MERGED = WS_H, WS_X1 = WS_U, WS_HDN = WS_GP;
constexpr int CW_TMO = 0, CW_NTILES = 16, CW_BAR = 4096, CW_CNT = 8192, CW_CUR = 10240;

constexpr int RING_BYTES = 131072;
constexpr int LDSCTL_OFF = RING_BYTES, MISC_OFF = LDSCTL_OFF + 320, UTAB_OFF = LDSCTL_OFF + 1024;
constexpr int LDS_BYTES = 147456;

__device__ __forceinline__ unsigned f2bf(float f) { unsigned u = __builtin_bit_cast(unsigned, f); return (u + 0x7fffu + ((u >> 16) & 1u)) >> 16; }
__device__ __forceinline__ unsigned pk2(float lo, float hi) { return f2bf(lo) | (f2bf(hi) << 16); }
__device__ __forceinline__ float bf2f(unsigned short b) { return __builtin_bit_cast(float, (unsigned)b << 16); }
__device__ __forceinline__ float bflo(unsigned w) { return __builtin_bit_cast(float, w << 16); }
__device__ __forceinline__ float bfhi(unsigned w) { return __builtin_bit_cast(float, w & 0xffff0000u); }
__device__ __forceinline__ unsigned cvt_pk_bf16(float lo, float hi) { unsigned r; asm volatile("v_cvt_pk_bf16_f32 %0, %1, %2" : "=v"(r) : "v"(lo), "v"(hi)); return r; }

#define XB_TMO      128
#define XB_XCNT(j)  (256  + 64 * (j))
#define XB_XSUB(j)  (1280 + 64 * (j))
#define XB_XGEN(j)  (2304 + 64 * (j))
#define XB_TOP      3328
#define XB_TOPGEN   3392
#define XCD_BAR_WORDS 3456
#define XB_SPIN_CAP (1u << 18)
__device__ __forceinline__ unsigned xb_ld(unsigned* p)              { return __hip_atomic_load(p, __ATOMIC_RELAXED, __HIP_MEMORY_SCOPE_AGENT); }
__device__ __forceinline__ unsigned xb_add(unsigned* p, unsigned v) { return __hip_atomic_fetch_add(p, v, __ATOMIC_RELAXED, __HIP_MEMORY_SCOPE_AGENT); }
__device__ __forceinline__ unsigned xb_xcc_id() { return (unsigned)__builtin_amdgcn_s_getreg((3 << 11) | 20) & 0xFu; }
#define XB_SPIN(cond, bar) do { unsigned _sp = 0; while (cond) { __builtin_amdgcn_s_sleep(1); \
    if ((++_sp & 255u) == 0u) { if (xb_ld(&(bar)[XB_TMO])) break; if (_sp > XB_SPIN_CAP) { atomicAdd(&(bar)[XB_TMO], 1u); break; } } } } while (0)
struct XcdBarrier { unsigned* bar; unsigned x; volatile LAS unsigned* st; };
__device__ __forceinline__ XcdBarrier xcd_barrier_post(unsigned* bar, volatile LAS unsigned* st) {
    XcdBarrier b; b.bar = bar; b.x = xb_xcc_id(); b.st = st;
    if (threadIdx.x == 0) (void)xb_add(&bar[XB_XCNT(b.x)], 1u);
    return b;
}
__device__ __forceinline__ void xcd_barrier_complete(unsigned* bar, unsigned x, unsigned& nloc, unsigned& nx) {
    const unsigned G = gridDim.x * gridDim.y * gridDim.z;
    unsigned sum, cnt, mine, sp = 0u;
    for (;;) {
        sum = 0u; cnt = 0u; mine = 0u;
#pragma unroll
        for (unsigned j = 0; j < 16; ++j) { const unsigned c = xb_ld(&bar[XB_XCNT(j)]); sum += c; cnt += (c > 0u) ? 1u : 0u; mine = (j == x) ? c : mine; }
        if (sum == G) break;
        __builtin_amdgcn_s_sleep(1);
        if ((++sp & 255u) == 0u) { if (xb_ld(&bar[XB_TMO])) break; if (sp > XB_SPIN_CAP) { atomicAdd(&bar[XB_TMO], 1u); break; } }
    }
    nloc = mine > 0u ? mine : 1u; nx = cnt > 0u ? cnt : 1u;
}
__device__ __forceinline__ void xcd_barrier(const XcdBarrier& b) {
    asm volatile("s_waitcnt vmcnt(0)" ::: "memory");
    __syncthreads();
    if (threadIdx.x == 0) {
        unsigned* bar = b.bar;
        __builtin_amdgcn_s_waitcnt(0);
        unsigned nloc = b.st[0], nx = b.st[1];
        if (nloc == 0u) { xcd_barrier_complete(bar, b.x, nloc, nx); b.st[0] = nloc; b.st[1] = nx; }
        const unsigned old = xb_add(&bar[XB_XSUB(b.x)], 1u);
        const unsigned gen = old / nloc;
        if (old + 1u == (gen + 1u) * nloc) {
            __builtin_amdgcn_fence(__ATOMIC_RELEASE, "agent");
            asm volatile("s_waitcnt vmcnt(0)" ::: "memory");
            const unsigned og = xb_add(&bar[XB_TOP], 1u);
            const unsigned tg = og / nx;
            if (og + 1u == (tg + 1u) * nx) xb_add(&bar[XB_TOPGEN], 1u);
            else XB_SPIN(xb_ld(&bar[XB_TOPGEN]) == tg, bar);
            __builtin_amdgcn_fence(__ATOMIC_ACQUIRE, "agent");
            xb_add(&bar[XB_XGEN(b.x)], 1u);
            asm volatile("s_waitcnt vmcnt(0)" ::: "memory");
        } else {
            XB_SPIN(xb_ld(&bar[XB_XGEN(b.x)]) == gen, bar);
            __builtin_amdgcn_fence(__ATOMIC_ACQUIRE, "agent");
            asm volatile("s_waitcnt vmcnt(0)" ::: "memory");
        }
    }
    __syncthreads();
}

namespace gm {
constexpr int BM = 256, BK = 64, HALF = 128, HTB = HALF * BK * 2, NXCD = 8, WGM = 8, NT = 16;
__host__ __device__ __forceinline__ int lds_byte(int r, int c) { const int st = (r >> 4) * 2 + (c >> 5), rr = r & 15, cc = c & 31, ob = rr * 64 + cc * 2; return st * 1024 + (ob ^ (((ob >> 9) & 1) << 5)); }
__host__ __device__ __forceinline__ void stage_rc(int b, int& R, int& C) { const int st = b / 1024, sb = b % 1024, swz = sb ^ (((sb >> 9) & 1) << 5); R = (st >> 1) * 16 + swz / 64; C = (st & 1) * 32 + (swz % 64) / 2; }
__host__ __device__ __forceinline__ int perm32(int rho) { const int n = rho >> 4, i = rho & 15; return 8 * (i >> 2) + 4 * n + (i & 3); }

struct Unit { const char* a; const char* b0; const char* b1; int pm, pn, e0, e1; };

struct StaticOrder {
    const char* A; const char* Bt; int lda, ldb; int nM, nN, nwg, G, c;
    __device__ void init(const void* A_, const void* Bt_, int lda_, int ldb_, int M, int N, int G_, int c_) { A = (const char*)A_; Bt = (const char*)Bt_; lda = lda_; ldb = ldb_; nM = M / BM; nN = N / BM; nwg = nM * nN; G = G_; c = c_; }
    __device__ __forceinline__ bool next(int i, Unit& u) const {
        const long L = (long)i * G + c; if (L >= nwg) return false;
        int wgid = (int)L; { const int q = nwg / NXCD, r = nwg % NXCD, xcd = wgid % NXCD, off = wgid / NXCD; wgid = (xcd < r ? xcd * (q + 1) : r * (q + 1) + (xcd - r) * q) + off; }
        const int nig = WGM * nN, gid = wgid / nig, fm = gid * WGM, gsz = (nM - fm) < WGM ? (nM - fm) : WGM;
        u.pm = fm + ((wgid % nig) % gsz); u.pn = (wgid % nig) / gsz; u.e0 = 0; u.e1 = 0;
        u.a = A + (size_t)u.pm * BM * lda * 2; u.b0 = Bt + (size_t)u.pn * BM * ldb * 2; u.b1 = u.b0;
        return true;
    }
    __device__ __forceinline__ void offs(const Unit&, const int (&)[2], const int (&)[2], unsigned (&)[2][2]) const {}
};

template <class Epi, class Sched, int KS, bool GATHER, bool MID>
__device__ __forceinline__ void gemm_phase(LAS unsigned char* lds, const Sched& S, const Epi& E, const int lda, const int ldb) {
    int tid = threadIdx.x; asm volatile("" : "+v"(tid));
    const int wid = __builtin_amdgcn_readfirstlane(tid >> 6), lane = tid & 63, wr = wid >> 2, wc = wid & 3, fr = lane & 15, fq = lane >> 4;
    int Rr[2], Cc[2]; unsigned offA[2][2], offAn[2][2], voffB[2];
#pragma unroll
    for (int i = 0; i < 2; ++i) { int R, C; stage_rc(tid * 16 + i * 8192, R, C); Rr[i] = R; Cc[i] = C; const int Rb = Epi::PERM ? ((R & ~31) + perm32(R & 31)) : R;
        voffB[i] = (unsigned)(Rb * ldb + C) * 2u;
        offA[0][i] = (unsigned)(R * lda + C) * 2u; offA[1][i] = (unsigned)((R + HALF) * lda + C) * 2u; offAn[0][i] = offA[0][i]; offAn[1][i] = offA[1][i]; }
    const size_t kstep = (size_t)(BK * 2);
    const size_t hstepB = (size_t)HALF * ldb * 2;
    const unsigned ldsw = (unsigned)wid * 1024u;
    const int aoff = lds_byte(wr * 64 + fr, fq * 8), boff = lds_byte(wc * 32 + fr, fq * 8);
#define G_SA(b, h) (((b) * 2 + (h)) * HTB)
#define G_SB(b, h) ((4 + (b) * 2 + (h)) * HTB)
#define G_STAGE_A(bufoff, gbase, OFF, h) do { _Pragma("unroll") for (int _i = 0; _i < 2; ++_i) \
        __builtin_amdgcn_global_load_lds((const unsigned*)((const char*)(gbase) + (OFF)[h][_i]), (LAS unsigned*)(lds + (bufoff) + ldsw + _i * 8192), 16, 0, 0); } while (0)
#define G_STAGE_B(bufoff, gbase) do { _Pragma("unroll") for (int _i = 0; _i < 2; ++_i) \
        __builtin_amdgcn_global_load_lds((const unsigned*)((const char*)(gbase) + voffB[_i]), (LAS unsigned*)(lds + (bufoff) + ldsw + _i * 8192), 16, 0, 0); } while (0)
#define G_LDA(dst, b, h) do { _Pragma("unroll") for (int m = 0; m < 4; ++m) _Pragma("unroll") for (int k = 0; k < 2; ++k) dst[m][k] = *(const LAS bf16x8*)(lds + G_SA(b, h) + aoff + m * 2048 + k * 1024); } while (0)
#define G_LDB(dst, b, h) do { _Pragma("unroll") for (int n = 0; n < 2; ++n) _Pragma("unroll") for (int k = 0; k < 2; ++k) dst[n][k] = *(const LAS bf16x8*)(lds + G_SB(b, h) + boff + n * 2048 + k * 1024); } while (0)
#define G_MMA(ai, bj, At, Bt) do { __builtin_amdgcn_s_setprio(1); _Pragma("unroll") for (int m = 0; m < 4; ++m) _Pragma("unroll") for (int n = 0; n < 2; ++n) _Pragma("unroll") for (int k = 0; k < 2; ++k) \
        acc[ai][bj][m][n] = __builtin_amdgcn_mfma_f32_16x16x32_bf16(Bt[n][k], At[m][k], acc[ai][bj][m][n], 0, 0, 0); __builtin_amdgcn_s_setprio(0); } while (0)
#define G_WAIT_V(n) asm volatile("s_waitcnt vmcnt(" #n ")" ::: "memory")
#define G_WAIT_L(n) asm volatile("s_waitcnt lgkmcnt(" #n ")" ::: "memory")
#define G_BAR __builtin_amdgcn_s_barrier()
#define G_SCHED __builtin_amdgcn_sched_barrier(0)
#define G_BP(u, t) ((t) < KS ? (u).b0 + (size_t)(t) * kstep : (u).b1 + (size_t)((t) - KS) * kstep)
    Unit cur, nxt; int ui = 0;
    if (!S.next(0, cur)) return;
    if constexpr (GATHER) S.offs(cur, Rr, Cc, offA);
    f32x4 acc[2][2][4][2];
#pragma unroll
    for (int a = 0; a < 2; ++a)
#pragma unroll
        for (int b = 0; b < 2; ++b)
#pragma unroll
            for (int m = 0; m < 4; ++m)
#pragma unroll
                for (int n = 0; n < 2; ++n) acc[a][b][m][n] = (f32x4){0.f, 0.f, 0.f, 0.f};
    bf16x8 At[4][2], B0[2][2], B1[2][2];
    {
        const char* cA = cur.a; const char* cB = cur.b0; const char* cB1 = G_BP(cur, 1);
        G_STAGE_B(G_SB(0, 0), cB); G_STAGE_B(G_SB(0, 1), cB + hstepB); G_STAGE_A(G_SA(0, 0), cA, offA, 0); G_STAGE_A(G_SA(0, 1), cA, offA, 1);
        if (wr == 1) G_BAR;
        G_WAIT_V(2); G_BAR;
        G_STAGE_B(G_SB(1, 0), cB1); G_STAGE_A(G_SA(1, 0), cA + kstep, offA, 0); G_STAGE_B(G_SB(1, 1), cB1 + hstepB);
        G_WAIT_V(6); G_BAR;
    }
    for (;;) {
        const bool has_next = S.next(ui + 1, nxt);
        for (int t = 0; t < NT; t += 2) {
            const bool last = (t == NT - 2);
            if constexpr (MID) { if (t == NT / 2) E.mid(acc, cur, wr, wc, fr, fq); }
            if constexpr (GATHER) { if (t == NT - 4 && has_next) S.offs(nxt, Rr, Cc, offAn); }
            const char* a1 = cur.a + (size_t)(t + 1) * kstep;
            const bool sw = last && has_next;
            const int t2 = last ? 0 : t + 2;
            const char* ua = sw ? nxt.a : cur.a; const char* ub0 = sw ? nxt.b0 : cur.b0; const char* ub1 = sw ? nxt.b1 : cur.b1;
            const char* a2 = ua + (size_t)t2 * kstep; const char* a3 = a2 + kstep;
            const char* b2 = (t2 < KS) ? ub0 + (size_t)t2 * kstep : ub1 + (size_t)(t2 - KS) * kstep;
            const char* b3 = (t2 + 1 < KS) ? ub0 + (size_t)(t2 + 1) * kstep : ub1 + (size_t)(t2 + 1 - KS) * kstep;
            G_LDB(B0, 0, 0); G_LDB(B1, 0, 1); G_SCHED; G_LDA(At, 0, 0); G_STAGE_A(G_SA(1, 1), a1, offA, 1);
            G_WAIT_V(8); G_WAIT_L(0); G_BAR; G_MMA(0, 0, At, B0); G_MMA(0, 1, At, B1); G_BAR; G_SCHED;
            if constexpr (GATHER) { if (sw) {
#pragma unroll
                for (int h = 0; h < 2; ++h)
#pragma unroll
                    for (int i = 0; i < 2; ++i) offA[h][i] = offAn[h][i]; } }
            G_LDA(At, 0, 1); G_STAGE_B(G_SB(0, 0), b2); G_STAGE_B(G_SB(0, 1), b2 + hstepB); G_STAGE_A(G_SA(0, 0), a2, offA, 0);
            G_WAIT_V(8); G_WAIT_L(0); G_BAR; G_MMA(1, 0, At, B0); G_MMA(1, 1, At, B1); G_BAR; G_SCHED;
            G_LDB(B0, 1, 0); G_LDB(B1, 1, 1); G_SCHED; G_LDA(At, 1, 0); G_STAGE_A(G_SA(0, 1), a2, offA, 1);
            G_WAIT_V(8); G_WAIT_L(0); G_BAR; G_MMA(0, 0, At, B0); G_MMA(0, 1, At, B1); G_BAR; G_SCHED;
            G_LDA(At, 1, 1); G_STAGE_B(G_SB(1, 0), b3); G_STAGE_B(G_SB(1, 1), b3 + hstepB); G_STAGE_A(G_SA(1, 0), a3, offA, 0);
            G_WAIT_V(8); G_WAIT_L(0); G_BAR; G_MMA(1, 0, At, B0); G_MMA(1, 1, At, B1); G_BAR; G_SCHED;
        }
        if (wr == 0) G_BAR;
        E(acc, cur, wr, wc, fr, fq);
        if (!has_next) break;
#pragma unroll
        for (int a = 0; a < 2; ++a)
#pragma unroll
            for (int b = 0; b < 2; ++b)
#pragma unroll
                for (int m = 0; m < 4; ++m)
#pragma unroll
                    for (int n = 0; n < 2; ++n) acc[a][b][m][n] = (f32x4){0.f, 0.f, 0.f, 0.f};
        cur = nxt; ++ui;
        if (wr == 1) G_BAR;
    }
    G_WAIT_V(0);
    G_BAR;
#undef G_SA
#undef G_SB
#undef G_STAGE_A
#undef G_STAGE_B
#undef G_LDA
#undef G_LDB
#undef G_MMA
#undef G_WAIT_V
#undef G_WAIT_L
#undef G_BAR
#undef G_SCHED
#undef G_BP
}

__device__ __forceinline__ void st8(bf16_t* p, f32x4 v0, f32x4 v1) { u32x4 w; w.x = cvt_pk_bf16(v0[0], v0[1]); w.y = cvt_pk_bf16(v0[2], v0[3]); w.z = cvt_pk_bf16(v1[0], v1[1]); w.w = cvt_pk_bf16(v1[2], v1[3]); *(u32x4*)p = w; }
__device__ __forceinline__ float sigm(float z) { return __builtin_amdgcn_rcpf(1.0f + __builtin_amdgcn_exp2f(-z * LOG2E)); }

struct EpiProj {
    static constexpr bool PERM = true;
    bf16_t *U, *Q, *K, *V, *GP, *GA; const float *gq, *gk;
    __device__ __forceinline__ void mid(f32x4 (&)[2][2][4][2], const Unit&, int, int, int, int) const {}
    __device__ __forceinline__ void operator()(const f32x4 (&acc)[2][2][4][2], const Unit& u, int wr, int wc, int fr, int fq) const {
        const int pn = u.pn; const int row0 = u.pm * BM + wr * 64 + fr;
        if (pn < 2) {
            const int col0 = (pn & 1) * 256 + wc * 32 + 8 * fq;
#pragma unroll
            for (int ai = 0; ai < 2; ++ai)
#pragma unroll
                for (int m = 0; m < 4; ++m) { bf16_t* rowp = U + (size_t)(row0 + ai * HALF + m * 16) * 512 + col0;
#pragma unroll
                    for (int bj = 0; bj < 2; ++bj) st8(rowp + bj * HALF, acc[ai][bj][m][0], acc[ai][bj][m][1]); }
        } else if (pn == 6 || pn == 7) {
#pragma unroll
            for (int ai = 0; ai < 2; ++ai)
#pragma unroll
                for (int m = 0; m < 4; ++m) { const int row = row0 + ai * HALF + m * 16, b = row >> 11, t = row & 2047;
#pragma unroll
                    for (int bj = 0; bj < 2; ++bj) { const int bh = b * 4 + 2 * (pn - 6) + bj;
                        st8(V + ((((size_t)bh * 32 + (t >> 6)) * 16 + (wc * 4 + ((t >> 4) & 3))) * 16 + (t & 15)) * 32 + 8 * fq, acc[ai][bj][m][0], acc[ai][bj][m][1]); } }
        } else if (pn < 6) {
            const bool isq = pn < 4; bf16_t* base = isq ? Q : K; const float* g = isq ? gq : gk; const float sc = isq ? (0.125f * LOG2E) : 1.0f;
            f32x4 gv[2][2];
#pragma unroll
            for (int bj = 0; bj < 2; ++bj) { gv[bj][0] = *(const f32x4*)(g + 32 * bj + 8 * fq); gv[bj][1] = *(const f32x4*)(g + 32 * bj + 8 * fq + 4); }
            const int col0 = (pn & 1) * 256 + 64 * wc + 8 * fq;
#pragma unroll
            for (int ai = 0; ai < 2; ++ai)
#pragma unroll
                for (int m = 0; m < 4; ++m) {
                    float ss = 0.f;
#pragma unroll
                    for (int bj = 0; bj < 2; ++bj)
#pragma unroll
                        for (int n = 0; n < 2; ++n) { const f32x4 x = acc[ai][bj][m][n]; ss += (x[0] * x[0] + x[1] * x[1]) + (x[2] * x[2] + x[3] * x[3]); }
                    ss += __shfl_xor(ss, 16); ss += __shfl_xor(ss, 32);
                    const float rinv = __builtin_amdgcn_rsqf(ss * (1.0f / 64.0f) + EPS) * sc;
                    const int row = row0 + ai * HALF + m * 16;
                    if (isq) { bf16_t* rowp = base + (size_t)row * 512 + col0;
#pragma unroll
                        for (int bj = 0; bj < 2; ++bj) st8(rowp + 32 * bj, acc[ai][bj][m][0] * rinv * gv[bj][0], acc[ai][bj][m][1] * rinv * gv[bj][1]);
                    } else {
                        const int b = row >> 11, t = row & 2047, sh = (pn - 4) * 4 + wc, bh = b * 4 + (sh >> 1), mm = sh & 1;
#pragma unroll
                        for (int bj = 0; bj < 2; ++bj) st8(base + (((((size_t)bh * 2 + mm) * 32 + (t >> 6)) * 8 + (4 * bj + fq)) * 64 + (t & 63)) * 8, acc[ai][bj][m][0] * rinv * gv[bj][0], acc[ai][bj][m][1] * rinv * gv[bj][1]);
                    }
                }
        } else {
            bf16_t* base = (pn < 12) ? GP : GA; const int col0 = ((pn - 8) & 3) * 256 + wc * 32 + 8 * fq;
#pragma unroll
            for (int ai = 0; ai < 2; ++ai)
#pragma unroll
                for (int m = 0; m < 4; ++m) { bf16_t* rowp = base + (size_t)(row0 + ai * HALF + m * 16) * 1024 + col0;
#pragma unroll
                    for (int bj = 0; bj < 2; ++bj) { f32x4 v0 = acc[ai][bj][m][0], v1 = acc[ai][bj][m][1];
#pragma unroll
                        for (int i = 0; i < 4; ++i) { v0[i] = sigm(v0[i]); v1[i] = sigm(v1[i]); }
                        st8(rowp + bj * HALF, v0, v1); } }
        }
    }
};

struct EpiMerge {
    static constexpr bool PERM = true;
    const bf16_t *GP, *GA; bf16_t* O;
    __device__ __forceinline__ void mid(f32x4 (&acc)[2][2][4][2], const Unit& u, int wr, int wc, int fr, int fq) const {
        int row0 = u.pm * BM + wr * 64 + fr; const int col0 = u.pn * BM + wc * 32 + 8 * fq;
        asm volatile("" : "+v"(row0));
#pragma unroll
        for (int ai = 0; ai < 2; ++ai)
#pragma unroll
            for (int m = 0; m < 4; ++m) { const size_t off = (size_t)(row0 + ai * HALF + m * 16) * 1024 + col0;
#pragma unroll
                for (int bj = 0; bj < 2; ++bj) { const u32x4 p = *(const u32x4*)(GP + off + bj * HALF), a = *(const u32x4*)(GA + off + bj * HALF);
                    f32x4 r0, r1;
                    r0[0] = bflo(p.x) * __builtin_amdgcn_rcpf(bflo(a.x)); r0[1] = bfhi(p.x) * __builtin_amdgcn_rcpf(bfhi(a.x)); r0[2] = bflo(p.y) * __builtin_amdgcn_rcpf(bflo(a.y)); r0[3] = bfhi(p.y) * __builtin_amdgcn_rcpf(bfhi(a.y));
                    r1[0] = bflo(p.z) * __builtin_amdgcn_rcpf(bflo(a.z)); r1[1] = bfhi(p.z) * __builtin_amdgcn_rcpf(bfhi(a.z)); r1[2] = bflo(p.w) * __builtin_amdgcn_rcpf(bflo(a.w)); r1[3] = bfhi(p.w) * __builtin_amdgcn_rcpf(bfhi(a.w));
                    acc[ai][bj][m][0] *= r0; acc[ai][bj][m][1] *= r1; }
                asm volatile("" ::: "memory"); }
    }
    __device__ __forceinline__ void operator()(const f32x4 (&acc)[2][2][4][2], const Unit& u, int wr, int wc, int fr, int fq) const {
        const int row0 = u.pm * BM + wr * 64 + fr, col0 = u.pn * BM + wc * 32 + 8 * fq;
#pragma unroll
        for (int ai = 0; ai < 2; ++ai)
#pragma unroll
            for (int m = 0; m < 4; ++m) { const size_t off = (size_t)(row0 + ai * HALF + m * 16) * 1024 + col0;
#pragma unroll
                for (int bj = 0; bj < 2; ++bj) { const u32x4 a = *(const u32x4*)(GA + off + bj * HALF);
                    const f32x4 g0 = {bflo(a.x), bfhi(a.x), bflo(a.y), bfhi(a.y)}, g1 = {bflo(a.z), bfhi(a.z), bflo(a.w), bfhi(a.w)};
                    st8(O + off + bj * HALF, acc[ai][bj][m][0] * g0, acc[ai][bj][m][1] * g1); } }
    }
};

struct EpiRes {
    static constexpr bool PERM = true;
    const float* X; bf16_t* O;
    __device__ __forceinline__ void mid(f32x4 (&)[2][2][4][2], const Unit&, int, int, int, int) const {}
    __device__ __forceinline__ void operator()(const f32x4 (&acc)[2][2][4][2], const Unit& u, int wr, int wc, int fr, int fq) const {
        const int row0 = u.pm * BM + wr * 64 + fr, col0 = u.pn * BM + wc * 32 + 8 * fq;
#pragma unroll
        for (int ai = 0; ai < 2; ++ai)
#pragma unroll
            for (int m = 0; m < 4; ++m) { const size_t off = (size_t)(row0 + ai * HALF + m * 16) * 1024 + col0;
#pragma unroll
                for (int bj = 0; bj < 2; ++bj) { const f32x4 x0 = *(const f32x4*)(X + off + bj * HALF), x1 = *(const f32x4*)(X + off + bj * HALF + 4);
                    st8(O + off + bj * HALF, x0 + acc[ai][bj][m][0], x1 + acc[ai][bj][m][1]); } }
    }
};

struct EpiMoe1 {
    static constexpr bool PERM = true;
    const float *SR, *SWLO, *SWHI; bf16_t* HDN;
    __device__ __forceinline__ void mid(f32x4 (&)[2][2][4][2], const Unit&, int, int, int, int) const {}
    __device__ __forceinline__ void operator()(const f32x4 (&acc)[2][2][4][2], const Unit& u, int wr, int wc, int fr, int fq) const {
        const int slot0 = u.pm * BM + wr * 64 + fr; const float* SW = (u.pn < 4) ? SWLO : SWHI;
        const int col0 = (u.pn >> 2) * 512 + (u.pn & 3) * 128 + wc * 32 + 8 * fq;
#pragma unroll
        for (int ai = 0; ai < 2; ++ai)
#pragma unroll
            for (int m = 0; m < 4; ++m) { const int slot = slot0 + ai * HALF + m * 16; const float rs = SR[slot], w = SW[slot];
                f32x4 h0, h1;
#pragma unroll
                for (int i = 0; i < 4; ++i) { const float g0 = acc[ai][0][m][0][i] * rs, u0 = acc[ai][1][m][0][i] * rs, g1 = acc[ai][0][m][1][i] * rs, u1 = acc[ai][1][m][1][i] * rs;
                    h0[i] = g0 * sigm(g0) * u0 * w; h1[i] = g1 * sigm(g1) * u1 * w; }
                st8(HDN + (size_t)slot * 1024 + col0, h0, h1); }
    }
};

struct EpiMoe2 {
    static constexpr bool PERM = true;
    const int* STOK; const bf16_t* X1; float* O;
    __device__ __forceinline__ void mid(f32x4 (&)[2][2][4][2], const Unit&, int, int, int, int) const {}
    __device__ __forceinline__ void operator()(const f32x4 (&acc)[2][2][4][2], const Unit& u, int wr, int wc, int fr, int fq) const {
        const int slot0 = u.pm * BM + wr * 64 + fr, col0 = u.pn * BM + wc * 32 + 8 * fq;
#pragma unroll
        for (int ai = 0; ai < 2; ++ai)
#pragma unroll
            for (int m = 0; m < 4; ++m) { const int tok = STOK[slot0 + ai * HALF + m * 16];
                if (tok >= 0) { const size_t off = (size_t)tok * 1024 + col0;
#pragma unroll
                    for (int bj = 0; bj < 2; ++bj) { const u32x4 xv = *(const u32x4*)(X1 + off + bj * HALF);
                        const f32x4 x0 = {bflo(xv.x), bfhi(xv.x), bflo(xv.y), bfhi(xv.y)}, x1 = {bflo(xv.z), bfhi(xv.z), bflo(xv.w), bfhi(xv.w)};
                        *(f32x4*)(O + off + bj * HALF) = x0 + acc[ai][bj][m][0]; *(f32x4*)(O + off + bj * HALF + 4) = x1 + acc[ai][bj][m][1]; } } }
    }
};

struct MoeSched {
    const LAS int* tab; const char* A; const char* B; const int* STOK; int mode;
    __device__ __forceinline__ bool next(int i, Unit& u) const {
        if (i >= 16) return false;
        const int tile = __builtin_amdgcn_readfirstlane(tab[i * 4 + 0]); if (tile < 0) return false;
        const int pn = __builtin_amdgcn_readfirstlane(tab[i * 4 + 1]), e0 = __builtin_amdgcn_readfirstlane(tab[i * 4 + 2]), e1 = __builtin_amdgcn_readfirstlane(tab[i * 4 + 3]);
        u.pm = tile; u.pn = pn; u.e0 = e0; u.e1 = e1;
        if (mode == 1) { const int e = (pn < 4) ? e0 : e1; u.a = A; u.b0 = B + ((size_t)e * 1024 * 1024 + (size_t)(pn & 3) * 256 * 1024) * 2; u.b1 = u.b0; }
        else { u.a = A + (size_t)tile * 256 * 1024 * 2; u.b0 = B + ((size_t)pn * 256 * 16384 + (size_t)e0 * 512) * 2; u.b1 = B + ((size_t)pn * 256 * 16384 + (size_t)e1 * 512) * 2; }
        return true;
    }
    __device__ __forceinline__ void offs(const Unit& u, const int (&Rr)[2], const int (&Cc)[2], unsigned (&off)[2][2]) const {
#pragma unroll
        for (int h = 0; h < 2; ++h)
#pragma unroll
            for (int i = 0; i < 2; ++i) { int tok = STOK[u.pm * 256 + h * 128 + Rr[i]]; tok = tok < 0 ? 0 : tok; off[h][i] = ((unsigned)tok * 1024u + (unsigned)Cc[i]) * 2u; }
    }
};
}

namespace att {
__device__ __forceinline__ int crow(int r, int hi) { return (r & 3) + 8 * (r >> 2) + 4 * hi; }
__device__ __forceinline__ void glds16(const void* gsrc, unsigned lds_dst) { unsigned keep;
    asm volatile("s_mov_b32 %0, m0\n\ts_mov_b32 m0, %2\n\ts_nop 0\n\tglobal_load_lds_dwordx4 %1, off\n\ts_mov_b32 m0, %0" : "=&s"(keep) : "v"(gsrc), "s"(lds_dst) : "memory"); }
#define ATT_WAIT_BAR() asm volatile("s_waitcnt vmcnt(0) lgkmcnt(0)\n\ts_barrier" ::: "memory")
constexpr int SLOT = 32768;
constexpr int WSF_OFF = LDSCTL_OFF + 2048;
constexpr int XCH_OFF = 0;

__device__ __forceinline__ void attn_unit(int b, int h, int qb, const bf16_t* Q, const bf16_t* K, const bf16_t* V, bf16_t* DO, char* shm, float B2, float lam, const float* subg TP_PARAMS) {
    TP_BEGIN(25);
    const int tid = threadIdx.x, lane = tid & 63, r32 = lane & 31, hi = lane >> 5; const int wid = __builtin_amdgcn_readfirstlane(tid >> 6);
    const int mm = wid >> 2, wq = wid & 3;
    const long rowbase = (long)b * SEQ; const int q0 = qb * 128, i0 = q0 + wq * 32;
    const float aslope = LOG2E * __builtin_amdgcn_exp2f(-2.0f * (float)(h + 1));
    const unsigned lds0 = (unsigned)(uintptr_t)shm;
    float* wsf = (float*)(shm + WSF_OFF) + wid * 64;
    const bf16_t* Qw = Q + (rowbase + i0 + r32) * 512 + h * 128 + mm * 64 + hi * 8;
    bf16x8 qr[4];
#pragma unroll
    for (int ks = 0; ks < 4; ++ks) qr[ks] = *(const bf16x8*)(Qw + ks * 16);
    const int bh = b * 4 + h;
    const bf16_t* ksrc0 = K + (((size_t)bh * 2 + 0) * 32 * 8 + wid) * 512 + lane * 8;
    const bf16_t* ksrc1 = K + (((size_t)bh * 2 + 1) * 32 * 8 + wid) * 512 + lane * 8;
    const int p0i = 2 * wid, p1i = 2 * wid + 1;
    const bf16_t* vsrc0 = V + ((size_t)bh * 32 * 16 + p0i) * 512 + lane * 8;
    const bf16_t* vsrc1 = vsrc0 + 512;
    const int NTL = 2 * qb + 2;
#define ATT_DMA(t, slot) do { const unsigned _s = lds0 + (unsigned)(slot) * SLOT; \
        glds16(ksrc0 + (size_t)(t) * 4096, (unsigned)__builtin_amdgcn_readfirstlane(_s + wid * 1024)); glds16(ksrc1 + (size_t)(t) * 4096, (unsigned)__builtin_amdgcn_readfirstlane(_s + 8192 + wid * 1024)); \
        glds16(vsrc0 + (size_t)(t) * 8192, (unsigned)__builtin_amdgcn_readfirstlane(_s + 16384 + p0i * 1024)); glds16(vsrc1 + (size_t)(t) * 8192, (unsigned)__builtin_amdgcn_readfirstlane(_s + 16384 + p1i * 1024)); } while (0)
    ATT_DMA(0, 0); ATT_DMA(1, 1);
    f32x16 o[4]; o[0] = f32x16{}; o[1] = f32x16{}; o[2] = f32x16{}; o[3] = f32x16{};
    float l_reg = 0.f;
    const int irow = i0 + r32;
    __builtin_amdgcn_s_waitcnt(0x0F70);
    TP_END(25);
    const int vlane = ((lane >> 4) & 1) * 32 + (lane & 3) * 8 + (4 * hi + ((lane & 15) >> 2)) * 64;
    u32x4 pw[4]; pw[0] = (u32x4){0u, 0u, 0u, 0u}; pw[1] = pw[0]; pw[2] = pw[0]; pw[3] = pw[0];
    bool have_prev = false;
#define ATT_PV(SL) do { const int vb = (int)(lds0 + (SL) * SLOT + 16384) + vlane; \
        _Pragma("unroll") for (int d0 = 0; d0 < 4; ++d0) { s16x4 lo[4], hh[4]; \
            _Pragma("unroll") for (int ks = 0; ks < 4; ++ks) { \
                asm volatile("ds_read_b64_tr_b16 %0,%1 offset:%c2" : "=&v"(lo[ks]) : "v"(vb), "i"(d0 * 4096 + ks * 1024) : "memory"); \
                asm volatile("ds_read_b64_tr_b16 %0,%1 offset:%c2" : "=&v"(hh[ks]) : "v"(vb), "i"(d0 * 4096 + ks * 1024 + 512) : "memory"); } \
            asm volatile("s_waitcnt lgkmcnt(0)" ::: "memory"); __builtin_amdgcn_sched_barrier(0); \
            _Pragma("unroll") for (int ks = 0; ks < 4; ++ks) { const bf16x8 vf = (bf16x8){lo[ks][0], lo[ks][1], lo[ks][2], lo[ks][3], hh[ks][0], hh[ks][1], hh[ks][2], hh[ks][3]}; \
                o[d0] = __builtin_amdgcn_mfma_f32_32x32x16_bf16(__builtin_bit_cast(bf16x8, pw[ks]), vf, o[d0], 0, 0, 0); } \
        } } while (0)
#define ATT_TILE(MASKED) do { \
        TP_BEGIN(21); \
        if (t + 1 < NTL) asm volatile("s_waitcnt vmcnt(4) lgkmcnt(0)\n\ts_barrier" ::: "memory"); else ATT_WAIT_BAR(); \
        TP_END(21); TP_BEGIN(22); \
        if (t + 2 < NTL) ATT_DMA(t + 2, (t + 2) & 3); \
        TP_END(22); TP_BEGIN(24); \
        if (mm == 1 && have_prev) ATT_PV((t - 1) & 3); \
        TP_END(24); TP_BEGIN(23); \
        const int j0 = 64 * t; \
        have_prev = (!(MASKED) || j0 <= i0 + 31); \
        if (have_prev) { \
            const char* kb = shm + (t & 3) * SLOT + mm * 8192 + hi * 1024 + r32 * 16; \
            f32x16 p0 = f32x16{}, p1 = f32x16{}; \
            _Pragma("unroll") for (int d0 = 0; d0 < 4; ++d0) { \
                const bf16x8 b0 = *(const bf16x8*)(kb + d0 * 2048), b1 = *(const bf16x8*)(kb + d0 * 2048 + 512); \
                p0 = __builtin_amdgcn_mfma_f32_32x32x16_bf16(b0, qr[d0], p0, 0, 0, 0); p1 = __builtin_amdgcn_mfma_f32_32x32x16_bf16(b1, qr[d0], p1, 0, 0, 0); } \
            const float base = aslope * (float)(j0 + 4 * hi - irow) - B2; \
            _Pragma("unroll") for (int r = 0; r < 16; ++r) { const int kk = (r & 3) + 8 * (r >> 2); p0[r] += base + aslope * (float)kk; p1[r] += base + aslope * (float)(kk + 32); } \
            if (MASKED) { const int jb = j0 + 4 * hi; \
                _Pragma("unroll") for (int r = 0; r < 16; ++r) { const int j = jb + (r & 3) + 8 * (r >> 2); if (j > irow) p0[r] = -1.0e30f; if (j + 32 > irow) p1[r] = -1.0e30f; } } \
            float sacc = 0.f; \
            _Pragma("unroll") for (int r = 0; r < 16; ++r) { p0[r] = __builtin_amdgcn_exp2f(p0[r]); p1[r] = __builtin_amdgcn_exp2f(p1[r]); sacc += p0[r] + p1[r]; } \
            l_reg += sacc; \
            pw[0] = (u32x4){cvt_pk_bf16(p0[0], p0[1]), cvt_pk_bf16(p0[2], p0[3]), cvt_pk_bf16(p0[4], p0[5]), cvt_pk_bf16(p0[6], p0[7])}; \
            pw[1] = (u32x4){cvt_pk_bf16(p0[8], p0[9]), cvt_pk_bf16(p0[10], p0[11]), cvt_pk_bf16(p0[12], p0[13]), cvt_pk_bf16(p0[14], p0[15])}; \
            pw[2] = (u32x4){cvt_pk_bf16(p1[0], p1[1]), cvt_pk_bf16(p1[2], p1[3]), cvt_pk_bf16(p1[4], p1[5]), cvt_pk_bf16(p1[6], p1[7])}; \
            pw[3] = (u32x4){cvt_pk_bf16(p1[8], p1[9]), cvt_pk_bf16(p1[10], p1[11]), cvt_pk_bf16(p1[12], p1[13]), cvt_pk_bf16(p1[14], p1[15])}; \
            TP_END(23); TP_BEGIN(24); \
            if (mm == 0) ATT_PV(t & 3); \
            TP_END(24); TP_BEGIN(23); \
        } TP_END(23); } while (0)
    int t = 0;
    for (; t < NTL - 2; ++t) ATT_TILE(false);
    for (; t < NTL; ++t) ATT_TILE(true);
    if (mm == 1 && have_prev) ATT_PV((NTL - 1) & 3);
    TP_BEGIN(26);
#undef ATT_TILE
#undef ATT_PV
    { auto rr = __builtin_amdgcn_permlane32_swap(__float_as_uint(l_reg), __float_as_uint(l_reg), false, false); l_reg = __uint_as_float(rr[0]) + __uint_as_float(rr[1]); }
    if (hi == 0) wsf[r32] = l_reg;
    asm volatile("s_waitcnt lgkmcnt(0)" ::: "memory");
    const float fac = (mm == 0) ? 1.0f : lam;
#pragma unroll
    for (int r = 0; r < 16; ++r) { const float rl = fac * __builtin_amdgcn_rcpf(wsf[crow(r, hi)]);
#pragma unroll
        for (int d0 = 0; d0 < 4; ++d0) o[d0][r] *= rl; }
    ATT_WAIT_BAR();
    float* xch = (float*)(shm + XCH_OFF) + (size_t)wq * 32 * 128;
    if (mm == 1) {
#pragma unroll
        for (int r = 0; r < 16; ++r)
#pragma unroll
            for (int d0 = 0; d0 < 4; ++d0) xch[crow(r, hi) * 128 + 32 * d0 + r32] = o[d0][r];
    }
    ATT_WAIT_BAR();
    if (mm == 0) {
        float gsub[4];
#pragma unroll
        for (int d0 = 0; d0 < 4; ++d0) gsub[d0] = subg[32 * d0 + r32] * 0.8f;
#pragma unroll
        for (int r = 0; r < 16; ++r) {
            float ss = 0.f;
#pragma unroll
            for (int d0 = 0; d0 < 4; ++d0) { o[d0][r] -= xch[crow(r, hi) * 128 + 32 * d0 + r32]; ss += o[d0][r] * o[d0][r]; }
            ss += __shfl_xor(ss, 1); ss += __shfl_xor(ss, 2); ss += __shfl_xor(ss, 4); ss += __shfl_xor(ss, 8); ss += __shfl_xor(ss, 16);
            const float rinv = __builtin_amdgcn_rsqf(ss * (1.0f / 128.0f) + EPS);
            bf16_t* orow = DO + (size_t)(rowbase + i0 + crow(r, hi)) * 1024 + 512 + h * 128 + r32;
#pragma unroll
            for (int d0 = 0; d0 < 4; ++d0) orow[32 * d0] = (bf16_t)f2bf(o[d0][r] * rinv * gsub[d0]);
        }
    }
    ATT_WAIT_BAR();
    TP_END(26);
#undef ATT_DMA
}
}

struct Args { const float* in[23]; float* out; unsigned char* ws; };

__device__ __forceinline__ float wave_sum(float v) {
#pragma unroll
    for (int o = 1; o < 64; o <<= 1) v += __shfl_xor(v, o);
    return v;
}
__device__ __forceinline__ float wave_max(float v) {
#pragma unroll
    for (int o = 1; o < 64; o <<= 1) v = fmaxf(v, __shfl_xor(v, o));
    return v;
}

template <class DstF>
__device__ __forceinline__ void transpose_item(const float* W, int N, int k0, int n0, LAS float* scr, int lane, const float* ksc, DstF dst) {
    const int kk = lane >> 3, n4 = (lane & 7) * 4;
    f32x4 v[8];
#pragma unroll
    for (int j = 0; j < 8; ++j) v[j] = *(const f32x4*)(W + (size_t)(k0 + kk + 8 * j) * N + n0 + n4);
#pragma unroll
    for (int j = 0; j < 8; ++j) { LAS float* d = scr + (kk + 8 * j) * 33 + n4; d[0] = v[j][0]; d[1] = v[j][1]; d[2] = v[j][2]; d[3] = v[j][3]; }
    LDS_WAIT(); asm volatile("" ::: "memory");
    const int c = lane & 7;
    f32x4 s0 = {1.f, 1.f, 1.f, 1.f}, s1 = s0;
    if (ksc) { s0 = *(const f32x4*)(ksc + k0 + 8 * c); s1 = *(const f32x4*)(ksc + k0 + 8 * c + 4); }
#pragma unroll
    for (int j = 0; j < 4; ++j) { const int n = (lane >> 3) + 8 * j; const LAS float* s = scr + (8 * c) * 33 + n;
        u32x4 o; o.x = pk2(s[0 * 33] * s0[0], s[1 * 33] * s0[1]); o.y = pk2(s[2 * 33] * s0[2], s[3 * 33] * s0[3]); o.z = pk2(s[4 * 33] * s1[0], s[5 * 33] * s1[1]); o.w = pk2(s[6 * 33] * s1[2], s[7 * 33] * s1[3]);
        *(GAS u32x4*)(dst(n0 + n) + k0 + 8 * c) = o; }
    LDS_WAIT(); asm volatile("" ::: "memory");
}

#define PH_BEGIN() unsigned char* ws = args.ws; asm volatile("" : "+s"(ws)); int tid = threadIdx.x; asm volatile("" : "+v"(tid)); \
    const int lane = tid & 63, wave = __builtin_amdgcn_readfirstlane(tid >> 6); const int G = gridDim.x, bx = blockIdx.x; \
    const int vcu = (G % 8 == 0) ? (bx % 8) * (G / 8) + bx / 8 : bx; const int gw = vcu * NWAVES + wave, NGW = G * NWAVES; \
    gu32* ctl = (gu32*)(ws + WS_CTL); (void)lane; (void)wave; (void)gw; (void)NGW; (void)ctl; (void)vcu
#define WSP(T, off) ((T*)(ws + (off)))

__global__ void __launch_bounds__(NWAVES * 64, 2) hybrid_fwd(Args args) {
    extern __shared__ __attribute__((aligned(16))) unsigned char lds[];
    LAS unsigned char* L = (LAS unsigned char*)lds;
    volatile LAS unsigned* MISC = (volatile LAS unsigned*)(L + MISC_OFF);
    for (int u = threadIdx.x; u < (LDS_BYTES - LDSCTL_OFF) / 4; u += NWAVES * 64) ((LAS unsigned*)(L + LDSCTL_OFF))[u] = 0u;
    __syncthreads();
    XcdBarrier bar = xcd_barrier_post((unsigned*)((gu32*)(args.ws + WS_CTL) + CW_BAR), MISC + 8);
    TP_DECL();

    TP_BEGIN(10);
    if (PHASE_MASK & 1) REPS(1) {
        PH_BEGIN();
        bf16_t* WinT = WSP(bf16_t, WS_WIN); bf16_t* WmT = WSP(bf16_t, WS_WM); bf16_t* WoT = WSP(bf16_t, WS_WO); bf16_t* WguT = WSP(bf16_t, WS_WGU); bf16_t* WdT = WSP(bf16_t, WS_WD);
        bf16_t* WrH = WSP(bf16_t, WS_WRH); bf16_t* WrL = WSP(bf16_t, WS_WRL); bf16_t* Hb = WSP(bf16_t, WS_H);
        LAS float* scr = (LAS float*)(L + wave * 16384);
        constexpr int I_IN = 16 * 128, I_AU = 8 * 32, I_OUT = 16 * 32, I_G = 32 * 256, I_U = 32 * 256, I_D = 32 * 256;
        constexpr int NITEMS = I_IN + I_AU + I_OUT + I_G + I_U + I_D;
        for (int it = gw; it < NITEMS; it += NGW) {
            int r = it;
            if (r < I_IN) { const int kb = r / 128, nb = r % 128;
                transpose_item(args.in[2], 4096, kb * 64, nb * 32, scr, lane, nullptr, [&](int n) -> bf16_t* {
                    int v = n; if (n >= 512 && n < 1536) { const int l = n & 255; v = (n & ~255) + 128 * ((l >> 5) & 1) + 32 * (l >> 6) + (l & 31); }
                    return WinT + (size_t)v * 1024; });
                continue; } r -= I_IN;
            if (r < I_AU) { const int kb = r / 32, nb = r % 32;
                transpose_item(args.in[13], 1024, kb * 64, nb * 32, scr, lane, nullptr, [&](int n) -> bf16_t* { return WmT + (size_t)n * 1024 + 512; }); continue; } r -= I_AU;
            if (r < I_OUT) { const int kb = r / 32, nb = r % 32;
                transpose_item(args.in[14], 1024, kb * 64, nb * 32, scr, lane, nullptr, [&](int n) -> bf16_t* { return WoT + (size_t)n * 1024; }); continue; } r -= I_OUT;
            if (r < I_G) { const int e = r / 256, q = r % 256, kb = q / 16, nb = q % 16;
                transpose_item(args.in[20] + (size_t)e * 1024 * 512, 512, kb * 64, nb * 32, scr, lane, args.in[15], [&](int n) -> bf16_t* { return WguT + (size_t)e * 1024 * 1024 + (size_t)(256 * (n >> 7) + (n & 127)) * 1024; }); continue; } r -= I_G;
            if (r < I_U) { const int e = r / 256, q = r % 256, kb = q / 16, nb = q % 16;
                transpose_item(args.in[21] + (size_t)e * 1024 * 512, 512, kb * 64, nb * 32, scr, lane, args.in[15], [&](int n) -> bf16_t* { return WguT + (size_t)e * 1024 * 1024 + (size_t)(256 * (n >> 7) + 128 + (n & 127)) * 1024; }); continue; } r -= I_U;
            { const int e = r / 256, q = r % 256, kb = q / 32, nb = q % 32;
                transpose_item(args.in[22] + (size_t)e * 512 * 1024, 1024, kb * 64, nb * 32, scr, lane, nullptr, [&](int n) -> bf16_t* { return WdT + (size_t)n * 16384 + (size_t)e * 512; }); }
        }
        for (int it = gw; it < 2048; it += NGW) {
            const int kq = it >> 4, nb = it & 15, n = 64 * nb + lane, k = 4 * kq, g = k >> 7, kl = k & 127;
            const float* pw = args.in[3] + (size_t)(g * 128 + kl) * 128; const float* sc = args.in[4] + g * 128; const float* wu = args.in[5] + (size_t)(g * 128) * 1024 + n;
            float a0 = 0.f, a1 = 0.f, a2 = 0.f, a3 = 0.f;
            for (int c = 0; c < 128; ++c) { const float wv = wu[(size_t)c * 1024] * sc[c]; a0 += pw[c] * wv; a1 += pw[128 + c] * wv; a2 += pw[256 + c] * wv; a3 += pw[384 + c] * wv; }
            u32x2 o; o.x = pk2(a0, a1); o.y = pk2(a2, a3);
            *(u32x2*)(WmT + (size_t)n * 1024 + k) = o;
        }
        for (int it = gw * 64 + lane; it < 48 * 1024; it += NGW * 64) {
            const int n = it >> 10, k = it & 1023; float w = 0.f;
            if (n < 4) w = args.in[16][k * 4 + n]; else if (n < 36) w = args.in[18][k * 32 + (n - 4)];
            w *= args.in[15][k];
            const unsigned hb = f2bf(w); const float lo = w - __builtin_bit_cast(float, hb << 16);
            WrH[it] = (bf16_t)hb; WrL[it] = (bf16_t)f2bf(lo);
        }
        { const float* x = args.in[0]; const GAS f32x4* g4 = (const GAS f32x4*)args.in[1] + lane; f32x4 gg[4];
#pragma unroll
          for (int j = 0; j < 4; ++j) gg[j] = g4[64 * j];
          for (int m = gw * 2; m < NTOK; m += NGW * 2) {
            const GAS f32x4* xr = (const GAS f32x4*)(x + (size_t)m * DM) + lane;
            f32x4 v[8]; float s0 = 0.f, s1 = 0.f;
#pragma unroll
            for (int j = 0; j < 8; ++j) v[j] = xr[64 * j];
#pragma unroll
            for (int j = 0; j < 4; ++j) { s0 += (v[j].x * v[j].x + v[j].y * v[j].y) + (v[j].z * v[j].z + v[j].w * v[j].w); s1 += (v[4 + j].x * v[4 + j].x + v[4 + j].y * v[4 + j].y) + (v[4 + j].z * v[4 + j].z + v[4 + j].w * v[4 + j].w); }
            const float r0 = __builtin_amdgcn_rsqf(wave_sum(s0) * (1.f / DM) + EPS), r1 = __builtin_amdgcn_rsqf(wave_sum(s1) * (1.f / DM) + EPS);
            GAS unsigned long long* o8 = (GAS unsigned long long*)(Hb + (size_t)m * DM) + lane;
#pragma unroll
            for (int j = 0; j < 8; ++j) { const f32x4 y = v[j] * (j < 4 ? r0 : r1) * gg[j & 3]; o8[64 * j] = (unsigned long long)pk2(y.x, y.y) | ((unsigned long long)pk2(y.z, y.w) << 32); }
          } }
    }
    xcd_barrier(bar);
    TP_END(10);

    TP_BEGIN(11);
    if (PHASE_MASK & 2) REPS(2) {
        PH_BEGIN();
        gm::StaticOrder S; S.init(WSP(bf16_t, WS_H), WSP(bf16_t, WS_WIN), 1024, 1024, NTOK, 4096, G, bx);
        gm::EpiProj E{WSP(bf16_t, WS_U), WSP(bf16_t, WS_Q), WSP(bf16_t, WS_K), WSP(bf16_t, WS_V), WSP(bf16_t, WS_GP), WSP(bf16_t, WS_GA), args.in[6], args.in[7]};
        gm::gemm_phase<gm::EpiProj, gm::StaticOrder, gm::NT, false, false>(L, S, E, 1024, 1024);
    }
    xcd_barrier(bar);
    TP_END(11);

    TP_BEGIN(12);
    if (PHASE_MASK & 4) REPS(4) {
        PH_BEGIN();
        bf16_t* Ub = WSP(bf16_t, WS_U); bf16_t* DOb = WSP(bf16_t, WS_DO);
        float lam, B2;
        { const float a1 = args.in[8][lane] * args.in[9][lane], a2 = args.in[10][lane] * args.in[11][lane];
          lam = __expf(wave_sum(a1)) - __expf(wave_sum(a2)) + 0.2f;
          const float mq = wave_max(fabsf(args.in[6][lane])), mk = wave_max(fabsf(args.in[7][lane]));
          B2 = 8.0f * mq * mk * LOG2E * 1.02f + 0.5f; }
        TP_BEGIN(20);
        for (int i = 0; i < 8; ++i) {
            const int bh = vcu >> 1, j = vcu & 1; const int s = 2 * (i >> 1) + j; const int qb = (i & 1) ? 15 - s : s;
            att::attn_unit(bh >> 2, bh & 3, qb, WSP(bf16_t, WS_Q), WSP(bf16_t, WS_K), WSP(bf16_t, WS_V), DOb, (char*)lds, B2, lam, args.in[12] TP_ARGS);
        }
        TP_END(20);
        { const int w = 2 << (lane >> 4);
          const bf16_t* Ul = Ub + lane * 8;
          for (int blk = gw; blk < NTOK / 8; blk += NGW) {
            const int tok0 = blk * 8, t0 = tok0 & (SEQ - 1);
            u32x4 hist[15], curv[8], oldv[8];
#pragma unroll
            for (int s = 1; s <= 15; ++s) { const int ok = (s < w) && (t0 - s >= 0); hist[s - 1] = *(const u32x4*)(Ul + (size_t)(ok ? tok0 - s : tok0) * 512); if (!ok) hist[s - 1] = (u32x4){0u, 0u, 0u, 0u}; }
#pragma unroll
            for (int tt = 0; tt < 8; ++tt) { curv[tt] = *(const u32x4*)(Ul + (size_t)(tok0 + tt) * 512);
                const int ok = (t0 + tt - w + 1 >= 0); oldv[tt] = *(const u32x4*)(Ul + (size_t)(ok ? tok0 + tt - w + 1 : tok0) * 512); if (!ok) oldv[tt] = (u32x4){0u, 0u, 0u, 0u}; }
            float S[8];
#pragma unroll
            for (int c = 0; c < 8; ++c) S[c] = 0.f;
#pragma unroll
            for (int s = 0; s < 15; ++s) { const u32x4 v = hist[s];
                S[0] += bflo(v.x); S[1] += bfhi(v.x); S[2] += bflo(v.y); S[3] += bfhi(v.y); S[4] += bflo(v.z); S[5] += bfhi(v.z); S[6] += bflo(v.w); S[7] += bfhi(v.w); }
#pragma unroll
            for (int tt = 0; tt < 8; ++tt) { const u32x4 v = curv[tt], q = oldv[tt]; const int t = t0 + tt;
                const float c0 = bflo(v.x), c1 = bfhi(v.x), c2 = bflo(v.y), c3 = bfhi(v.y), c4 = bflo(v.z), c5 = bfhi(v.z), c6 = bflo(v.w), c7 = bfhi(v.w);
                S[0] += c0; S[1] += c1; S[2] += c2; S[3] += c3; S[4] += c4; S[5] += c5; S[6] += c6; S[7] += c7;
                const float inv = 1.0f / (float)((t + 1 < w) ? t + 1 : w);
                u32x4 o; o.x = pk2(S[0] * inv - c0, S[1] * inv - c1); o.y = pk2(S[2] * inv - c2, S[3] * inv - c3); o.z = pk2(S[4] * inv - c4, S[5] * inv - c5); o.w = pk2(S[6] * inv - c6, S[7] * inv - c7);
                *(u32x4*)(DOb + (size_t)(tok0 + tt) * 1024 + lane * 8) = o;
                S[0] -= bflo(q.x); S[1] -= bfhi(q.x); S[2] -= bflo(q.y); S[3] -= bfhi(q.y); S[4] -= bflo(q.z); S[5] -= bfhi(q.z); S[6] -= bflo(q.w); S[7] -= bfhi(q.w); }
          } }
    }
    xcd_barrier(bar);
    TP_END(12);

    TP_BEGIN(13);
    if (PHASE_MASK & 8) REPS(8) {
        PH_BEGIN();
        gm::StaticOrder S; S.init(WSP(bf16_t, WS_DO), WSP(bf16_t, WS_WM), 1024, 1024, NTOK, 1024, G, bx);
        gm::EpiMerge E{WSP(bf16_t, WS_GP), WSP(bf16_t, WS_GA), WSP(bf16_t, WS_MERGED)};
        gm::gemm_phase<gm::EpiMerge, gm::StaticOrder, gm::NT, false, true>(L, S, E, 1024, 1024);
    }
    xcd_barrier(bar);
    TP_END(13);

    TP_BEGIN(14);
    if (PHASE_MASK & 16) REPS(16) {
        PH_BEGIN();
        gm::StaticOrder S; S.init(WSP(bf16_t, WS_MERGED), WSP(bf16_t, WS_WO), 1024, 1024, NTOK, 1024, G, bx);
        gm::EpiRes E{args.in[0], WSP(bf16_t, WS_X1)};
        gm::gemm_phase<gm::EpiRes, gm::StaticOrder, gm::NT, false, false>(L, S, E, 1024, 1024);
    }
    xcd_barrier(bar);
    TP_END(14);

    TP_BEGIN(15);
    if (PHASE_MASK & 32) {
        PH_BEGIN();
        float* rstd2 = WSP(float, WS_RSTD); int* tcls = WSP(int, WS_TCLS); float* twlo = WSP(float, WS_TWLO); float* twhi = WSP(float, WS_TWHI);
        int* stok = WSP(int, WS_STOK); float* swlo = WSP(float, WS_SWLO); float* swhi = WSP(float, WS_SWHI); float* srstd = WSP(float, WS_SRSTD);
        const bf16_t* X1 = WSP(bf16_t, WS_X1); const bf16_t* WrH = WSP(bf16_t, WS_WRH); const bf16_t* WrL = WSP(bf16_t, WS_WRL);
        for (int i = gw * 64 + lane; i < MAXT * 256; i += NGW * 64) { stok[i] = -1; swlo[i] = 0.f; swhi[i] = 0.f; srstd[i] = 0.f; }
        constexpr int TROW = 1040, LG_OFF = 96 * TROW;
        const int row = lane & 15, kg = lane >> 4;
        const int tok0 = gw * 32;
        f32x4 acc[2][3];
#pragma unroll
        for (int rg = 0; rg < 2; ++rg)
#pragma unroll
            for (int nf = 0; nf < 3; ++nf) acc[rg][nf] = (f32x4){0.f, 0.f, 0.f, 0.f};
        float ss[2] = {0.f, 0.f};
        for (int blk0 = 0; blk0 < NTOK; blk0 += NGW * 32) {
          const int tb = blk0 + tok0; const bool live = tb < NTOK;
          for (int half = 0; half < 2; ++half) {
            __syncthreads();
            for (int i = tid; i < 96 * 64; i += NWAVES * 64) { const int r = i >> 6, c = i & 63;
                const bf16_t* src = (r < 48 ? WrH + (size_t)r * 1024 : WrL + (size_t)(r - 48) * 1024) + half * 512 + c * 8;
                *(LAS u32x4*)(L + r * TROW + c * 16) = *(const u32x4*)src; }
            __syncthreads();
            if (live) {
                const bf16_t* xa = X1 + (size_t)(tb + row) * 1024 + half * 512 + kg * 16;
#pragma unroll 4
                for (int sp = 0; sp < 8; ++sp) {
                    u32x4 A[2][2];
#pragma unroll
                    for (int rg = 0; rg < 2; ++rg) { A[rg][0] = *(const u32x4*)(xa + (size_t)rg * 16 * 1024 + sp * 64); A[rg][1] = *(const u32x4*)(xa + (size_t)rg * 16 * 1024 + sp * 64 + 8); }
#pragma unroll
                    for (int rg = 0; rg < 2; ++rg)
#pragma unroll
                        for (int hh = 0; hh < 2; ++hh) { const u32x4 v = A[rg][hh];
                            const float f0 = bflo(v.x), f1 = bfhi(v.x), f2 = bflo(v.y), f3 = bfhi(v.y), f4 = bflo(v.z), f5 = bfhi(v.z), f6 = bflo(v.w), f7 = bfhi(v.w);
                            ss[rg] += (f0 * f0 + f1 * f1) + (f2 * f2 + f3 * f3) + (f4 * f4 + f5 * f5) + (f6 * f6 + f7 * f7); }
#pragma unroll
                    for (int hh = 0; hh < 2; ++hh)
#pragma unroll
                        for (int nf = 0; nf < 3; ++nf) {
                            const bf16x8 Bh = *(const LAS bf16x8*)(L + (nf * 16 + row) * TROW + (sp * 64 + kg * 16 + hh * 8) * 2);
                            const bf16x8 Bl = *(const LAS bf16x8*)(L + (48 + nf * 16 + row) * TROW + (sp * 64 + kg * 16 + hh * 8) * 2);
#pragma unroll
                            for (int rg = 0; rg < 2; ++rg) { const bf16x8 Af = __builtin_bit_cast(bf16x8, A[rg][hh]);
                                acc[rg][nf] = __builtin_amdgcn_mfma_f32_16x16x32_bf16(Af, Bh, acc[rg][nf], 0, 0, 0);
                                acc[rg][nf] = __builtin_amdgcn_mfma_f32_16x16x32_bf16(Af, Bl, acc[rg][nf], 0, 0, 0); }
                        }
                }
            }
          }
          if (live) {
            LAS float* lg = (LAS float*)(L + LG_OFF + wave * 3072);
#pragma unroll
            for (int rg = 0; rg < 2; ++rg) {
                float s2 = ss[rg]; s2 += __shfl_xor(s2, 16); s2 += __shfl_xor(s2, 32);
                const float rstd = __builtin_amdgcn_rsqf(s2 * (1.0f / 1024.0f) + EPS);
#pragma unroll
                for (int nf = 0; nf < 3; ++nf)
#pragma unroll
                    for (int r = 0; r < 4; ++r) lg[(4 * kg + r) * 48 + 16 * nf + row] = acc[rg][nf][r];
                LDS_WAIT(); asm volatile("" ::: "memory");
                if (lane < 16) {
                    const int tok = tb + rg * 16 + lane;
                    const LAS float* my = lg + lane * 48;
                    float gl[4]; int g = 0;
#pragma unroll
                    for (int j = 0; j < 4; ++j) gl[j] = rstd * my[j] + args.in[17][j];
                    float gmx = gl[0];
#pragma unroll
                    for (int j = 1; j < 4; ++j) if (gl[j] > gmx) { gmx = gl[j]; g = j; }
                    float den = 0.f;
#pragma unroll
                    for (int j = 0; j < 4; ++j) den += __expf(gl[j] - gmx);
                    const float ptop = 1.0f / den;
                    float le[8];
#pragma unroll
                    for (int e = 0; e < 8; ++e) le[e] = rstd * my[4 + g * 8 + e] + args.in[19][g * 8 + e];
                    int e1 = 0; float v1 = le[0];
#pragma unroll
                    for (int e = 1; e < 8; ++e) if (le[e] > v1) { v1 = le[e]; e1 = e; }
                    int e2 = -1; float v2 = -3.0e38f;
#pragma unroll
                    for (int e = 0; e < 8; ++e) if (e != e1 && le[e] > v2) { v2 = le[e]; e2 = e; }
                    const float rr = __expf(v2 - v1), w1 = ptop / (1.0f + rr), w2 = ptop * rr / (1.0f + rr);
                    const int lo = e1 < e2 ? e1 : e2, hi2 = e1 < e2 ? e2 : e1;
                    const float wlo = e1 < e2 ? w1 : w2, whi = e1 < e2 ? w2 : w1;
                    const int cls = g * 28 + lo * 8 - (lo * (lo + 1)) / 2 + (hi2 - lo - 1);
                    tcls[tok] = cls; twlo[tok] = wlo; twhi[tok] = whi; rstd2[tok] = rstd;
                    atomicAdd((unsigned*)(ctl + CW_CNT) + cls * 16, 1u);
                }
                LDS_WAIT(); asm volatile("" ::: "memory");
                ss[rg] = 0.f;
#pragma unroll
                for (int nf = 0; nf < 3; ++nf) acc[rg][nf] = (f32x4){0.f, 0.f, 0.f, 0.f};
            }
          }
        }
    }
    xcd_barrier(bar);
    TP_END(15);

    TP_BEGIN(16);
    if (PHASE_MASK & 64) {
        PH_BEGIN();
        float* rstd2 = WSP(float, WS_RSTD); int* tcls = WSP(int, WS_TCLS); float* twlo = WSP(float, WS_TWLO); float* twhi = WSP(float, WS_TWHI);
        int* stok = WSP(int, WS_STOK); float* swlo = WSP(float, WS_SWLO); float* swhi = WSP(float, WS_SWHI); float* srstd = WSP(float, WS_SRSTD);
        int* tilecls = WSP(int, WS_TILECLS);
        LAS int* tstart = (LAS int*)(L);
        LAS int* cntl = (LAS int*)(L + 1024);
        if (tid < NCLS) cntl[tid] = (int)__hip_atomic_load((unsigned*)(ctl + CW_CNT) + tid * 16, RLX_AGENT);
        __syncthreads();
        if (tid == 0) { int s = 0; for (int c = 0; c < NCLS; ++c) { tstart[c] = s; s += (cntl[c] + 255) >> 8; } tstart[128] = s; }
        __syncthreads();
        if (bx == 0) {
            if (tid < NCLS) { const int t0 = tstart[tid], nt = (cntl[tid] + 255) >> 8; for (int t = 0; t < nt; ++t) tilecls[t0 + t] = tid; }
            if (tid == 0) __hip_atomic_store((unsigned*)(ctl + CW_NTILES), (unsigned)tstart[128], RLX_AGENT);
        }
        for (int tok = bx * 512 + tid; tok < NTOK; tok += G * 512) {
            const int c = tcls[tok];
            const unsigned pos = atomicAdd((unsigned*)(ctl + CW_CUR) + c * 16, 1u);
            const int slot = tstart[c] * 256 + (int)pos;
            stok[slot] = tok; swlo[slot] = twlo[tok]; swhi[slot] = twhi[tok]; srstd[slot] = rstd2[tok];
        }
    }
    xcd_barrier(bar);
    TP_END(16);

    TP_BEGIN(17);
    if (PHASE_MASK & 128) REPS(128) {
        PH_BEGIN();
        LAS int* utab = (LAS int*)(L + UTAB_OFF); const int* tilecls = WSP(int, WS_TILECLS);
        const int ntiles = (int)__hip_atomic_load((unsigned*)(ctl + CW_NTILES), RLX_AGENT);
        if (tid < 16) { const int Lx = tid * G + vcu; const int tile = Lx >> 3, pn = Lx & 7; int e0 = 0, e1 = 0, tl = -1;
            if (tile < ntiles) { const int cls = tilecls[tile]; const int g = cls / 28; int rem = cls % 28, lo = 0; while (rem >= 7 - lo) { rem -= 7 - lo; ++lo; } e0 = g * 8 + lo; e1 = g * 8 + lo + 1 + rem; tl = tile; }
            utab[tid * 4 + 0] = tl; utab[tid * 4 + 1] = pn; utab[tid * 4 + 2] = e0; utab[tid * 4 + 3] = e1; }
        __syncthreads();
        gm::MoeSched S{utab, (const char*)WSP(bf16_t, WS_X1), (const char*)WSP(bf16_t, WS_WGU), WSP(int, WS_STOK), 1};
        gm::EpiMoe1 E{WSP(float, WS_SRSTD), WSP(float, WS_SWLO), WSP(float, WS_SWHI), WSP(bf16_t, WS_HDN)};
        gm::gemm_phase<gm::EpiMoe1, gm::MoeSched, gm::NT, true, false>(L, S, E, 1024, 1024);
    }
    xcd_barrier(bar);
    TP_END(17);
    TP_BEGIN(18);
    if (PHASE_MASK & 256) {
        PH_BEGIN();
        LAS int* utab = (LAS int*)(L + UTAB_OFF); const int* tilecls = WSP(int, WS_TILECLS);
        const int ntiles = (int)__hip_atomic_load((unsigned*)(ctl + CW_NTILES), RLX_AGENT);
        if (tid < 16) { const int Lx = tid * G + vcu; const int tile = Lx >> 2, pn = Lx & 3; int e0 = 0, e1 = 0, tl = -1;
            if (tile < ntiles) { const int cls = tilecls[tile]; const int g = cls / 28; int rem = cls % 28, lo = 0; while (rem >= 7 - lo) { rem -= 7 - lo; ++lo; } e0 = g * 8 + lo; e1 = g * 8 + lo + 1 + rem; tl = tile; }
            utab[tid * 4 + 0] = tl; utab[tid * 4 + 1] = pn; utab[tid * 4 + 2] = e0; utab[tid * 4 + 3] = e1; }
        __syncthreads();
        gm::MoeSched S{utab, (const char*)WSP(bf16_t, WS_HDN), (const char*)WSP(bf16_t, WS_WD), WSP(int, WS_STOK), 2};
        gm::EpiMoe2 E{WSP(int, WS_STOK), WSP(bf16_t, WS_X1), args.out};
        gm::gemm_phase<gm::EpiMoe2, gm::MoeSched, 8, false, false>(L, S, E, 1024, 16384);
    }
    TP_END(18);
    TP_FINISH();
}

extern "C" void kernel_launch(void* const* d_in, const int* in_sizes, int n_in, void* d_out, int out_size, void* d_ws, size_t ws_size, hipStream_t stream) {
    static int grid = 0;
    if (grid == 0) {
        if (n_in != 23 || out_size != NTOK * DM || ws_size < WS_END) { fprintf(stderr, "kernel_launch: unexpected shapes (n_in %d, out %d, ws %zu)\n", n_in, out_size, ws_size); grid = -1; return; }
        int dev = 0, cus = 0;
        if (hipGetDevice(&dev) != hipSuccess || hipDeviceGetAttribute(&cus, hipDeviceAttributeMultiprocessorCount, dev) != hipSuccess) { grid = -1; return; }
        if (hipFuncSetAttribute((const void*)hybrid_fwd, hipFuncAttributeMaxDynamicSharedMemorySize, LDS_BYTES) != hipSuccess) { fprintf(stderr, "kernel_launch: hipFuncSetAttribute failed\n"); grid = -1; return; }
        int per_cu = 0;
        if (hipOccupancyMaxActiveBlocksPerMultiprocessor(&per_cu, (const void*)hybrid_fwd, NWAVES * 64, LDS_BYTES) != hipSuccess || per_cu < 1) fprintf(stderr, "kernel_launch: occupancy query says %d\n", per_cu);
        (void)hipGetLastError();
        grid = cus;
        if (grid != 256) fprintf(stderr, "kernel_launch: %d CUs (built for 256)\n", grid);
    }
    if (grid < 0) return;
    if (hipMemsetAsync((char*)d_ws + WS_CTL, 0, CTL_ZERO_BYTES, stream) != hipSuccess) return;
    Args a{};
    for (int i = 0; i < 23; ++i) a.in[i] = (const float*)d_in[i];
    a.out = (float*)d_out; a.ws = (unsigned char*)d_ws;
    hipLaunchKernelGGL(hybrid_fwd, dim3(grid), dim3(NWAVES * 64), LDS_BYTES, stream, a);
}
```

```cpp
#include <hip/hip_runtime.h>
#include <hip/hip_bf16.h>
#include <cstdio>
#include <cstdint>

#define LAS __attribute__((address_space(3)))
#define GAS __attribute__((address_space(1)))
typedef unsigned short bf16_t;
typedef short bf16x8 __attribute__((ext_vector_type(8)));
typedef short s16x4 __attribute__((ext_vector_type(4)));
typedef float f32x2 __attribute__((ext_vector_type(2)));
typedef float f32x4 __attribute__((ext_vector_type(4)));
typedef float f32x16 __attribute__((ext_vector_type(16)));
typedef unsigned u32x4 __attribute__((ext_vector_type(4)));
typedef unsigned u32x2 __attribute__((ext_vector_type(2)));
typedef GAS unsigned gu32;
#define RLX_AGENT __ATOMIC_RELAXED, __HIP_MEMORY_SCOPE_AGENT
#define LDS_WAIT() asm volatile("s_waitcnt lgkmcnt(0)" ::: "memory")
#define VM_WAIT() asm volatile("s_waitcnt vmcnt(0)" ::: "memory")

#ifndef PHASE_MASK
#define PHASE_MASK 0x1ff
#endif
#ifndef DUP_MASK
#define DUP_MASK 0
#endif
#ifdef TPROBE
#ifndef TP_AMP
#define TP_AMP 4
#endif
#ifndef TP_WAVE
#define TP_WAVE 0
#endif
__device__ __forceinline__ unsigned long long tp_now() { unsigned long long t; __builtin_amdgcn_sched_barrier(0); asm volatile("s_memrealtime %0\n\ts_waitcnt lgkmcnt(0)" : "=s"(t) :: "memory"); __builtin_amdgcn_sched_barrier(0); return t; }
#define TP_DECL() unsigned long long tp_t0 = 0, tp_acc = 0; (void)tp_t0
#define TP_PARAMS , unsigned long long& tp_t0, unsigned long long& tp_acc
#define TP_ARGS , tp_t0, tp_acc
#define TP_BEGIN(k) do { if ((k) == TPROBE) tp_t0 = tp_now(); } while (0)
#define TP_END(k) do { if ((k) == TPROBE) tp_acc += tp_now() - tp_t0; } while (0)
#define TP_FINISH() do { if (blockIdx.x == 0 && threadIdx.x == TP_WAVE * 64) { const unsigned long long s0 = tp_now(); while (tp_now() - s0 < tp_acc * TP_AMP) __builtin_amdgcn_s_sleep(8); } } while (0)
#else
#define TP_DECL()
#define TP_PARAMS
#define TP_ARGS
#define TP_BEGIN(k)
#define TP_END(k)
#define TP_FINISH()
#endif
#define REPS(bit) for (int rep_ = 0; rep_ < ((DUP_MASK & (bit)) ? 2 : 1); ++rep_)

constexpr int NTOK = 65536, DM = 1024, SEQ = 2048;
constexpr float LOG2E = 1.4426950408889634f;
constexpr float EPS = 1e-6f;
constexpr int NCLS = 112, MAXT = 368;
constexpr int NWAVES = 8;

constexpr size_t MiB = 1u << 20;
constexpr size_t WS_CTL = 0, CTL_ZERO_BYTES = 1 * MiB;
constexpr size_t WS_RSTD = 1 * MiB, WS_TCLS = WS_RSTD + 256 * 1024, WS_TWLO = WS_TCLS + 256 * 1024, WS_TWHI = WS_TWLO + 256 * 1024;
constexpr size_t WS_STOK = 2 * MiB, WS_SWLO = WS_STOK + 512 * 1024, WS_SWHI = WS_SWLO + 512 * 1024, WS_SRSTD = WS_SWHI + 512 * 1024;
constexpr size_t WS_TILECLS = 4 * MiB;
constexpr size_t WS_WRH = 5 * MiB, WS_WRL = WS_WRH + 128 * 1024;
constexpr size_t WS_WIN = 16 * MiB, WS_WM = 24 * MiB, WS_WO = 26 * MiB;
constexpr size_t WS_WGU = 32 * MiB, WS_WD = 96 * MiB;
constexpr size_t WS_H = 128 * MiB;
constexpr size_t WS_U = 256 * MiB, WS_Q = 320 * MiB, WS_K = 384 * MiB, WS_V = 448 * MiB;
constexpr size_t WS_GP = 512 * MiB, WS_GA = 640 * MiB;
constexpr size_t WS_DO = 768 * MiB;
constexpr size_t WS_END = 896 * MiB;
constexpr size_t WS_MERGED = WS_H, WS_X1 = WS_U, WS_HDN = WS_GP;
constexpr int CW_TMO = 0, CW_NTILES = 16, CW_BAR = 4096, CW_CNT = 8192, CW_CUR = 10240, CW_ATTQ = 12288;

constexpr int RING_BYTES = 131072;
constexpr int LDSCTL_OFF = RING_BYTES, MISC_OFF = LDSCTL_OFF + 320, UTAB_OFF = LDSCTL_OFF + 1024;
constexpr int JUNK_OFF = LDSCTL_OFF + 8192;
constexpr int LDS_BYTES = 147456;

__device__ __forceinline__ unsigned f2bf(float f) { unsigned u = __builtin_bit_cast(unsigned, f); return (u + 0x7fffu + ((u >> 16) & 1u)) >> 16; }
__device__ __forceinline__ unsigned pk2(float lo, float hi) { return f2bf(lo) | (f2bf(hi) << 16); }
__device__ __forceinline__ float bf2f(unsigned short b) { return __builtin_bit_cast(float, (unsigned)b << 16); }
__device__ __forceinline__ float bflo(unsigned w) { return __builtin_bit_cast(float, w << 16); }
__device__ __forceinline__ float bfhi(unsigned w) { return __builtin_bit_cast(float, w & 0xffff0000u); }
__device__ __forceinline__ unsigned cvt_pk_bf16(float lo, float hi) { unsigned r; asm("v_cvt_pk_bf16_f32 %0, %1, %2" : "=v"(r) : "v"(lo), "v"(hi)); return r; }

#define XB_TMO      128
#define XB_XCNT(j)  (256  + 64 * (j))
#define XB_XSUB(j)  (1280 + 64 * (j))
#define XB_XGEN(j)  (2304 + 64 * (j))
#define XB_TOP      3328
#define XB_TOPGEN   3392
#define XCD_BAR_WORDS 3456
#define XB_SPIN_CAP (1u << 18)
__device__ __forceinline__ unsigned xb_ld(unsigned* p)              { return __hip_atomic_load(p, __ATOMIC_RELAXED, __HIP_MEMORY_SCOPE_AGENT); }
__device__ __forceinline__ unsigned xb_add(unsigned* p, unsigned v) { return __hip_atomic_fetch_add(p, v, __ATOMIC_RELAXED, __HIP_MEMORY_SCOPE_AGENT); }
__device__ __forceinline__ unsigned xb_xcc_id() { return (unsigned)__builtin_amdgcn_s_getreg((3 << 11) | 20) & 0xFu; }
#define XB_SPIN(cond, bar) do { unsigned _sp = 0; while (cond) { __builtin_amdgcn_s_sleep(1); \
    if ((++_sp & 255u) == 0u) { if (xb_ld(&(bar)[XB_TMO])) break; if (_sp > XB_SPIN_CAP) { atomicAdd(&(bar)[XB_TMO], 1u); break; } } } } while (0)
struct XcdBarrier { unsigned* bar; unsigned x; volatile LAS unsigned* st; };
__device__ __forceinline__ XcdBarrier xcd_barrier_post(unsigned* bar, volatile LAS unsigned* st) {
    XcdBarrier b; b.bar = bar; b.x = xb_xcc_id(); b.st = st;
    if (threadIdx.x == 0) (void)xb_add(&bar[XB_XCNT(b.x)], 1u);
    return b;
}
__device__ __forceinline__ void xcd_barrier_complete(unsigned* bar, unsigned x, unsigned& nloc, unsigned& nx) {
    const unsigned G = gridDim.x * gridDim.y * gridDim.z;
    unsigned sum, cnt, mine, sp = 0u;
    for (;;) {
        sum = 0u; cnt = 0u; mine = 0u;
#pragma unroll
        for (unsigned j = 0; j < 16; ++j) { const unsigned c = xb_ld(&bar[XB_XCNT(j)]); sum += c; cnt += (c > 0u) ? 1u : 0u; mine = (j == x) ? c : mine; }
        if (sum == G) break;
        __builtin_amdgcn_s_sleep(1);
        if ((++sp & 255u) == 0u) { if (xb_ld(&bar[XB_TMO])) break; if (sp > XB_SPIN_CAP) { atomicAdd(&bar[XB_TMO], 1u); break; } }
    }
    nloc = mine > 0u ? mine : 1u; nx = cnt > 0u ? cnt : 1u;
}
__device__ __forceinline__ void xcd_barrier(const XcdBarrier& b) {
    asm volatile("s_waitcnt vmcnt(0)" ::: "memory");
    __syncthreads();
    if (threadIdx.x == 0) {
        unsigned* bar = b.bar;
        __builtin_amdgcn_s_waitcnt(0);
        unsigned nloc = b.st[0], nx = b.st[1];
        if (nloc == 0u) { xcd_barrier_complete(bar, b.x, nloc, nx); b.st[0] = nloc; b.st[1] = nx; }
        const unsigned old = xb_add(&bar[XB_XSUB(b.x)], 1u);
        const unsigned gen = old / nloc;
        if (old + 1u == (gen + 1u) * nloc) {
            __builtin_amdgcn_fence(__ATOMIC_RELEASE, "agent");
            asm volatile("s_waitcnt vmcnt(0)" ::: "memory");
            const unsigned og = xb_add(&bar[XB_TOP], 1u);
            const unsigned tg = og / nx;
            if (og + 1u == (tg + 1u) * nx) xb_add(&bar[XB_TOPGEN], 1u);
            else XB_SPIN(xb_ld(&bar[XB_TOPGEN]) == tg, bar);
            __builtin_amdgcn_fence(__ATOMIC_ACQUIRE, "agent");
            xb_add(&bar[XB_XGEN(b.x)], 1u);
            asm volatile("s_waitcnt vmcnt(0)" ::: "memory");
        } else {
            XB_SPIN(xb_ld(&bar[XB_XGEN(b.x)]) == gen, bar);
            __builtin_amdgcn_fence(__ATOMIC_ACQUIRE, "agent");
            asm volatile("s_waitcnt vmcnt(0)" ::: "memory");
        }
    }
    __syncthreads();
}

namespace gm {
constexpr int BM = 256, BK = 64, HALF = 128, HTB = HALF * BK * 2, NXCD = 8, WGM = 8, NT = 16;
__host__ __device__ __forceinline__ int lds_byte(int r, int c) { const int st = (r >> 4) * 2 + (c >> 5), rr = r & 15, cc = c & 31, ob = rr * 64 + cc * 2; return st * 1024 + (ob ^ (((ob >> 9) & 1) << 5)); }
__host__ __device__ __forceinline__ void stage_rc(int b, int& R, int& C) { const int st = b / 1024, sb = b % 1024, swz = sb ^ (((sb >> 9) & 1) << 5); R = (st >> 1) * 16 + swz / 64; C = (st & 1) * 32 + (swz % 64) / 2; }
__host__ __device__ __forceinline__ int perm32(int rho) { const int n = rho >> 4, i = rho & 15; return 8 * (i >> 2) + 4 * n + (i & 3); }

struct Unit { const char* a; const char* b0; const char* b1; int pm, pn, e0, e1; };

struct StaticOrder {
    const char* A; const char* Bt; int lda, ldb; int nM, nN, nwg, G, c;
    __device__ void init(const void* A_, const void* Bt_, int lda_, int ldb_, int M, int N, int G_, int c_) { A = (const char*)A_; Bt = (const char*)Bt_; lda = lda_; ldb = ldb_; nM = M / BM; nN = N / BM; nwg = nM * nN; G = G_; c = c_; }
    __device__ __forceinline__ bool next(int i, Unit& u) const {
        const long L = (long)i * G + c; if (L >= nwg) return false;
        int wgid = (int)L; { const int q = nwg / NXCD, r = nwg % NXCD, xcd = wgid % NXCD, off = wgid / NXCD; wgid = (xcd < r ? xcd * (q + 1) : r * (q + 1) + (xcd - r) * q) + off; }
        const int nig = WGM * nN, gid = wgid / nig, fm = gid * WGM, gsz = (nM - fm) < WGM ? (nM - fm) : WGM;
        u.pm = fm + ((wgid % nig) % gsz); u.pn = (wgid % nig) / gsz; u.e0 = 0; u.e1 = 0;
        u.a = A + (size_t)u.pm * BM * lda * 2; u.b0 = Bt + (size_t)u.pn * BM * ldb * 2; u.b1 = u.b0;
        return true;
    }
    __device__ __forceinline__ void offs(const Unit&, const int (&)[2], const int (&)[2], unsigned (&)[2][2]) const {}
};

template <int PH, class Epi, class Sched, int KS, bool GATHER, bool MID>
__device__ __forceinline__ void gemm_phase(LAS unsigned char* lds, const Sched& S, const Epi& E, const int lda, const int ldb TP_PARAMS) {
    int tid = threadIdx.x; asm volatile("" : "+v"(tid));
    const int wid = __builtin_amdgcn_readfirstlane(tid >> 6), lane = tid & 63, wr = wid >> 2, wc = wid & 3, fr = lane & 15, fq = lane >> 4;
    int Rr[2], Cc[2]; unsigned offA[2][2], offAn[2][2], voffB[2];
#pragma unroll
    for (int i = 0; i < 2; ++i) { int R, C; stage_rc(tid * 16 + i * 8192, R, C); Rr[i] = R; Cc[i] = C; const int Rb = Epi::PERM ? ((R & ~31) + perm32(R & 31)) : R;
        voffB[i] = (unsigned)(Rb * ldb + C) * 2u;
        offA[0][i] = (unsigned)(R * lda + C) * 2u; offA[1][i] = (unsigned)((R + HALF) * lda + C) * 2u; offAn[0][i] = offA[0][i]; offAn[1][i] = offA[1][i]; }
    const size_t kstep = (size_t)(BK * 2);
    const size_t hstepB = (size_t)HALF * ldb * 2;
    const unsigned ldsw = (unsigned)wid * 1024u;
    const int aoff = lds_byte(wr * 64 + fr, fq * 8), boff = lds_byte(wc * 32 + fr, fq * 8);
#define G_SA(b, h) (((b) * 2 + (h)) * HTB)
#define G_SB(b, h) ((4 + (b) * 2 + (h)) * HTB)
#define G_STAGE_A(bufoff, gbase, OFF, h) do { _Pragma("unroll") for (int _i = 0; _i < 2; ++_i) \
        __builtin_amdgcn_global_load_lds((const unsigned*)((const char*)(gbase) + (OFF)[h][_i]), (LAS unsigned*)(lds + (bufoff) + ldsw + _i * 8192), 16, 0, 0); } while (0)
#define G_STAGE_B(bufoff, gbase) do { _Pragma("unroll") for (int _i = 0; _i < 2; ++_i) \
        __builtin_amdgcn_global_load_lds((const unsigned*)((const char*)(gbase) + voffB[_i]), (LAS unsigned*)(lds + (bufoff) + ldsw + _i * 8192), 16, 0, 0); } while (0)
#define G_LDA(dst, b, h) do { _Pragma("unroll") for (int m = 0; m < 4; ++m) _Pragma("unroll") for (int k = 0; k < 2; ++k) dst[m][k] = *(const LAS bf16x8*)(lds + G_SA(b, h) + aoff + m * 2048 + k * 1024); } while (0)
#define G_LDB(dst, b, h) do { _Pragma("unroll") for (int n = 0; n < 2; ++n) _Pragma("unroll") for (int k = 0; k < 2; ++k) dst[n][k] = *(const LAS bf16x8*)(lds + G_SB(b, h) + boff + n * 2048 + k * 1024); } while (0)
#define G_MMA(ai, bj, At, Bt) do { __builtin_amdgcn_s_setprio(1); _Pragma("unroll") for (int m = 0; m < 4; ++m) _Pragma("unroll") for (int n = 0; n < 2; ++n) _Pragma("unroll") for (int k = 0; k < 2; ++k) \
        acc[ai][bj][m][n] = __builtin_amdgcn_mfma_f32_16x16x32_bf16(Bt[n][k], At[m][k], acc[ai][bj][m][n], 0, 0, 0); __builtin_amdgcn_s_setprio(0); } while (0)
#define G_WAIT_V(n) asm volatile("s_waitcnt vmcnt(" #n ")" ::: "memory")
#define G_WAIT_L(n) asm volatile("s_waitcnt lgkmcnt(" #n ")" ::: "memory")
#define G_BAR __builtin_amdgcn_s_barrier()
#define G_SCHED __builtin_amdgcn_sched_barrier(0)
#define G_BP(u, t) ((t) < KS ? (u).b0 + (size_t)(t) * kstep : (u).b1 + (size_t)((t) - KS) * kstep)
    Unit cur, nxt; int ui = 0;
    if (!S.next(0, cur)) return;
    if constexpr (GATHER) S.offs(cur, Rr, Cc, offA);
    f32x4 acc[2][2][4][2];
#pragma unroll
    for (int a = 0; a < 2; ++a)
#pragma unroll
        for (int b = 0; b < 2; ++b)
#pragma unroll
            for (int m = 0; m < 4; ++m)
#pragma unroll
                for (int n = 0; n < 2; ++n) acc[a][b][m][n] = (f32x4){0.f, 0.f, 0.f, 0.f};
    bf16x8 At[4][2], B0[2][2], B1[2][2];
    {
        const char* cA = cur.a; const char* cB = cur.b0; const char* cB1 = G_BP(cur, 1);
        G_STAGE_B(G_SB(0, 0), cB); G_STAGE_B(G_SB(0, 1), cB + hstepB); G_STAGE_A(G_SA(0, 0), cA, offA, 0); G_STAGE_A(G_SA(0, 1), cA, offA, 1);
        if (wr == 1) G_BAR;
        G_WAIT_V(2); G_BAR;
        G_STAGE_B(G_SB(1, 0), cB1); G_STAGE_A(G_SA(1, 0), cA + kstep, offA, 0); G_STAGE_B(G_SB(1, 1), cB1 + hstepB);
        G_WAIT_V(6); G_BAR;
    }
    for (;;) {
        const bool has_next = S.next(ui + 1, nxt);
#if defined(EPI_PREFETCH)
        E.prefetch(cur, wr, wc, lane, (LAS unsigned*)(lds + JUNK_OFF + wid * 256));
#endif
        TP_BEGIN(100 + PH * 10);
        for (int t = 0; t < NT; t += 2) {
            const bool last = (t == NT - 2);
            if constexpr (MID) { if (t == NT / 2) { TP_BEGIN(102 + PH * 10); E.mid(acc, cur, wr, wc, fr, fq); TP_END(102 + PH * 10); } }
            if constexpr (GATHER) { if (t == NT - 4 && has_next) S.offs(nxt, Rr, Cc, offAn); }
            const char* a1 = cur.a + (size_t)(t + 1) * kstep;
            const bool sw = last && has_next;
            const int t2 = last ? 0 : t + 2;
            const char* ua = sw ? nxt.a : cur.a; const char* ub0 = sw ? nxt.b0 : cur.b0; const char* ub1 = sw ? nxt.b1 : cur.b1;
            const char* a2 = ua + (size_t)t2 * kstep; const char* a3 = a2 + kstep;
            const char* b2 = (t2 < KS) ? ub0 + (size_t)t2 * kstep : ub1 + (size_t)(t2 - KS) * kstep;
            const char* b3 = (t2 + 1 < KS) ? ub0 + (size_t)(t2 + 1) * kstep : ub1 + (size_t)(t2 + 1 - KS) * kstep;
            G_LDB(B0, 0, 0); G_LDB(B1, 0, 1); G_SCHED; G_LDA(At, 0, 0); G_STAGE_A(G_SA(1, 1), a1, offA, 1);
            G_WAIT_V(8); G_WAIT_L(0); G_BAR; G_MMA(0, 0, At, B0); G_MMA(0, 1, At, B1); G_BAR; G_SCHED;
            if constexpr (GATHER) { if (sw) {
#pragma unroll
                for (int h = 0; h < 2; ++h)
#pragma unroll
                    for (int i = 0; i < 2; ++i) offA[h][i] = offAn[h][i]; } }
            G_LDA(At, 0, 1); G_STAGE_B(G_SB(0, 0), b2); G_STAGE_B(G_SB(0, 1), b2 + hstepB); G_STAGE_A(G_SA(0, 0), a2, offA, 0);
            G_WAIT_V(8); G_WAIT_L(0); G_BAR; G_MMA(1, 0, At, B0); G_MMA(1, 1, At, B1); G_BAR; G_SCHED;
            G_LDB(B0, 1, 0); G_LDB(B1, 1, 1); G_SCHED; G_LDA(At, 1, 0); G_STAGE_A(G_SA(0, 1), a2, offA, 1);
            G_WAIT_V(8); G_WAIT_L(0); G_BAR; G_MMA(0, 0, At, B0); G_MMA(0, 1, At, B1); G_BAR; G_SCHED;
            G_LDA(At, 1, 1); G_STAGE_B(G_SB(1, 0), b3); G_STAGE_B(G_SB(1, 1), b3 + hstepB); G_STAGE_A(G_SA(1, 0), a3, offA, 0);
            G_WAIT_V(8); G_WAIT_L(0); G_BAR; G_MMA(1, 0, At, B0); G_MMA(1, 1, At, B1); G_BAR; G_SCHED;
        }
        TP_END(100 + PH * 10); TP_BEGIN(101 + PH * 10);
        if (wr == 0) G_BAR;
        E(acc, cur, wr, wc, fr, fq);
        TP_END(101 + PH * 10);
        if (!has_next) break;
#pragma unroll
        for (int a = 0; a < 2; ++a)
#pragma unroll
            for (int b = 0; b < 2; ++b)
#pragma unroll
                for (int m = 0; m < 4; ++m)
#pragma unroll
                    for (int n = 0; n < 2; ++n) acc[a][b][m][n] = (f32x4){0.f, 0.f, 0.f, 0.f};
        cur = nxt; ++ui;
        if (wr == 1) G_BAR;
    }
    G_WAIT_V(0);
    G_BAR;
#undef G_SA
#undef G_SB
#undef G_STAGE_A
#undef G_STAGE_B
#undef G_LDA
#undef G_LDB
#undef G_MMA
#undef G_WAIT_V
#undef G_WAIT_L
#undef G_BAR
#undef G_SCHED
#undef G_BP
}

__device__ __forceinline__ void st8(bf16_t* p, f32x4 v0, f32x4 v1) { u32x4 w; w.x = cvt_pk_bf16(v0[0], v0[1]); w.y = cvt_pk_bf16(v0[2], v0[3]); w.z = cvt_pk_bf16(v1[0], v1[1]); w.w = cvt_pk_bf16(v1[2], v1[3]); *(u32x4*)p = w; }
__device__ __forceinline__ float sigm(float z) { return __builtin_amdgcn_rcpf(1.0f + __builtin_amdgcn_exp2f(-z * LOG2E)); }

__device__ __forceinline__ void touch(const void* p, LAS unsigned* junk) { __builtin_amdgcn_global_load_lds((const unsigned*)p, junk, 4, 0, 0); }

struct EpiProj {
    static constexpr bool PERM = true;
    __device__ __forceinline__ void prefetch(const Unit&, int, int, int, LAS unsigned*) const {}
    bf16_t *U, *Q, *K, *V, *GP, *GA; const float *gq, *gk;
    __device__ __forceinline__ void mid(f32x4 (&)[2][2][4][2], const Unit&, int, int, int, int) const {}
    __device__ __forceinline__ void operator()(const f32x4 (&acc)[2][2][4][2], const Unit& u, int wr, int wc, int fr, int fq) const {
        const int pn = u.pn; const int row0 = u.pm * BM + wr * 64 + fr;
        if (pn < 2) {
            const int col0 = (pn & 1) * 256 + wc * 32 + 8 * fq;
#pragma unroll
            for (int ai = 0; ai < 2; ++ai)
#pragma unroll
                for (int m = 0; m < 4; ++m) { bf16_t* rowp = U + (size_t)(row0 + ai * HALF + m * 16) * 512 + col0;
#pragma unroll
                    for (int bj = 0; bj < 2; ++bj) st8(rowp + bj * HALF, acc[ai][bj][m][0], acc[ai][bj][m][1]); }
        } else if (pn == 6 || pn == 7) {
#pragma unroll
            for (int ai = 0; ai < 2; ++ai)
#pragma unroll
                for (int m = 0; m < 4; ++m) { const int row = row0 + ai * HALF + m * 16, b = row >> 11, t = row & 2047;
#pragma unroll
                    for (int bj = 0; bj < 2; ++bj) { const int bh = b * 4 + 2 * (pn - 6) + bj;
                        st8(V + ((((size_t)bh * 32 + (t >> 6)) * 16 + (wc * 4 + ((t >> 4) & 3))) * 16 + (t & 15)) * 32 + 8 * fq, acc[ai][bj][m][0], acc[ai][bj][m][1]); } }
        } else if (pn < 6) {
            const bool isq = pn < 4; bf16_t* base = isq ? Q : K; const float* g = isq ? gq : gk; const float sc = isq ? (0.125f * LOG2E) : 1.0f;
            f32x4 gv[2][2];
#pragma unroll
            for (int bj = 0; bj < 2; ++bj) { gv[bj][0] = *(const f32x4*)(g + 32 * bj + 8 * fq); gv[bj][1] = *(const f32x4*)(g + 32 * bj + 8 * fq + 4); }
            const int col0 = (pn & 1) * 256 + 64 * wc + 8 * fq;
#pragma unroll
            for (int ai = 0; ai < 2; ++ai)
#pragma unroll
                for (int m = 0; m < 4; ++m) {
                    float ss = 0.f;
#pragma unroll
                    for (int bj = 0; bj < 2; ++bj)
#pragma unroll
                        for (int n = 0; n < 2; ++n) { const f32x4 x = acc[ai][bj][m][n]; ss += (x[0] * x[0] + x[1] * x[1]) + (x[2] * x[2] + x[3] * x[3]); }
                    ss += __shfl_xor(ss, 16); ss += __shfl_xor(ss, 32);
                    const float rinv = __builtin_amdgcn_rsqf(ss * (1.0f / 64.0f) + EPS) * sc;
                    const int row = row0 + ai * HALF + m * 16;
                    if (isq) { bf16_t* rowp = base + (size_t)row * 512 + col0;
#pragma unroll
                        for (int bj = 0; bj < 2; ++bj) st8(rowp + 32 * bj, acc[ai][bj][m][0] * rinv * gv[bj][0], acc[ai][bj][m][1] * rinv * gv[bj][1]);
                    } else {
                        const int b = row >> 11, t = row & 2047, sh = (pn - 4) * 4 + wc, bh = b * 4 + (sh >> 1), mm = sh & 1;
#pragma unroll
                        for (int bj = 0; bj < 2; ++bj) st8(base + (((((size_t)bh * 2 + mm) * 32 + (t >> 6)) * 8 + (4 * bj + fq)) * 64 + (t & 63)) * 8, acc[ai][bj][m][0] * rinv * gv[bj][0], acc[ai][bj][m][1] * rinv * gv[bj][1]);
                    }
                }
        } else {
            const int col0 = (pn - 8) * 128 + wc * 32 + 8 * fq;
#pragma unroll
            for (int ai = 0; ai < 2; ++ai)
#pragma unroll
                for (int m = 0; m < 4; ++m) { const size_t off = (size_t)(row0 + ai * HALF + m * 16) * 1024 + col0;
                    f32x4 r0, r1, a0, a1;
#pragma unroll
                    for (int i = 0; i < 4; ++i) {
                        const float ea0 = __builtin_amdgcn_exp2f(-acc[ai][1][m][0][i] * LOG2E), ea1 = __builtin_amdgcn_exp2f(-acc[ai][1][m][1][i] * LOG2E);
                        a0[i] = __builtin_amdgcn_rcpf(1.0f + ea0); a1[i] = __builtin_amdgcn_rcpf(1.0f + ea1);
                        r0[i] = sigm(acc[ai][0][m][0][i]) * (1.0f + ea0); r1[i] = sigm(acc[ai][0][m][1][i]) * (1.0f + ea1); }
                    st8(GP + off, r0, r1); st8(GA + off, a0, a1); }
        }
    }
};

struct EpiMerge {
    static constexpr bool PERM = true;
    const bf16_t *GP, *GA; bf16_t* O;
    __device__ __forceinline__ void prefetch(const Unit& u, int wr, int wc, int lane, LAS unsigned* junk) const {
#pragma unroll
        for (int q = 0; q < 4; ++q) { const int idx = q * 64 + lane, ri = idx >> 1, bj = idx & 1; const int row = u.pm * BM + 128 * (ri >> 6) + 64 * wr + (ri & 63);
            const size_t off = (size_t)row * 1024 + u.pn * BM + wc * 32 + bj * HALF; touch(GP + off, junk); touch(GA + off, junk); }
    }
    __device__ __forceinline__ void mid(f32x4 (&acc)[2][2][4][2], const Unit& u, int wr, int wc, int fr, int fq) const {
        int row0 = u.pm * BM + wr * 64 + fr; const int col0 = u.pn * BM + wc * 32 + 8 * fq;
        asm volatile("" : "+v"(row0));
#pragma unroll
        for (int ai = 0; ai < 2; ++ai) {
            u32x4 pv[4][2];
#pragma unroll
            for (int m = 0; m < 4; ++m) { const size_t off = (size_t)(row0 + ai * HALF + m * 16) * 1024 + col0;
#pragma unroll
                for (int bj = 0; bj < 2; ++bj) pv[m][bj] = *(const u32x4*)(GP + off + bj * HALF); }
#pragma unroll
            for (int m = 0; m < 4; ++m)
#pragma unroll
                for (int bj = 0; bj < 2; ++bj) { const u32x4 p = pv[m][bj];
                    const f32x4 r0 = {bflo(p.x), bfhi(p.x), bflo(p.y), bfhi(p.y)}, r1 = {bflo(p.z), bfhi(p.z), bflo(p.w), bfhi(p.w)};
                    acc[ai][bj][m][0] *= r0; acc[ai][bj][m][1] *= r1; }
            asm volatile("" ::: "memory");
        }
    }
    __device__ __forceinline__ void operator()(const f32x4 (&acc)[2][2][4][2], const Unit& u, int wr, int wc, int fr, int fq) const {
        const int row0 = u.pm * BM + wr * 64 + fr, col0 = u.pn * BM + wc * 32 + 8 * fq;
#pragma unroll
        for (int ai = 0; ai < 2; ++ai) {
            u32x4 av[4][2];
#pragma unroll
            for (int m = 0; m < 4; ++m)
#pragma unroll
                for (int bj = 0; bj < 2; ++bj) av[m][bj] = *(const u32x4*)(GA + (size_t)(row0 + ai * HALF + m * 16) * 1024 + col0 + bj * HALF);
#pragma unroll
            for (int m = 0; m < 4; ++m)
#pragma unroll
                for (int bj = 0; bj < 2; ++bj) { const u32x4 a = av[m][bj];
                    const f32x4 g0 = {bflo(a.x), bfhi(a.x), bflo(a.y), bfhi(a.y)}, g1 = {bflo(a.z), bfhi(a.z), bflo(a.w), bfhi(a.w)};
                    st8(O + (size_t)(row0 + ai * HALF + m * 16) * 1024 + col0 + bj * HALF, acc[ai][bj][m][0] * g0, acc[ai][bj][m][1] * g1); }
            asm volatile("" ::: "memory");
        }
    }
};

struct EpiRes {
    static constexpr bool PERM = true;
    const float* X; bf16_t* O;
    __device__ __forceinline__ void prefetch(const Unit& u, int wr, int wc, int lane, LAS unsigned* junk) const {
#pragma unroll
        for (int q = 0; q < 4; ++q) { const int idx = q * 64 + lane, ri = idx >> 1, bj = idx & 1; const int row = u.pm * BM + 128 * (ri >> 6) + 64 * wr + (ri & 63);
            touch(X + (size_t)row * 1024 + u.pn * BM + wc * 32 + bj * HALF, junk); }
    }
    __device__ __forceinline__ void mid(f32x4 (&)[2][2][4][2], const Unit&, int, int, int, int) const {}
    __device__ __forceinline__ void operator()(const f32x4 (&acc)[2][2][4][2], const Unit& u, int wr, int wc, int fr, int fq) const {
        const int row0 = u.pm * BM + wr * 64 + fr, col0 = u.pn * BM + wc * 32 + 8 * fq;
#pragma unroll
        for (int ai = 0; ai < 2; ++ai) {
            f32x4 xv[4][2][2];
#pragma unroll
            for (int m = 0; m < 4; ++m)
#pragma unroll
                for (int bj = 0; bj < 2; ++bj) { const float* xp = X + (size_t)(row0 + ai * HALF + m * 16) * 1024 + col0 + bj * HALF; xv[m][bj][0] = *(const f32x4*)xp; xv[m][bj][1] = *(const f32x4*)(xp + 4); }
#pragma unroll
            for (int m = 0; m < 4; ++m)
#pragma unroll
                for (int bj = 0; bj < 2; ++bj) st8(O + (size_t)(row0 + ai * HALF + m * 16) * 1024 + col0 + bj * HALF, xv[m][bj][0] + acc[ai][bj][m][0], xv[m][bj][1] + acc[ai][bj][m][1]);
            asm volatile("" ::: "memory");
        }
    }
};

struct EpiMoe1 {
    static constexpr bool PERM = true;
    __device__ __forceinline__ void prefetch(const Unit&, int, int, int, LAS unsigned*) const {}
    const float *SR, *SWLO, *SWHI; bf16_t* HDN;
    __device__ __forceinline__ void mid(f32x4 (&)[2][2][4][2], const Unit&, int, int, int, int) const {}
    __device__ __forceinline__ void operator()(const f32x4 (&acc)[2][2][4][2], const Unit& u, int wr, int wc, int fr, int fq) const {
        const int slot0 = u.pm * BM + wr * 64 + fr; const float* SW = (u.pn < 4) ? SWLO : SWHI;
        const int col0 = (u.pn >> 2) * 512 + (u.pn & 3) * 128 + wc * 32 + 8 * fq;
        float rsv[2][4], wv[2][4];
#pragma unroll
        for (int ai = 0; ai < 2; ++ai)
#pragma unroll
            for (int m = 0; m < 4; ++m) { rsv[ai][m] = SR[slot0 + ai * HALF + m * 16]; wv[ai][m] = SW[slot0 + ai * HALF + m * 16]; }
#pragma unroll
        for (int ai = 0; ai < 2; ++ai)
#pragma unroll
            for (int m = 0; m < 4; ++m) { const int slot = slot0 + ai * HALF + m * 16; const float rs = rsv[ai][m], w = wv[ai][m];
                f32x4 h0, h1;
#pragma unroll
                for (int i = 0; i < 4; ++i) { const float g0 = acc[ai][0][m][0][i] * rs, u0 = acc[ai][1][m][0][i] * rs, g1 = acc[ai][0][m][1][i] * rs, u1 = acc[ai][1][m][1][i] * rs;
                    h0[i] = g0 * sigm(g0) * u0 * w; h1[i] = g1 * sigm(g1) * u1 * w; }
                st8(HDN + (size_t)slot * 1024 + col0, h0, h1); }
    }
};

struct EpiMoe2 {
    static constexpr bool PERM = true;
    const int* STOK; const bf16_t* X1; float* O;
    __device__ __forceinline__ void prefetch(const Unit& u, int wr, int wc, int lane, LAS unsigned* junk) const {
#pragma unroll
        for (int q = 0; q < 4; ++q) { const int idx = q * 64 + lane, ri = idx >> 1, bj = idx & 1; int tok = STOK[u.pm * BM + 128 * (ri >> 6) + 64 * wr + (ri & 63)]; tok = tok < 0 ? 0 : tok;
            touch(X1 + (size_t)tok * 1024 + u.pn * BM + wc * 32 + bj * HALF, junk); }
    }
    __device__ __forceinline__ void mid(f32x4 (&)[2][2][4][2], const Unit&, int, int, int, int) const {}
    __device__ __forceinline__ void operator()(const f32x4 (&acc)[2][2][4][2], const Unit& u, int wr, int wc, int fr, int fq) const {
        const int slot0 = u.pm * BM + wr * 64 + fr, col0 = u.pn * BM + wc * 32 + 8 * fq;
        int tk[2][4];
#pragma unroll
        for (int ai = 0; ai < 2; ++ai)
#pragma unroll
            for (int m = 0; m < 4; ++m) tk[ai][m] = STOK[slot0 + ai * HALF + m * 16];
#pragma unroll
        for (int ai = 0; ai < 2; ++ai) {
            u32x4 xv[4][2];
#pragma unroll
            for (int m = 0; m < 4; ++m) { const int tok = tk[ai][m] < 0 ? 0 : tk[ai][m];
#pragma unroll
                for (int bj = 0; bj < 2; ++bj) xv[m][bj] = *(const u32x4*)(X1 + (size_t)tok * 1024 + col0 + bj * HALF); }
#pragma unroll
            for (int m = 0; m < 4; ++m) { const int tok = tk[ai][m];
                if (tok >= 0) { const size_t off = (size_t)tok * 1024 + col0;
#pragma unroll
                    for (int bj = 0; bj < 2; ++bj) { const u32x4 x = xv[m][bj];
                        const f32x4 x0 = {bflo(x.x), bfhi(x.x), bflo(x.y), bfhi(x.y)}, x1 = {bflo(x.z), bfhi(x.z), bflo(x.w), bfhi(x.w)};
                        *(f32x4*)(O + off + bj * HALF) = x0 + acc[ai][bj][m][0]; *(f32x4*)(O + off + bj * HALF + 4) = x1 + acc[ai][bj][m][1]; } } }
            asm volatile("" ::: "memory");
        }
    }
};

struct MoeSched {
    const LAS int* tab; const char* A; const char* B; const int* STOK; int mode;
    __device__ __forceinline__ bool next(int i, Unit& u) const {
        if (i >= 16) return false;
        const int tile = __builtin_amdgcn_readfirstlane(tab[i * 4 + 0]); if (tile < 0) return false;
        const int pn = __builtin_amdgcn_readfirstlane(tab[i * 4 + 1]), e0 = __builtin_amdgcn_readfirstlane(tab[i * 4 + 2]), e1 = __builtin_amdgcn_readfirstlane(tab[i * 4 + 3]);
        u.pm = tile; u.pn = pn; u.e0 = e0; u.e1 = e1;
        if (mode == 1) { const int e = (pn < 4) ? e0 : e1; u.a = A; u.b0 = B + ((size_t)e * 1024 * 1024 + (size_t)(pn & 3) * 256 * 1024) * 2; u.b1 = u.b0; }
        else { u.a = A + (size_t)tile * 256 * 1024 * 2; u.b0 = B + ((size_t)e0 * 1024 + (size_t)pn * 256) * 512 * 2; u.b1 = B + ((size_t)e1 * 1024 + (size_t)pn * 256) * 512 * 2; }
        return true;
    }
    __device__ __forceinline__ void offs(const Unit& u, const int (&Rr)[2], const int (&Cc)[2], unsigned (&off)[2][2]) const {
#pragma unroll
        for (int h = 0; h < 2; ++h)
#pragma unroll
            for (int i = 0; i < 2; ++i) { int tok = STOK[u.pm * 256 + h * 128 + Rr[i]]; tok = tok < 0 ? 0 : tok; off[h][i] = ((unsigned)tok * 1024u + (unsigned)Cc[i]) * 2u; }
    }
};
}

namespace att {
__device__ __forceinline__ int crow(int r, int hi) { return (r & 3) + 8 * (r >> 2) + 4 * hi; }
__device__ __forceinline__ void glds16(const void* gsrc, unsigned lds_dst) { unsigned keep;
    asm volatile("s_mov_b32 %0, m0\n\ts_mov_b32 m0, %2\n\ts_nop 0\n\tglobal_load_lds_dwordx4 %1, off\n\ts_mov_b32 m0, %0" : "=&s"(keep) : "v"(gsrc), "s"(lds_dst) : "memory"); }
typedef __attribute__((address_space(3))) const char* lds_cptr;
typedef short v4i16_t __attribute__((ext_vector_type(4)));
__device__ __forceinline__ s16x4 vtr(lds_cptr p) { return __builtin_bit_cast(s16x4, __builtin_amdgcn_ds_read_tr16_b64_v4i16((__attribute__((address_space(3))) v4i16_t*)p)); }
#define ATT_WAIT_BAR() asm volatile("s_waitcnt vmcnt(0) lgkmcnt(0)\n\ts_barrier" ::: "memory")
constexpr int SLOT = 32768;
constexpr int WSF_OFF = LDSCTL_OFF + 2048;
constexpr int XCH_OFF = 0;

__device__ __forceinline__ void attn_unit(int b, int h, int qb, const bf16_t* Q, const bf16_t* K, const bf16_t* V, bf16_t* DO, char* shm, float B2, float lam, const float* subg TP_PARAMS) {
    TP_BEGIN(25);
    const int tid = threadIdx.x, lane = tid & 63, r32 = lane & 31, hi = lane >> 5; const int wid = __builtin_amdgcn_readfirstlane(tid >> 6);
    const int mm = wid >> 2, wq = wid & 3;
    const long rowbase = (long)b * SEQ; const int q0 = qb * 128, i0 = q0 + wq * 32;
    const float aslope = LOG2E * __builtin_amdgcn_exp2f(-2.0f * (float)(h + 1));
    const unsigned lds0 = (unsigned)(uintptr_t)shm; const lds_cptr shm3 = (lds_cptr)shm;
    float* wsf = (float*)(shm + WSF_OFF) + wid * 64;
    const bf16_t* Qw = Q + (rowbase + i0 + r32) * 512 + h * 128 + mm * 64 + hi * 8;
    bf16x8 qr[4];
#pragma unroll
    for (int ks = 0; ks < 4; ++ks) qr[ks] = *(const bf16x8*)(Qw + ks * 16);
    const int bh = b * 4 + h;
    const bf16_t* ksrc0 = K + (((size_t)bh * 2 + 0) * 32 * 8 + wid) * 512 + lane * 8;
    const bf16_t* ksrc1 = K + (((size_t)bh * 2 + 1) * 32 * 8 + wid) * 512 + lane * 8;
    const int p0i = 2 * wid, p1i = 2 * wid + 1;
    const bf16_t* vsrc0 = V + ((size_t)bh * 32 * 16 + p0i) * 512 + lane * 8;
    const bf16_t* vsrc1 = vsrc0 + 512;
    const int NTL = 2 * qb + 2;
    int ts; { const int Dk = (int)((2.0f * B2 + 30.2f) / aslope) + 1; ts = q0 - Dk; ts = ts < 0 ? 0 : (ts >> 6); }
#define ATT_DMA(t, slot) do { const unsigned _s = lds0 + (unsigned)(slot) * SLOT; \
        glds16(ksrc0 + (size_t)(t) * 4096, (unsigned)__builtin_amdgcn_readfirstlane(_s + wid * 1024)); glds16(ksrc1 + (size_t)(t) * 4096, (unsigned)__builtin_amdgcn_readfirstlane(_s + 8192 + wid * 1024)); \
        glds16(vsrc0 + (size_t)(t) * 8192, (unsigned)__builtin_amdgcn_readfirstlane(_s + 16384 + p0i * 1024)); glds16(vsrc1 + (size_t)(t) * 8192, (unsigned)__builtin_amdgcn_readfirstlane(_s + 16384 + p1i * 1024)); } while (0)
    ATT_DMA(ts, ts & 3); ATT_DMA(ts + 1, (ts + 1) & 3);
#if defined(ATT_PRIO_YOUNG)
    if (wid >= 4) __builtin_amdgcn_s_setprio(1);
#endif
    f32x16 o[4]; o[0] = f32x16{}; o[1] = f32x16{}; o[2] = f32x16{}; o[3] = f32x16{};
    float l_reg = 0.f;
    const int irow = i0 + r32;
    u32x4 qbias, kbias0, kbias1;
    { const float a_h = bf2f((unsigned short)f2bf(aslope)), r1 = aslope - a_h, a_m = bf2f((unsigned short)f2bf(r1)), a_l = bf2f((unsigned short)f2bf(r1 - a_m));
      const unsigned j0b = f2bf((float)r32), j1b = f2bf((float)(r32 + 32));
      qbias  = hi ? (u32x4){0u, 0u, 0u, 0u} : (u32x4){f2bf(a_h) | (f2bf(a_m) << 16), f2bf(a_l), 0u, 0u};
      kbias0 = hi ? (u32x4){0u, 0u, 0u, 0u} : (u32x4){j0b | (j0b << 16), j0b, 0u, 0u};
      kbias1 = hi ? (u32x4){0u, 0u, 0u, 0u} : (u32x4){j1b | (j1b << 16), j1b, 0u, 0u}; }
    __builtin_amdgcn_s_waitcnt(0x0F70);
    TP_END(25);
    const int vlane = ((lane >> 4) & 1) * 32 + (lane & 3) * 8 + (4 * hi + ((lane & 15) >> 2)) * 64;
    f32x16 cini; { const float c0 = aslope * (float)(64 * ts - irow) - B2; _Pragma("unroll") for (int r = 0; r < 16; ++r) cini[r] = c0; }
    const float cstep = 64.0f * aslope;
#define ATT_VRD(g) vtr(vp + ((g) >> 2) * 4096 + ((g) & 3) * 1024), vtr(vp + ((g) >> 2) * 4096 + ((g) & 3) * 1024 + 512)
#define ATT_PV(SL) do { const lds_cptr vp = shm3 + (SL) * SLOT + 16384 + vlane; \
        s16x4 vf[2][2]; \
        { const s16x4 a0[2] = {ATT_VRD(0)}, a1[2] = {ATT_VRD(1)}; vf[0][0] = a0[0]; vf[0][1] = a0[1]; vf[1][0] = a1[0]; vf[1][1] = a1[1]; } \
        __builtin_amdgcn_sched_barrier(0); \
        _Pragma("unroll") for (int g = 0; g < 16; ++g) {            \
            const s16x4 lo = vf[g & 1][0], hh = vf[g & 1][1]; \
            const bf16x8 vfr = (bf16x8){lo[0], lo[1], lo[2], lo[3], hh[0], hh[1], hh[2], hh[3]}; \
            o[g >> 2] = __builtin_amdgcn_mfma_f32_32x32x16_bf16(__builtin_bit_cast(bf16x8, pw[g & 3]), vfr, o[g >> 2], 0, 0, 0); \
            if (g + 2 < 16) { const s16x4 a3[2] = {ATT_VRD(g + 2)}; vf[g & 1][0] = a3[0]; vf[g & 1][1] = a3[1]; } \
            __builtin_amdgcn_sched_barrier(0); } \
        } while (0)
#define ATT_TILE(MASKED) do { \
        TP_BEGIN(21); \
        if (t + 1 < NTL) asm volatile("s_waitcnt vmcnt(4) lgkmcnt(0)\n\ts_barrier" ::: "memory"); else ATT_WAIT_BAR(); \
        TP_END(21); TP_BEGIN(22); \
        if (t + 2 < NTL) ATT_DMA(t + 2, (t + 2) & 3); \
        TP_END(22); TP_BEGIN(23); \
        const int j0 = 64 * t; \
        if (!(MASKED) || j0 <= i0 + 31) { \
            const char* kb = shm + (t & 3) * SLOT + mm * 8192 + hi * 1024 + r32 * 16; \
            bf16x8 kf[2]; kf[0] = *(const bf16x8*)(kb); kf[1] = *(const bf16x8*)(kb + 512);     \
            __builtin_amdgcn_sched_barrier(0); \
            f32x16 p0 = __builtin_amdgcn_mfma_f32_32x32x16_bf16(__builtin_bit_cast(bf16x8, kbias0), __builtin_bit_cast(bf16x8, qbias), cini, 0, 0, 0); \
            f32x16 p1 = __builtin_amdgcn_mfma_f32_32x32x16_bf16(__builtin_bit_cast(bf16x8, kbias1), __builtin_bit_cast(bf16x8, qbias), cini, 0, 0, 0); \
            __builtin_amdgcn_sched_barrier(0); \
            _Pragma("unroll") for (int f = 0; f < 8; ++f) { \
                if (f & 1) p1 = __builtin_amdgcn_mfma_f32_32x32x16_bf16(kf[1], qr[f >> 1], p1, 0, 0, 0); else p0 = __builtin_amdgcn_mfma_f32_32x32x16_bf16(kf[0], qr[f >> 1], p0, 0, 0, 0); \
                if (f + 2 < 8) kf[f & 1] = *(const bf16x8*)(kb + ((f + 2) >> 1) * 2048 + (f & 1) * 512); \
                __builtin_amdgcn_sched_barrier(0); } \
            if (MASKED) { const int jb = j0 + 4 * hi; \
                _Pragma("unroll") for (int r = 0; r < 16; ++r) { const int j = jb + (r & 3) + 8 * (r >> 2); if (j > irow) p0[r] = -1.0e30f; if (j + 32 > irow) p1[r] = -1.0e30f; } } \
            float sacc = 0.f; \
            _Pragma("unroll") for (int r = 0; r < 16; ++r) { p0[r] = __builtin_amdgcn_exp2f(p0[r]); p1[r] = __builtin_amdgcn_exp2f(p1[r]); sacc += p0[r] + p1[r]; } \
            l_reg += sacc; \
            u32x4 pw[4]; \
            pw[0] = (u32x4){cvt_pk_bf16(p0[0], p0[1]), cvt_pk_bf16(p0[2], p0[3]), cvt_pk_bf16(p0[4], p0[5]), cvt_pk_bf16(p0[6], p0[7])}; \
            pw[1] = (u32x4){cvt_pk_bf16(p0[8], p0[9]), cvt_pk_bf16(p0[10], p0[11]), cvt_pk_bf16(p0[12], p0[13]), cvt_pk_bf16(p0[14], p0[15])}; \
            pw[2] = (u32x4){cvt_pk_bf16(p1[0], p1[1]), cvt_pk_bf16(p1[2], p1[3]), cvt_pk_bf16(p1[4], p1[5]), cvt_pk_bf16(p1[6], p1[7])}; \
            pw[3] = (u32x4){cvt_pk_bf16(p1[8], p1[9]), cvt_pk_bf16(p1[10], p1[11]), cvt_pk_bf16(p1[12], p1[13]), cvt_pk_bf16(p1[14], p1[15])}; \
            TP_END(23); TP_BEGIN(24); \
            ATT_PV(t & 3); \
            TP_END(24); TP_BEGIN(23); \
        } TP_END(23); \
        _Pragma("unroll") for (int r = 0; r < 16; ++r) cini[r] += cstep; } while (0)
    int t = ts;
    for (; t < NTL - 2; ++t) ATT_TILE(false);
    for (; t < NTL; ++t) ATT_TILE(true);
#undef ATT_PV
#undef ATT_VRD
    TP_BEGIN(26);
#undef ATT_TILE
    { auto rr = __builtin_amdgcn_permlane32_swap(__float_as_uint(l_reg), __float_as_uint(l_reg), false, false); l_reg = __uint_as_float(rr[0]) + __uint_as_float(rr[1]); }
    if (hi == 0) wsf[r32] = l_reg;
    asm volatile("s_waitcnt lgkmcnt(0)" ::: "memory");
    const float fac = (mm == 0) ? 1.0f : lam;
#pragma unroll
    for (int r = 0; r < 16; ++r) { const float rl = fac * __builtin_amdgcn_rcpf(wsf[crow(r, hi)]);
#pragma unroll
        for (int d0 = 0; d0 < 4; ++d0) o[d0][r] *= rl; }
    TP_BEGIN(27);
    ATT_WAIT_BAR();
    TP_END(27); TP_BEGIN(28);
    float* xch = (float*)(shm + XCH_OFF) + (size_t)wq * 32 * 128;
    if (mm == 1) {
#pragma unroll
        for (int r = 0; r < 16; ++r)
#pragma unroll
            for (int d0 = 0; d0 < 4; ++d0) xch[crow(r, hi) * 128 + 32 * d0 + r32] = o[d0][r];
    }
    ATT_WAIT_BAR();
    bf16_t* stg = (bf16_t*)(shm + 65536);
    if (mm == 0) {
        float gsub[4];
#pragma unroll
        for (int d0 = 0; d0 < 4; ++d0) gsub[d0] = subg[32 * d0 + r32] * 0.8f;
#pragma unroll
        for (int r = 0; r < 16; ++r) {
            float ss = 0.f;
#pragma unroll
            for (int d0 = 0; d0 < 4; ++d0) { o[d0][r] -= xch[crow(r, hi) * 128 + 32 * d0 + r32]; ss += o[d0][r] * o[d0][r]; }
            ss += __shfl_xor(ss, 1); ss += __shfl_xor(ss, 2); ss += __shfl_xor(ss, 4); ss += __shfl_xor(ss, 8); ss += __shfl_xor(ss, 16);
            const float rinv = __builtin_amdgcn_rsqf(ss * (1.0f / 128.0f) + EPS);
            bf16_t* srow = stg + (wq * 32 + crow(r, hi)) * 128 + r32;
#pragma unroll
            for (int d0 = 0; d0 < 4; ++d0) srow[32 * d0] = (bf16_t)f2bf(o[d0][r] * rinv * gsub[d0]);
        }
    }
    ATT_WAIT_BAR();
    { const int row = tid >> 2, q4 = tid & 3;
      const bf16_t* sp = stg + row * 128 + q4 * 32; bf16_t* gp = DO + (size_t)(rowbase + q0 + row) * 1024 + 512 + h * 128 + q4 * 32;
      u32x4 v[4];
#pragma unroll
      for (int i = 0; i < 4; ++i) v[i] = *(const u32x4*)(sp + i * 8);
#pragma unroll
      for (int i = 0; i < 4; ++i) *(u32x4*)(gp + i * 8) = v[i]; }
    asm volatile("s_waitcnt lgkmcnt(0)" ::: "memory");
    TP_END(28);
    TP_END(26);
#undef ATT_DMA
}
}

struct Args { const float* in[23]; float* out; unsigned char* ws; };

__device__ __forceinline__ float wave_sum(float v) {
#pragma unroll
    for (int o = 1; o < 64; o <<= 1) v += __shfl_xor(v, o);
    return v;
}
__device__ __forceinline__ float wave_max(float v) {
#pragma unroll
    for (int o = 1; o < 64; o <<= 1) v = fmaxf(v, __shfl_xor(v, o));
    return v;
}

template <class DstF>
__device__ __forceinline__ void transpose_item(const float* W, int N, int k0, int n0, LAS float* scr, int lane, const float* ksc, DstF dst) {
    const int kk = lane >> 3, n4 = (lane & 7) * 4;
    f32x4 v[8];
#pragma unroll
    for (int j = 0; j < 8; ++j) v[j] = *(const f32x4*)(W + (size_t)(k0 + kk + 8 * j) * N + n0 + n4);
#pragma unroll
    for (int j = 0; j < 8; ++j) { LAS float* d = scr + (kk + 8 * j) * 33 + n4; d[0] = v[j][0]; d[1] = v[j][1]; d[2] = v[j][2]; d[3] = v[j][3]; }
    LDS_WAIT(); asm volatile("" ::: "memory");
    const int c = lane & 7;
    f32x4 s0 = {1.f, 1.f, 1.f, 1.f}, s1 = s0;
    if (ksc) { s0 = *(const f32x4*)(ksc + k0 + 8 * c); s1 = *(const f32x4*)(ksc + k0 + 8 * c + 4); }
#pragma unroll
    for (int j = 0; j < 4; ++j) { const int n = (lane >> 3) + 8 * j; const LAS float* s = scr + (8 * c) * 33 + n;
        u32x4 o; o.x = pk2(s[0 * 33] * s0[0], s[1 * 33] * s0[1]); o.y = pk2(s[2 * 33] * s0[2], s[3 * 33] * s0[3]); o.z = pk2(s[4 * 33] * s1[0], s[5 * 33] * s1[1]); o.w = pk2(s[6 * 33] * s1[2], s[7 * 33] * s1[3]);
        *(GAS u32x4*)(dst(n0 + n) + k0 + 8 * c) = o; }
    LDS_WAIT(); asm volatile("" ::: "memory");
}

#define PH_BEGIN() unsigned char* ws = args.ws; asm volatile("" : "+s"(ws)); int tid = threadIdx.x; asm volatile("" : "+v"(tid)); \
    const int lane = tid & 63, wave = __builtin_amdgcn_readfirstlane(tid >> 6); const int G = gridDim.x, bx = blockIdx.x; \
    const int vcu = (G % 8 == 0) ? (bx % 8) * (G / 8) + bx / 8 : bx; const int gw = vcu * NWAVES + wave, NGW = G * NWAVES; \
    gu32* ctl = (gu32*)(ws + WS_CTL); (void)lane; (void)wave; (void)gw; (void)NGW; (void)ctl; (void)vcu
#define WSP(T, off) ((T*)(ws + (off)))

#ifndef DEPHASE3
#define DEPHASE3 0
#endif
#ifndef DEPHASE4
#define DEPHASE4 0
#endif
#ifndef DEPHASE8
#define DEPHASE8 0
#endif
__device__ __forceinline__ void dephase(int vcu, unsigned ticks) {
    if ((vcu & 1) && ticks) { const unsigned long long t0 = __builtin_amdgcn_s_memrealtime(); while (__builtin_amdgcn_s_memrealtime() - t0 < ticks) __builtin_amdgcn_s_sleep(16); }
}
__global__ void __launch_bounds__(NWAVES * 64, 2) hybrid_fwd(Args args) {
    extern __shared__ __attribute__((aligned(16))) unsigned char lds[];
    LAS unsigned char* L = (LAS unsigned char*)lds;
    volatile LAS unsigned* MISC = (volatile LAS unsigned*)(L + MISC_OFF);
    for (int u = threadIdx.x; u < (LDS_BYTES - LDSCTL_OFF) / 4; u += NWAVES * 64) ((LAS unsigned*)(L + LDSCTL_OFF))[u] = 0u;
    __syncthreads();
    XcdBarrier bar = xcd_barrier_post((unsigned*)((gu32*)(args.ws + WS_CTL) + CW_BAR), MISC + 8);
    TP_DECL();

    TP_BEGIN(10);
    if (PHASE_MASK & 1) REPS(1) {
        PH_BEGIN();
        bf16_t* WinT = WSP(bf16_t, WS_WIN); bf16_t* WmT = WSP(bf16_t, WS_WM); bf16_t* WoT = WSP(bf16_t, WS_WO); bf16_t* WguT = WSP(bf16_t, WS_WGU); bf16_t* WdT = WSP(bf16_t, WS_WD);
        bf16_t* WrH = WSP(bf16_t, WS_WRH); bf16_t* WrL = WSP(bf16_t, WS_WRL); bf16_t* Hb = WSP(bf16_t, WS_H);
        LAS float* scr = (LAS float*)(L + wave * 16384);
        constexpr int I_IN = 16 * 128, I_AU = 8 * 32, I_OUT = 16 * 32, I_G = 32 * 256, I_U = 32 * 256, I_D = 32 * 256;
        constexpr int NITEMS = I_IN + I_AU + I_OUT + I_G + I_U + I_D;
        TP_BEGIN(30);
        for (int it = gw; it < NITEMS; it += NGW) {
            int r = it;
            if (r < I_IN) { const int kb = r / 128, nb = r % 128;
                transpose_item(args.in[2], 4096, kb * 64, nb * 32, scr, lane, nullptr, [&](int n) -> bf16_t* {
                    int v = n; if (n >= 512 && n < 1536) { const int l = n & 255; v = (n & ~255) + 128 * ((l >> 5) & 1) + 32 * (l >> 6) + (l & 31); }
                    else if (n >= 2048) { const int c = (n - 2048) & 1023; v = 2048 + 256 * (c >> 7) + (c & 127) + ((n >= 3072) ? 128 : 0); }
                    return WinT + (size_t)v * 1024; });
                continue; } r -= I_IN;
            if (r < I_AU) { const int kb = r / 32, nb = r % 32;
                transpose_item(args.in[13], 1024, kb * 64, nb * 32, scr, lane, nullptr, [&](int n) -> bf16_t* { return WmT + (size_t)n * 1024 + 512; }); continue; } r -= I_AU;
            if (r < I_OUT) { const int kb = r / 32, nb = r % 32;
                transpose_item(args.in[14], 1024, kb * 64, nb * 32, scr, lane, nullptr, [&](int n) -> bf16_t* { return WoT + (size_t)n * 1024; }); continue; } r -= I_OUT;
            if (r < I_G) { const int e = r / 256, q = r % 256, kb = q / 16, nb = q % 16;
                transpose_item(args.in[20] + (size_t)e * 1024 * 512, 512, kb * 64, nb * 32, scr, lane, args.in[15], [&](int n) -> bf16_t* { return WguT + (size_t)e * 1024 * 1024 + (size_t)(256 * (n >> 7) + (n & 127)) * 1024; }); continue; } r -= I_G;
            if (r < I_U) { const int e = r / 256, q = r % 256, kb = q / 16, nb = q % 16;
                transpose_item(args.in[21] + (size_t)e * 1024 * 512, 512, kb * 64, nb * 32, scr, lane, args.in[15], [&](int n) -> bf16_t* { return WguT + (size_t)e * 1024 * 1024 + (size_t)(256 * (n >> 7) + 128 + (n & 127)) * 1024; }); continue; } r -= I_U;
            { const int e = r / 256, q = r % 256, kb = q / 32, nb = q % 32;
                transpose_item(args.in[22] + (size_t)e * 512 * 1024, 1024, kb * 64, nb * 32, scr, lane, nullptr, [&](int n) -> bf16_t* { return WdT + ((size_t)e * 1024 + n) * 512; }); }
        }
        TP_END(30); TP_BEGIN(31);
        for (int it = gw; it < 2048; it += NGW) {
            const int kq = it >> 4, nb = it & 15, n = 64 * nb + lane, k = 4 * kq, g = k >> 7, kl = k & 127;
            const float* pw = args.in[3] + (size_t)(g * 128 + kl) * 128; const float* sc = args.in[4] + g * 128; const float* wu = args.in[5] + (size_t)(g * 128) * 1024 + n;
            float a0 = 0.f, a1 = 0.f, a2 = 0.f, a3 = 0.f;
            for (int c0 = 0; c0 < 128; c0 += 16) { float wv[16];
#pragma unroll
                for (int c = 0; c < 16; ++c) wv[c] = wu[(size_t)(c0 + c) * 1024];
#pragma unroll
                for (int c = 0; c < 16; ++c) { const float w2 = wv[c] * sc[c0 + c]; a0 += pw[c0 + c] * w2; a1 += pw[128 + c0 + c] * w2; a2 += pw[256 + c0 + c] * w2; a3 += pw[384 + c0 + c] * w2; } }
            u32x2 o; o.x = pk2(a0, a1); o.y = pk2(a2, a3);
            *(u32x2*)(WmT + (size_t)n * 1024 + k) = o;
        }
        TP_END(31); TP_BEGIN(32);
        for (int it = gw * 64 + lane; it < 48 * 1024; it += NGW * 64) {
            const int n = it >> 10, k = it & 1023; float w = 0.f;
            if (n < 4) w = args.in[16][k * 4 + n]; else if (n < 36) w = args.in[18][k * 32 + (n - 4)];
            w *= args.in[15][k];
            const unsigned hb = f2bf(w); const float lo = w - __builtin_bit_cast(float, hb << 16);
            WrH[it] = (bf16_t)hb; WrL[it] = (bf16_t)f2bf(lo);
        }
        TP_END(32); TP_BEGIN(33);
        { const float* x = args.in[0]; const GAS f32x4* g4 = (const GAS f32x4*)args.in[1] + lane; f32x4 gg[4];
#pragma unroll
          for (int j = 0; j < 4; ++j) gg[j] = g4[64 * j];
          for (int m = gw * 2; m < NTOK; m += NGW * 2) {
            const GAS f32x4* xr = (const GAS f32x4*)(x + (size_t)m * DM) + lane;
            f32x4 v[8]; float s0 = 0.f, s1 = 0.f;
#pragma unroll
            for (int j = 0; j < 8; ++j) v[j] = xr[64 * j];
#pragma unroll
            for (int j = 0; j < 4; ++j) { s0 += (v[j].x * v[j].x + v[j].y * v[j].y) + (v[j].z * v[j].z + v[j].w * v[j].w); s1 += (v[4 + j].x * v[4 + j].x + v[4 + j].y * v[4 + j].y) + (v[4 + j].z * v[4 + j].z + v[4 + j].w * v[4 + j].w); }
            const float r0 = __builtin_amdgcn_rsqf(wave_sum(s0) * (1.f / DM) + EPS), r1 = __builtin_amdgcn_rsqf(wave_sum(s1) * (1.f / DM) + EPS);
            GAS unsigned long long* o8 = (GAS unsigned long long*)(Hb + (size_t)m * DM) + lane;
#pragma unroll
            for (int j = 0; j < 8; ++j) { const f32x4 y = v[j] * (j < 4 ? r0 : r1) * gg[j & 3]; o8[64 * j] = (unsigned long long)pk2(y.x, y.y) | ((unsigned long long)pk2(y.z, y.w) << 32); }
          } }
        TP_END(33);
    }
    xcd_barrier(bar);
    TP_END(10);

    TP_BEGIN(11);
    if (PHASE_MASK & 2) REPS(2) {
        PH_BEGIN();
        gm::StaticOrder S; S.init(WSP(bf16_t, WS_H), WSP(bf16_t, WS_WIN), 1024, 1024, NTOK, 4096, G, bx);
        gm::EpiProj E{WSP(bf16_t, WS_U), WSP(bf16_t, WS_Q), WSP(bf16_t, WS_K), WSP(bf16_t, WS_V), WSP(bf16_t, WS_GP), WSP(bf16_t, WS_GA), args.in[6], args.in[7]};
        gm::gemm_phase<1, gm::EpiProj, gm::StaticOrder, gm::NT, false, false>(L, S, E, 1024, 1024 TP_ARGS);
    }
    xcd_barrier(bar);
    TP_END(11);

    TP_BEGIN(12);
    if (PHASE_MASK & 4) REPS(4) {
        PH_BEGIN();
        bf16_t* Ub = WSP(bf16_t, WS_U); bf16_t* DOb = WSP(bf16_t, WS_DO);
        float lam, B2;
        { const float a1 = args.in[8][lane] * args.in[9][lane], a2 = args.in[10][lane] * args.in[11][lane];
          lam = __expf(wave_sum(a1)) - __expf(wave_sum(a2)) + 0.2f;
          const float mq = wave_max(fabsf(args.in[6][lane])), mk = wave_max(fabsf(args.in[7][lane]));
          B2 = 8.0f * mq * mk * LOG2E * 1.02f + 0.5f; }
        TP_BEGIN(20);
        { LAS int* tick = (LAS int*)(L + LDSCTL_OFF + 512);
          const int bq = vcu >> 3; unsigned* qh = (unsigned*)(ctl + CW_ATTQ) + bq * 16;
          if (tid == 0) tick[0] = (int)atomicAdd(qh, 1u);
          __syncthreads();
          int idx = tick[0];
          while (idx < 64) {
              __syncthreads();
              if (tid == 0) tick[0] = (int)atomicAdd(qh, 1u);
              int h, qb; if (idx < 32) { h = 3 - (idx & 1); qb = 15 - (idx >> 1); } else if (idx < 48) { h = 1; qb = 47 - idx; } else { h = 0; qb = 63 - idx; }
              att::attn_unit(bq, h, qb, WSP(bf16_t, WS_Q), WSP(bf16_t, WS_K), WSP(bf16_t, WS_V), DOb, (char*)lds, B2, lam, args.in[12] TP_ARGS);
              __syncthreads();
              idx = tick[0];
          } }
        TP_END(20);
        { const int w = 2 << (lane >> 4);
          const bf16_t* Ul = Ub + lane * 8;
          for (int blk = gw; blk < NTOK / 8; blk += NGW) {
            const int tok0 = blk * 8, t0 = tok0 & (SEQ - 1);
            u32x4 hist[15], curv[8], oldv[8];
#pragma unroll
            for (int s = 1; s <= 15; ++s) { const int ok = (s < w) && (t0 - s >= 0); hist[s - 1] = *(const u32x4*)(Ul + (size_t)(ok ? tok0 - s : tok0) * 512); if (!ok) hist[s - 1] = (u32x4){0u, 0u, 0u, 0u}; }
#pragma unroll
            for (int tt = 0; tt < 8; ++tt) { curv[tt] = *(const u32x4*)(Ul + (size_t)(tok0 + tt) * 512);
                const int ok = (t0 + tt - w + 1 >= 0); oldv[tt] = *(const u32x4*)(Ul + (size_t)(ok ? tok0 + tt - w + 1 : tok0) * 512); if (!ok) oldv[tt] = (u32x4){0u, 0u, 0u, 0u}; }
            float S[8];
#pragma unroll
            for (int c = 0; c < 8; ++c) S[c] = 0.f;
#pragma unroll
            for (int s = 0; s < 15; ++s) { const u32x4 v = hist[s];
                S[0] += bflo(v.x); S[1] += bfhi(v.x); S[2] += bflo(v.y); S[3] += bfhi(v.y); S[4] += bflo(v.z); S[5] += bfhi(v.z); S[6] += bflo(v.w); S[7] += bfhi(v.w); }
#pragma unroll
            for (int tt = 0; tt < 8; ++tt) { const u32x4 v = curv[tt], q = oldv[tt]; const int t = t0 + tt;
                const float c0 = bflo(v.x), c1 = bfhi(v.x), c2 = bflo(v.y), c3 = bfhi(v.y), c4 = bflo(v.z), c5 = bfhi(v.z), c6 = bflo(v.w), c7 = bfhi(v.w);
                S[0] += c0; S[1] += c1; S[2] += c2; S[3] += c3; S[4] += c4; S[5] += c5; S[6] += c6; S[7] += c7;
                const float inv = 1.0f / (float)((t + 1 < w) ? t + 1 : w);
                u32x4 o; o.x = pk2(S[0] * inv - c0, S[1] * inv - c1); o.y = pk2(S[2] * inv - c2, S[3] * inv - c3); o.z = pk2(S[4] * inv - c4, S[5] * inv - c5); o.w = pk2(S[6] * inv - c6, S[7] * inv - c7);
                *(u32x4*)(DOb + (size_t)(tok0 + tt) * 1024 + lane * 8) = o;
                S[0] -= bflo(q.x); S[1] -= bfhi(q.x); S[2] -= bflo(q.y); S[3] -= bfhi(q.y); S[4] -= bflo(q.z); S[5] -= bfhi(q.z); S[6] -= bflo(q.w); S[7] -= bfhi(q.w); }
          } }
    }
    xcd_barrier(bar);
    TP_END(12);

    TP_BEGIN(13);
    if (PHASE_MASK & 8) REPS(8) {
        PH_BEGIN();
        gm::StaticOrder S; S.init(WSP(bf16_t, WS_DO), WSP(bf16_t, WS_WM), 1024, 1024, NTOK, 1024, G, bx);
        gm::EpiMerge E{WSP(bf16_t, WS_GP), WSP(bf16_t, WS_GA), WSP(bf16_t, WS_MERGED)};
        dephase(vcu, DEPHASE3);
        gm::gemm_phase<3, gm::EpiMerge, gm::StaticOrder, gm::NT, false, true>(L, S, E, 1024, 1024 TP_ARGS);
    }
    xcd_barrier(bar);
    TP_END(13);

    TP_BEGIN(14);
    if (PHASE_MASK & 16) REPS(16) {
        PH_BEGIN();
        gm::StaticOrder S; S.init(WSP(bf16_t, WS_MERGED), WSP(bf16_t, WS_WO), 1024, 1024, NTOK, 1024, G, bx);
        gm::EpiRes E{args.in[0], WSP(bf16_t, WS_X1)};
        dephase(vcu, DEPHASE4);
        gm::gemm_phase<4, gm::EpiRes, gm::StaticOrder, gm::NT, false, false>(L, S, E, 1024, 1024 TP_ARGS);
    }
    xcd_barrier(bar);
    TP_END(14);

    TP_BEGIN(15);
    if (PHASE_MASK & 32) {
        PH_BEGIN();
        float* rstd2 = WSP(float, WS_RSTD); int* tcls = WSP(int, WS_TCLS); float* twlo = WSP(float, WS_TWLO); float* twhi = WSP(float, WS_TWHI);
        int* stok = WSP(int, WS_STOK); float* swlo = WSP(float, WS_SWLO); float* swhi = WSP(float, WS_SWHI); float* srstd = WSP(float, WS_SRSTD);
        const bf16_t* X1 = WSP(bf16_t, WS_X1); const bf16_t* WrH = WSP(bf16_t, WS_WRH); const bf16_t* WrL = WSP(bf16_t, WS_WRL);
        for (int i = gw * 64 + lane; i < MAXT * 256; i += NGW * 64) { stok[i] = -1; swlo[i] = 0.f; swhi[i] = 0.f; srstd[i] = 0.f; }
        constexpr int TROW = 1040, LG_OFF = 96 * TROW;
        const int row = lane & 15, kg = lane >> 4;
        const int tok0 = gw * 32;
        f32x4 acc[2][3];
#pragma unroll
        for (int rg = 0; rg < 2; ++rg)
#pragma unroll
            for (int nf = 0; nf < 3; ++nf) acc[rg][nf] = (f32x4){0.f, 0.f, 0.f, 0.f};
        float ss[2] = {0.f, 0.f};
        for (int blk0 = 0; blk0 < NTOK; blk0 += NGW * 32) {
          const int tb = blk0 + tok0; const bool live = tb < NTOK;
          for (int half = 0; half < 2; ++half) {
            __syncthreads();
            for (int i = tid; i < 96 * 64; i += NWAVES * 64) { const int r = i >> 6, c = i & 63;
                const bf16_t* src = (r < 48 ? WrH + (size_t)r * 1024 : WrL + (size_t)(r - 48) * 1024) + half * 512 + c * 8;
                *(LAS u32x4*)(L + r * TROW + c * 16) = *(const u32x4*)src; }
            __syncthreads();
            if (live) {
                const bf16_t* xa = X1 + (size_t)(tb + row) * 1024 + half * 512 + kg * 16;
#pragma unroll 4
                for (int sp = 0; sp < 8; ++sp) {
                    u32x4 A[2][2];
#pragma unroll
                    for (int rg = 0; rg < 2; ++rg) { A[rg][0] = *(const u32x4*)(xa + (size_t)rg * 16 * 1024 + sp * 64); A[rg][1] = *(const u32x4*)(xa + (size_t)rg * 16 * 1024 + sp * 64 + 8); }
#pragma unroll
                    for (int rg = 0; rg < 2; ++rg)
#pragma unroll
                        for (int hh = 0; hh < 2; ++hh) { const u32x4 v = A[rg][hh];
                            const float f0 = bflo(v.x), f1 = bfhi(v.x), f2 = bflo(v.y), f3 = bfhi(v.y), f4 = bflo(v.z), f5 = bfhi(v.z), f6 = bflo(v.w), f7 = bfhi(v.w);
                            ss[rg] += (f0 * f0 + f1 * f1) + (f2 * f2 + f3 * f3) + (f4 * f4 + f5 * f5) + (f6 * f6 + f7 * f7); }
#pragma unroll
                    for (int hh = 0; hh < 2; ++hh)
#pragma unroll
                        for (int nf = 0; nf < 3; ++nf) {
                            const bf16x8 Bh = *(const LAS bf16x8*)(L + (nf * 16 + row) * TROW + (sp * 64 + kg * 16 + hh * 8) * 2);
                            const bf16x8 Bl = *(const LAS bf16x8*)(L + (48 + nf * 16 + row) * TROW + (sp * 64 + kg * 16 + hh * 8) * 2);
#pragma unroll
                            for (int rg = 0; rg < 2; ++rg) { const bf16x8 Af = __builtin_bit_cast(bf16x8, A[rg][hh]);
                                acc[rg][nf] = __builtin_amdgcn_mfma_f32_16x16x32_bf16(Af, Bh, acc[rg][nf], 0, 0, 0);
                                acc[rg][nf] = __builtin_amdgcn_mfma_f32_16x16x32_bf16(Af, Bl, acc[rg][nf], 0, 0, 0); }
                        }
                }
            }
          }
          if (live) {
            LAS float* lg = (LAS float*)(L + LG_OFF + wave * 3072);
#pragma unroll
            for (int rg = 0; rg < 2; ++rg) {
                float s2 = ss[rg]; s2 += __shfl_xor(s2, 16); s2 += __shfl_xor(s2, 32);
                const float rstd = __builtin_amdgcn_rsqf(s2 * (1.0f / 1024.0f) + EPS);
#pragma unroll
                for (int nf = 0; nf < 3; ++nf)
#pragma unroll
                    for (int r = 0; r < 4; ++r) lg[(4 * kg + r) * 48 + 16 * nf + row] = acc[rg][nf][r];
                LDS_WAIT(); asm volatile("" ::: "memory");
                if (lane < 16) {
                    const int tok = tb + rg * 16 + lane;
                    const LAS float* my = lg + lane * 48;
                    float gl[4]; int g = 0;
#pragma unroll
                    for (int j = 0; j < 4; ++j) gl[j] = rstd * my[j] + args.in[17][j];
                    float gmx = gl[0];
#pragma unroll
                    for (int j = 1; j < 4; ++j) if (gl[j] > gmx) { gmx = gl[j]; g = j; }
                    float den = 0.f;
#pragma unroll
                    for (int j = 0; j < 4; ++j) den += __expf(gl[j] - gmx);
                    const float ptop = 1.0f / den;
                    float le[8];
#pragma unroll
                    for (int e = 0; e < 8; ++e) le[e] = rstd * my[4 + g * 8 + e] + args.in[19][g * 8 + e];
                    int e1 = 0; float v1 = le[0];
#pragma unroll
                    for (int e = 1; e < 8; ++e) if (le[e] > v1) { v1 = le[e]; e1 = e; }
                    int e2 = -1; float v2 = -3.0e38f;
#pragma unroll
                    for (int e = 0; e < 8; ++e) if (e != e1 && le[e] > v2) { v2 = le[e]; e2 = e; }
                    const float rr = __expf(v2 - v1), w1 = ptop / (1.0f + rr), w2 = ptop * rr / (1.0f + rr);
                    const int lo = e1 < e2 ? e1 : e2, hi2 = e1 < e2 ? e2 : e1;
                    const float wlo = e1 < e2 ? w1 : w2, whi = e1 < e2 ? w2 : w1;
                    const int cls = g * 28 + lo * 8 - (lo * (lo + 1)) / 2 + (hi2 - lo - 1);
                    tcls[tok] = cls; twlo[tok] = wlo; twhi[tok] = whi; rstd2[tok] = rstd;
                    atomicAdd((unsigned*)(ctl + CW_CNT) + cls * 16, 1u);
                }
                LDS_WAIT(); asm volatile("" ::: "memory");
                ss[rg] = 0.f;
#pragma unroll
                for (int nf = 0; nf < 3; ++nf) acc[rg][nf] = (f32x4){0.f, 0.f, 0.f, 0.f};
            }
          }
        }
    }
    xcd_barrier(bar);
    TP_END(15);

    TP_BEGIN(16);
    if (PHASE_MASK & 64) {
        PH_BEGIN();
        float* rstd2 = WSP(float, WS_RSTD); int* tcls = WSP(int, WS_TCLS); float* twlo = WSP(float, WS_TWLO); float* twhi = WSP(float, WS_TWHI);
        int* stok = WSP(int, WS_STOK); float* swlo = WSP(float, WS_SWLO); float* swhi = WSP(float, WS_SWHI); float* srstd = WSP(float, WS_SRSTD);
        int* tilecls = WSP(int, WS_TILECLS);
        LAS int* tstart = (LAS int*)(L);
        LAS int* cntl = (LAS int*)(L + 1024);
        if (tid < NCLS) cntl[tid] = (int)__hip_atomic_load((unsigned*)(ctl + CW_CNT) + tid * 16, RLX_AGENT);
        __syncthreads();
        if (tid == 0) { int s = 0; for (int c = 0; c < NCLS; ++c) { tstart[c] = s; s += (cntl[c] + 255) >> 8; } tstart[128] = s; }
        __syncthreads();
        if (bx == 0) {
            if (tid < NCLS) { const int t0 = tstart[tid], nt = (cntl[tid] + 255) >> 8; for (int t = 0; t < nt; ++t) tilecls[t0 + t] = tid; }
            if (tid == 0) __hip_atomic_store((unsigned*)(ctl + CW_NTILES), (unsigned)tstart[128], RLX_AGENT);
        }
        for (int tok = bx * 512 + tid; tok < NTOK; tok += G * 512) {
            const int c = tcls[tok];
            const unsigned pos = atomicAdd((unsigned*)(ctl + CW_CUR) + c * 16, 1u);
            const int slot = tstart[c] * 256 + (int)pos;
            stok[slot] = tok; swlo[slot] = twlo[tok]; swhi[slot] = twhi[tok]; srstd[slot] = rstd2[tok];
        }
    }
    xcd_barrier(bar);
    TP_END(16);

    TP_BEGIN(17);
    if (PHASE_MASK & 128) REPS(128) {
        PH_BEGIN();
        LAS int* utab = (LAS int*)(L + UTAB_OFF); const int* tilecls = WSP(int, WS_TILECLS);
        const int ntiles = (int)__hip_atomic_load((unsigned*)(ctl + CW_NTILES), RLX_AGENT);
        if (tid < 16) { const int Lx = tid * G + vcu; const int tile = Lx >> 3, pn = Lx & 7; int e0 = 0, e1 = 0, tl = -1;
            if (tile < ntiles) { const int cls = tilecls[tile]; const int g = cls / 28; int rem = cls % 28, lo = 0; while (rem >= 7 - lo) { rem -= 7 - lo; ++lo; } e0 = g * 8 + lo; e1 = g * 8 + lo + 1 + rem; tl = tile; }
            utab[tid * 4 + 0] = tl; utab[tid * 4 + 1] = pn; utab[tid * 4 + 2] = e0; utab[tid * 4 + 3] = e1; }
        __syncthreads();
        gm::MoeSched S{utab, (const char*)WSP(bf16_t, WS_X1), (const char*)WSP(bf16_t, WS_WGU), WSP(int, WS_STOK), 1};
        gm::EpiMoe1 E{WSP(float, WS_SRSTD), WSP(float, WS_SWLO), WSP(float, WS_SWHI), WSP(bf16_t, WS_HDN)};
        gm::gemm_phase<7, gm::EpiMoe1, gm::MoeSched, gm::NT, true, false>(L, S, E, 1024, 1024 TP_ARGS);
    }
    xcd_barrier(bar);
    TP_END(17);
    TP_BEGIN(18);
    if (PHASE_MASK & 256) {
        PH_BEGIN();
        LAS int* utab = (LAS int*)(L + UTAB_OFF); const int* tilecls = WSP(int, WS_TILECLS);
        const int ntiles = (int)__hip_atomic_load((unsigned*)(ctl + CW_NTILES), RLX_AGENT);
        if (tid < 16) { const int Lx = tid * G + vcu; const int tile = Lx >> 2, pn = Lx & 3; int e0 = 0, e1 = 0, tl = -1;
            if (tile < ntiles) { const int cls = tilecls[tile]; const int g = cls / 28; int rem = cls % 28, lo = 0; while (rem >= 7 - lo) { rem -= 7 - lo; ++lo; } e0 = g * 8 + lo; e1 = g * 8 + lo + 1 + rem; tl = tile; }
            utab[tid * 4 + 0] = tl; utab[tid * 4 + 1] = pn; utab[tid * 4 + 2] = e0; utab[tid * 4 + 3] = e1; }
        __syncthreads();
        gm::MoeSched S{utab, (const char*)WSP(bf16_t, WS_HDN), (const char*)WSP(bf16_t, WS_WD), WSP(int, WS_STOK), 2};
        gm::EpiMoe2 E{WSP(int, WS_STOK), WSP(bf16_t, WS_X1), args.out};
        dephase(vcu, DEPHASE8);
        gm::gemm_phase<8, gm::EpiMoe2, gm::MoeSched, 8, false, false>(L, S, E, 1024, 512 TP_ARGS);
    }
    TP_END(18);
    TP_FINISH();
}

extern "C" void kernel_launch(void* const* d_in, const int* in_sizes, int n_in, void* d_out, int out_size, void* d_ws, size_t ws_size, hipStream_t stream) {
    static int grid = 0;
    if (grid == 0) {
        if (n_in != 23 || out_size != NTOK * DM || ws_size < WS_END) { fprintf(stderr, "kernel_launch: unexpected shapes (n_in %d, out %d, ws %zu)\n", n_in, out_size, ws_size); grid = -1; return; }
        int dev = 0, cus = 0;
        if (hipGetDevice(&dev) != hipSuccess || hipDeviceGetAttribute(&cus, hipDeviceAttributeMultiprocessorCount, dev) != hipSuccess) { grid = -1; return; }
        if (hipFuncSetAttribute((const void*)hybrid_fwd, hipFuncAttributeMaxDynamicSharedMemorySize, LDS_BYTES) != hipSuccess) { fprintf(stderr, "kernel_launch: hipFuncSetAttribute failed\n"); grid = -1; return; }
        int per_cu = 0;
        if (hipOccupancyMaxActiveBlocksPerMultiprocessor(&per_cu, (const void*)hybrid_fwd, NWAVES * 64, LDS_BYTES) != hipSuccess || per_cu < 1) fprintf(stderr, "kernel_launch: occupancy query says %d\n", per_cu);
        (void)hipGetLastError();
        grid = cus;
        if (grid != 256) fprintf(stderr, "kernel_launch: %d CUs (built for 256)\n", grid);
    }
    if (grid < 0) return;
    if (hipMemsetAsync((char*)d_ws + WS_CTL, 0, CTL_ZERO_BYTES, stream) != hipSuccess) return;
    Args a{};
    for (int i = 0; i < 23; ++i) a.in[i] = (const float*)d_in[i];
    a.out = (float*)d_out; a.ws = (unsigned char*)d_ws;
    hipLaunchKernelGGL(hybrid_fwd, dim3(grid), dim3(NWAVES * 64), LDS_BYTES, stream, a);
}
```

```cpp
#include <hip/hip_runtime.h>
#include <hip/hip_bf16.h>
#include <cstdio>
#include <cstdint>

#define LAS __attribute__((address_space(3)))
#define GAS __attribute__((address_space(1)))
typedef unsigned short bf16_t;
typedef short bf16x8 __attribute__((ext_vector_type(8)));
typedef short s16x4 __attribute__((ext_vector_type(4)));
typedef float f32x2 __attribute__((ext_vector_type(2)));
typedef float f32x4 __attribute__((ext_vector_type(4)));
typedef float f32x16 __attribute__((ext_vector_type(16)));
typedef unsigned u32x4 __attribute__((ext_vector_type(4)));
typedef unsigned u32x2 __attribute__((ext_vector_type(2)));
typedef GAS unsigned gu32;
#define RLX_AGENT __ATOMIC_RELAXED, __HIP_MEMORY_SCOPE_AGENT
#define LDS_WAIT() asm volatile("s_waitcnt lgkmcnt(0)" ::: "memory")
#define VM_WAIT() asm volatile("s_waitcnt vmcnt(0)" ::: "memory")

#ifndef PHASE_MASK
#define PHASE_MASK 0x1ff
#endif
#ifndef DUP_MASK
#define DUP_MASK 0
#endif
#ifdef TPROBE
#ifndef TP_AMP
#define TP_AMP 4
#endif
#ifndef TP_WAVE
#define TP_WAVE 0
#endif
__device__ __forceinline__ unsigned long long tp_now() { unsigned long long t; __builtin_amdgcn_sched_barrier(0); asm volatile("s_memrealtime %0\n\ts_waitcnt lgkmcnt(0)" : "=s"(t) :: "memory"); __builtin_amdgcn_sched_barrier(0); return t; }
#define TP_DECL() unsigned long long tp_t0 = 0, tp_acc = 0; (void)tp_t0
#define TP_PARAMS , unsigned long long& tp_t0, unsigned long long& tp_acc
#define TP_ARGS , tp_t0, tp_acc
#define TP_BEGIN(k) do { if ((k) == TPROBE) tp_t0 = tp_now(); } while (0)
#define TP_END(k) do { if ((k) == TPROBE) tp_acc += tp_now() - tp_t0; } while (0)
#define TP_FINISH() do { if (blockIdx.x == 0 && threadIdx.x == TP_WAVE * 64) { const unsigned long long s0 = tp_now(); while (tp_now() - s0 < tp_acc * TP_AMP) __builtin_amdgcn_s_sleep(8); } } while (0)
#else
#define TP_DECL()
#define TP_PARAMS
#define TP_ARGS
#define TP_BEGIN(k)
#define TP_END(k)
#define TP_FINISH()
#endif
#define REPS(bit) for (int rep_ = 0; rep_ < ((DUP_MASK & (bit)) ? 2 : 1); ++rep_)

constexpr int NTOK = 65536, DM = 1024, SEQ = 2048;
constexpr float LOG2E = 1.4426950408889634f;
constexpr float EPS = 1e-6f;
constexpr int NCLS = 112, MAXT = 368;
constexpr int NWAVES = 8;

constexpr size_t MiB = 1u << 20;
constexpr size_t WS_CTL = 0, CTL_ZERO_BYTES = 1 * MiB;
constexpr size_t WS_RSTD = 1 * MiB, WS_TCLS = WS_RSTD + 256 * 1024, WS_TWLO = WS_TCLS + 256 * 1024, WS_TWHI = WS_TWLO + 256 * 1024;
constexpr size_t WS_STOK = 2 * MiB, WS_SWLO = WS_STOK + 512 * 1024, WS_SWHI = WS_SWLO + 512 * 1024, WS_SRSTD = WS_SWHI + 512 * 1024;
constexpr size_t WS_TILECLS = 4 * MiB;
constexpr size_t WS_WRH = 5 * MiB, WS_WRL = WS_WRH + 128 * 1024;
constexpr size_t WS_WIN = 16 * MiB, WS_WM = 24 * MiB, WS_WO = 26 * MiB;
constexpr size_t WS_WGU = 32 * MiB, WS_WD = 96 * MiB;
constexpr size_t WS_H = 128 * MiB;
constexpr size_t WS_U = 256 * MiB, WS_Q = 320 * MiB, WS_K = 384 * MiB, WS_V = 448 * MiB;
constexpr size_t WS_GP = 512 * MiB, WS_GA = 640 * MiB;
constexpr size_t WS_DO = 768 * MiB;
constexpr size_t WS_END = 896 * MiB;
constexpr size_t WS_MERGED = WS_H, WS_X1 = WS_U, WS_HDN = WS_GP;
constexpr int CW_TMO = 0, CW_NTILES = 16, CW_BAR = 4096, CW_CNT = 8192, CW_CUR = 10240, CW_ATTQ = 12288;

constexpr int RING_BYTES = 131072;
constexpr int LDSCTL_OFF = RING_BYTES, MISC_OFF = LDSCTL_OFF + 320, UTAB_OFF = LDSCTL_OFF + 1024;
constexpr int JUNK_OFF = LDSCTL_OFF + 8192;
constexpr int LDS_BYTES = 147456;

__device__ __forceinline__ unsigned f2bf(float f) { unsigned u = __builtin_bit_cast(unsigned, f); return (u + 0x7fffu + ((u >> 16) & 1u)) >> 16; }
__device__ __forceinline__ unsigned pk2(float lo, float hi) { return f2bf(lo) | (f2bf(hi) << 16); }
__device__ __forceinline__ float bf2f(unsigned short b) { return __builtin_bit_cast(float, (unsigned)b << 16); }
__device__ __forceinline__ float bflo(unsigned w) { return __builtin_bit_cast(float, w << 16); }
__device__ __forceinline__ float bfhi(unsigned w) { return __builtin_bit_cast(float, w & 0xffff0000u); }
__device__ __forceinline__ unsigned cvt_pk_bf16(float lo, float hi) { unsigned r; asm("v_cvt_pk_bf16_f32 %0, %1, %2" : "=v"(r) : "v"(lo), "v"(hi)); return r; }

#define XB_TMO      128
#define XB_XCNT(j)  (256  + 64 * (j))
#define XB_XSUB(j)  (1280 + 64 * (j))
#define XB_XGEN(j)  (2304 + 64 * (j))
#define XB_TOP      3328
#define XB_TOPGEN   3392
#define XCD_BAR_WORDS 3456
#define XB_SPIN_CAP (1u << 18)
__device__ __forceinline__ unsigned xb_ld(unsigned* p)              { return __hip_atomic_load(p, __ATOMIC_RELAXED, __HIP_MEMORY_SCOPE_AGENT); }
__device__ __forceinline__ unsigned xb_add(unsigned* p, unsigned v) { return __hip_atomic_fetch_add(p, v, __ATOMIC_RELAXED, __HIP_MEMORY_SCOPE_AGENT); }
__device__ __forceinline__ unsigned xb_xcc_id() { return (unsigned)__builtin_amdgcn_s_getreg((3 << 11) | 20) & 0xFu; }
#define XB_SPIN(cond, bar) do { unsigned _sp = 0; while (cond) { __builtin_amdgcn_s_sleep(1); \
    if ((++_sp & 255u) == 0u) { if (xb_ld(&(bar)[XB_TMO])) break; if (_sp > XB_SPIN_CAP) { atomicAdd(&(bar)[XB_TMO], 1u); break; } } } } while (0)
struct XcdBarrier { unsigned* bar; unsigned x; volatile LAS unsigned* st; };
__device__ __forceinline__ XcdBarrier xcd_barrier_post(unsigned* bar, volatile LAS unsigned* st) {
    XcdBarrier b; b.bar = bar; b.x = xb_xcc_id(); b.st = st;
    if (threadIdx.x == 0) (void)xb_add(&bar[XB_XCNT(b.x)], 1u);
    return b;
}
__device__ __forceinline__ void xcd_barrier_complete(unsigned* bar, unsigned x, unsigned& nloc, unsigned& nx) {
    const unsigned G = gridDim.x * gridDim.y * gridDim.z;
    unsigned sum, cnt, mine, sp = 0u;
    for (;;) {
        sum = 0u; cnt = 0u; mine = 0u;
#pragma unroll
        for (unsigned j = 0; j < 16; ++j) { const unsigned c = xb_ld(&bar[XB_XCNT(j)]); sum += c; cnt += (c > 0u) ? 1u : 0u; mine = (j == x) ? c : mine; }
        if (sum == G) break;
        __builtin_amdgcn_s_sleep(1);
        if ((++sp & 255u) == 0u) { if (xb_ld(&bar[XB_TMO])) break; if (sp > XB_SPIN_CAP) { atomicAdd(&bar[XB_TMO], 1u); break; } }
    }
    nloc = mine > 0u ? mine : 1u; nx = cnt > 0u ? cnt : 1u;
}
__device__ __forceinline__ void xcd_barrier(const XcdBarrier& b) {
    asm volatile("s_waitcnt vmcnt(0)" ::: "memory");
    __syncthreads();
    if (threadIdx.x == 0) {
        unsigned* bar = b.bar;
        __builtin_amdgcn_s_waitcnt(0);
        unsigned nloc = b.st[0], nx = b.st[1];
        if (nloc == 0u) { xcd_barrier_complete(bar, b.x, nloc, nx); b.st[0] = nloc; b.st[1] = nx; }
        const unsigned old = xb_add(&bar[XB_XSUB(b.x)], 1u);
        const unsigned gen = old / nloc;
        if (old + 1u == (gen + 1u) * nloc) {
            __builtin_amdgcn_fence(__ATOMIC_RELEASE, "agent");
            asm volatile("s_waitcnt vmcnt(0)" ::: "memory");
            const unsigned og = xb_add(&bar[XB_TOP], 1u);
            const unsigned tg = og / nx;
            if (og + 1u == (tg + 1u) * nx) xb_add(&bar[XB_TOPGEN], 1u);
            else XB_SPIN(xb_ld(&bar[XB_TOPGEN]) == tg, bar);
            __builtin_amdgcn_fence(__ATOMIC_ACQUIRE, "agent");
            xb_add(&bar[XB_XGEN(b.x)], 1u);
            asm volatile("s_waitcnt vmcnt(0)" ::: "memory");
        } else {
            XB_SPIN(xb_ld(&bar[XB_XGEN(b.x)]) == gen, bar);
            __builtin_amdgcn_fence(__ATOMIC_ACQUIRE, "agent");
            asm volatile("s_waitcnt vmcnt(0)" ::: "memory");
        }
    }
    __syncthreads();
}

namespace gm {
constexpr int BM = 256, BK = 64, HALF = 128, HTB = HALF * BK * 2, NXCD = 8, WGM = 8, NT = 16;
__host__ __device__ __forceinline__ int lds_byte(int r, int c) { const int st = (r >> 4) * 2 + (c >> 5), rr = r & 15, cc = c & 31, ob = rr * 64 + cc * 2; return st * 1024 + (ob ^ (((ob >> 9) & 1) << 5)); }
__host__ __device__ __forceinline__ void stage_rc(int b, int& R, int& C) { const int st = b / 1024, sb = b % 1024, swz = sb ^ (((sb >> 9) & 1) << 5); R = (st >> 1) * 16 + swz / 64; C = (st & 1) * 32 + (swz % 64) / 2; }
__host__ __device__ __forceinline__ int perm32(int rho) { const int n = rho >> 4, i = rho & 15; return 8 * (i >> 2) + 4 * n + (i & 3); }

struct Unit { const char* a; const char* b0; const char* b1; int pm, pn, e0, e1, half; };

struct StaticOrder {
    const char* A; const char* Bt; int lda, ldb; int nM, nN, nwg, G, c;
    __device__ void init(const void* A_, const void* Bt_, int lda_, int ldb_, int M, int N, int G_, int c_) { A = (const char*)A_; Bt = (const char*)Bt_; lda = lda_; ldb = ldb_; nM = M / BM; nN = N / BM; nwg = nM * nN; G = G_; c = c_; }
    __device__ __forceinline__ bool next(int i, Unit& u) const {
        const long L = (long)i * G + c; if (L >= nwg) return false;
        int wgid = (int)L; { const int q = nwg / NXCD, r = nwg % NXCD, xcd = wgid % NXCD, off = wgid / NXCD; wgid = (xcd < r ? xcd * (q + 1) : r * (q + 1) + (xcd - r) * q) + off; }
        const int nig = WGM * nN, gid = wgid / nig, fm = gid * WGM, gsz = (nM - fm) < WGM ? (nM - fm) : WGM;
        u.pm = fm + ((wgid % nig) % gsz); u.pn = (wgid % nig) / gsz; u.e0 = 0; u.e1 = 0; u.half = 0;
        u.a = A + (size_t)u.pm * BM * lda * 2; u.b0 = Bt + (size_t)u.pn * BM * ldb * 2; u.b1 = u.b0;
        return true;
    }
    __device__ __forceinline__ void offs(const Unit&, const int (&)[2], const int (&)[2], unsigned (&)[2][2]) const {}
};

template <int PH, class Epi, class Sched, int KS, bool GATHER, bool MID>
__device__ __forceinline__ void gemm_phase(LAS unsigned char* lds, const Sched& S, const Epi& E, const int lda, const int ldb TP_PARAMS) {
    int tid = threadIdx.x; asm volatile("" : "+v"(tid));
    const int wid = __builtin_amdgcn_readfirstlane(tid >> 6), lane = tid & 63, wr = wid >> 2, wc = wid & 3, fr = lane & 15, fq = lane >> 4;
    int Rr[2], Cc[2]; unsigned offA[2][2], offAn[2][2], voffB[2];
#pragma unroll
    for (int i = 0; i < 2; ++i) { int R, C; stage_rc(tid * 16 + i * 8192, R, C); Rr[i] = R; Cc[i] = C; const int Rb = Epi::PERM ? ((R & ~31) + perm32(R & 31)) : R;
        voffB[i] = (unsigned)(Rb * ldb + C) * 2u;
        offA[0][i] = (unsigned)(R * lda + C) * 2u; offA[1][i] = (unsigned)((R + HALF) * lda + C) * 2u; offAn[0][i] = offA[0][i]; offAn[1][i] = offA[1][i]; }
    const size_t kstep = (size_t)(BK * 2);
    const size_t hstepB = (size_t)HALF * ldb * 2;
    const unsigned ldsw = (unsigned)wid * 1024u;
    const int aoff = lds_byte(wr * 64 + fr, fq * 8), boff = lds_byte(wc * 32 + fr, fq * 8);
#define G_SA(b, h) (((b) * 2 + (h)) * HTB)
#define G_SB(b, h) ((4 + (b) * 2 + (h)) * HTB)
#define G_STAGE_A(bufoff, gbase, OFF, h) do { _Pragma("unroll") for (int _i = 0; _i < 2; ++_i) \
        __builtin_amdgcn_global_load_lds((const unsigned*)((const char*)(gbase) + (OFF)[h][_i]), (LAS unsigned*)(lds + (bufoff) + ldsw + _i * 8192), 16, 0, 0); } while (0)
#define G_STAGE_B(bufoff, gbase) do { _Pragma("unroll") for (int _i = 0; _i < 2; ++_i) \
        __builtin_amdgcn_global_load_lds((const unsigned*)((const char*)(gbase) + voffB[_i]), (LAS unsigned*)(lds + (bufoff) + ldsw + _i * 8192), 16, 0, 0); } while (0)
#define G_LDA(dst, b, h) do { _Pragma("unroll") for (int m = 0; m < 4; ++m) _Pragma("unroll") for (int k = 0; k < 2; ++k) dst[m][k] = *(const LAS bf16x8*)(lds + G_SA(b, h) + aoff + m * 2048 + k * 1024); } while (0)
#define G_LDB(dst, b, h) do { _Pragma("unroll") for (int n = 0; n < 2; ++n) _Pragma("unroll") for (int k = 0; k < 2; ++k) dst[n][k] = *(const LAS bf16x8*)(lds + G_SB(b, h) + boff + n * 2048 + k * 1024); } while (0)
#define G_MMA(ai, bj, At, Bt) do { __builtin_amdgcn_s_setprio(1); _Pragma("unroll") for (int m = 0; m < 4; ++m) _Pragma("unroll") for (int n = 0; n < 2; ++n) _Pragma("unroll") for (int k = 0; k < 2; ++k) \
        acc[ai][bj][m][n] = __builtin_amdgcn_mfma_f32_16x16x32_bf16(Bt[n][k], At[m][k], acc[ai][bj][m][n], 0, 0, 0); __builtin_amdgcn_s_setprio(0); } while (0)
#define G_WAIT_V(n) asm volatile("s_waitcnt vmcnt(" #n ")" ::: "memory")
#define G_WAIT_L(n) asm volatile("s_waitcnt lgkmcnt(" #n ")" ::: "memory")
#define G_BAR __builtin_amdgcn_s_barrier()
#define G_SCHED __builtin_amdgcn_sched_barrier(0)
#define G_BP(u, t) ((t) < KS ? (u).b0 + (size_t)(t) * kstep : (u).b1 + (size_t)((t) - KS) * kstep)
    Unit cur, nxt; int ui = 0;
    if (!S.next(0, cur)) return;
    if constexpr (GATHER) S.offs(cur, Rr, Cc, offA);
    f32x4 acc[2][2][4][2];
#pragma unroll
    for (int a = 0; a < 2; ++a)
#pragma unroll
        for (int b = 0; b < 2; ++b)
#pragma unroll
            for (int m = 0; m < 4; ++m)
#pragma unroll
                for (int n = 0; n < 2; ++n) acc[a][b][m][n] = (f32x4){0.f, 0.f, 0.f, 0.f};
    bf16x8 At[4][2], B0[2][2], B1[2][2];
    {
        const char* cA = cur.a; const char* cB = cur.b0; const char* cB1 = G_BP(cur, 1);
        G_STAGE_B(G_SB(0, 0), cB); G_STAGE_B(G_SB(0, 1), cB + hstepB); G_STAGE_A(G_SA(0, 0), cA, offA, 0); G_STAGE_A(G_SA(0, 1), cA, offA, 1);
        if (wr == 1) G_BAR;
        G_WAIT_V(2); G_BAR;
        G_STAGE_B(G_SB(1, 0), cB1); G_STAGE_A(G_SA(1, 0), cA + kstep, offA, 0); G_STAGE_B(G_SB(1, 1), cB1 + hstepB);
        G_WAIT_V(6); G_BAR;
    }
    for (;;) {
        const bool has_next = S.next(ui + 1, nxt);
#if defined(EPI_PREFETCH)
        E.prefetch(cur, wr, wc, lane, (LAS unsigned*)(lds + JUNK_OFF + wid * 256));
#endif
        TP_BEGIN(100 + PH * 10);
        for (int t = 0; t < NT; t += 2) {
            const bool last = (t == NT - 2);
            if constexpr (MID) { if (t == NT / 2) { TP_BEGIN(102 + PH * 10); E.mid(acc, cur, wr, wc, fr, fq); TP_END(102 + PH * 10); } }
            if constexpr (GATHER) { if (t == NT - 4 && has_next) S.offs(nxt, Rr, Cc, offAn); }
            const char* a1 = cur.a + (size_t)(t + 1) * kstep;
            const bool sw = last && has_next;
            const int t2 = last ? 0 : t + 2;
            const char* ua = sw ? nxt.a : cur.a; const char* ub0 = sw ? nxt.b0 : cur.b0; const char* ub1 = sw ? nxt.b1 : cur.b1;
            const char* a2 = ua + (size_t)t2 * kstep; const char* a3 = a2 + kstep;
            const char* b2 = (t2 < KS) ? ub0 + (size_t)t2 * kstep : ub1 + (size_t)(t2 - KS) * kstep;
            const char* b3 = (t2 + 1 < KS) ? ub0 + (size_t)(t2 + 1) * kstep : ub1 + (size_t)(t2 + 1 - KS) * kstep;
            G_LDB(B0, 0, 0); G_LDB(B1, 0, 1); G_SCHED; G_LDA(At, 0, 0); G_STAGE_A(G_SA(1, 1), a1, offA, 1);
            G_WAIT_V(8); G_WAIT_L(0); G_BAR; G_MMA(0, 0, At, B0); G_MMA(0, 1, At, B1); G_BAR; G_SCHED;
            if constexpr (GATHER) { if (sw) {
#pragma unroll
                for (int h = 0; h < 2; ++h)
#pragma unroll
                    for (int i = 0; i < 2; ++i) offA[h][i] = offAn[h][i]; } }
            G_LDA(At, 0, 1); G_STAGE_B(G_SB(0, 0), b2); G_STAGE_B(G_SB(0, 1), b2 + hstepB); G_STAGE_A(G_SA(0, 0), a2, offA, 0);
            G_WAIT_V(8); G_WAIT_L(0); G_BAR; if (!cur.half) { G_MMA(1, 0, At, B0); G_MMA(1, 1, At, B1); } G_BAR; G_SCHED;
            G_LDB(B0, 1, 0); G_LDB(B1, 1, 1); G_SCHED; G_LDA(At, 1, 0); G_STAGE_A(G_SA(0, 1), a2, offA, 1);
            G_WAIT_V(8); G_WAIT_L(0); G_BAR; G_MMA(0, 0, At, B0); G_MMA(0, 1, At, B1); G_BAR; G_SCHED;
            G_LDA(At, 1, 1); G_STAGE_B(G_SB(1, 0), b3); G_STAGE_B(G_SB(1, 1), b3 + hstepB); G_STAGE_A(G_SA(1, 0), a3, offA, 0);
            G_WAIT_V(8); G_WAIT_L(0); G_BAR; if (!cur.half) { G_MMA(1, 0, At, B0); G_MMA(1, 1, At, B1); } G_BAR; G_SCHED;
        }
        TP_END(100 + PH * 10); TP_BEGIN(101 + PH * 10);
        if (wr == 0) G_BAR;
        E(acc, cur, wr, wc, fr, fq);
        TP_END(101 + PH * 10);
        if (!has_next) break;
#pragma unroll
        for (int a = 0; a < 2; ++a)
#pragma unroll
            for (int b = 0; b < 2; ++b)
#pragma unroll
                for (int m = 0; m < 4; ++m)
#pragma unroll
                    for (int n = 0; n < 2; ++n) acc[a][b][m][n] = (f32x4){0.f, 0.f, 0.f, 0.f};
        cur = nxt; ++ui;
        if (wr == 1) G_BAR;
    }
    G_WAIT_V(0);
    G_BAR;
#undef G_SA
#undef G_SB
#undef G_STAGE_A
#undef G_STAGE_B
#undef G_LDA
#undef G_LDB
#undef G_MMA
#undef G_WAIT_V
#undef G_WAIT_L
#undef G_BAR
#undef G_SCHED
#undef G_BP
}

__device__ __forceinline__ void st8(bf16_t* p, f32x4 v0, f32x4 v1) { u32x4 w; w.x = cvt_pk_bf16(v0[0], v0[1]); w.y = cvt_pk_bf16(v0[2], v0[3]); w.z = cvt_pk_bf16(v1[0], v1[1]); w.w = cvt_pk_bf16(v1[2], v1[3]); *(u32x4*)p = w; }
__device__ __forceinline__ float sigm(float z) { return __builtin_amdgcn_rcpf(1.0f + __builtin_amdgcn_exp2f(-z * LOG2E)); }

__device__ __forceinline__ void touch(const void* p, LAS unsigned* junk) { __builtin_amdgcn_global_load_lds((const unsigned*)p, junk, 4, 0, 0); }

struct EpiProj {
    static constexpr bool PERM = true;
    __device__ __forceinline__ void prefetch(const Unit&, int, int, int, LAS unsigned*) const {}
    bf16_t *U, *Q, *K, *V, *GP, *GA; const float *gq, *gk;
    __device__ __forceinline__ void mid(f32x4 (&)[2][2][4][2], const Unit&, int, int, int, int) const {}
    __device__ __forceinline__ void operator()(const f32x4 (&acc)[2][2][4][2], const Unit& u, int wr, int wc, int fr, int fq) const {
        const int pn = u.pn; const int row0 = u.pm * BM + wr * 64 + fr;
        if (pn < 2) {
            const int col0 = (pn & 1) * 256 + wc * 32 + 8 * fq;
#pragma unroll
            for (int ai = 0; ai < 2; ++ai)
#pragma unroll
                for (int m = 0; m < 4; ++m) { bf16_t* rowp = U + (size_t)(row0 + ai * HALF + m * 16) * 512 + col0;
#pragma unroll
                    for (int bj = 0; bj < 2; ++bj) st8(rowp + bj * HALF, acc[ai][bj][m][0], acc[ai][bj][m][1]); }
        } else if (pn == 6 || pn == 7) {
#pragma unroll
            for (int ai = 0; ai < 2; ++ai)
#pragma unroll
                for (int m = 0; m < 4; ++m) { const int row = row0 + ai * HALF + m * 16, b = row >> 11, t = row & 2047;
#pragma unroll
                    for (int bj = 0; bj < 2; ++bj) { const int bh = b * 4 + 2 * (pn - 6) + bj;
                        st8(V + ((((size_t)bh * 32 + (t >> 6)) * 16 + (wc * 4 + ((t >> 4) & 3))) * 16 + (t & 15)) * 32 + 8 * fq, acc[ai][bj][m][0], acc[ai][bj][m][1]); } }
        } else if (pn < 6) {
            const bool isq = pn < 4; bf16_t* base = isq ? Q : K; const float* g = isq ? gq : gk; const float sc = isq ? (0.125f * LOG2E) : 1.0f;
            f32x4 gv[2][2];
#pragma unroll
            for (int bj = 0; bj < 2; ++bj) { gv[bj][0] = *(const f32x4*)(g + 32 * bj + 8 * fq); gv[bj][1] = *(const f32x4*)(g + 32 * bj + 8 * fq + 4); }
            const int col0 = (pn & 1) * 256 + 64 * wc + 8 * fq;
#pragma unroll
            for (int ai = 0; ai < 2; ++ai)
#pragma unroll
                for (int m = 0; m < 4; ++m) {
                    float ss = 0.f;
#pragma unroll
                    for (int bj = 0; bj < 2; ++bj)
#pragma unroll
                        for (int n = 0; n < 2; ++n) { const f32x4 x = acc[ai][bj][m][n]; ss += (x[0] * x[0] + x[1] * x[1]) + (x[2] * x[2] + x[3] * x[3]); }
                    ss += __shfl_xor(ss, 16); ss += __shfl_xor(ss, 32);
                    const float rinv = __builtin_amdgcn_rsqf(ss * (1.0f / 64.0f) + EPS) * sc;
                    const int row = row0 + ai * HALF + m * 16;
                    if (isq) { bf16_t* rowp = base + (size_t)row * 512 + col0;
#pragma unroll
                        for (int bj = 0; bj < 2; ++bj) st8(rowp + 32 * bj, acc[ai][bj][m][0] * rinv * gv[bj][0], acc[ai][bj][m][1] * rinv * gv[bj][1]);
                    } else {
                        const int b = row >> 11, t = row & 2047, sh = (pn - 4) * 4 + wc, bh = b * 4 + (sh >> 1), mm = sh & 1;
#pragma unroll
                        for (int bj = 0; bj < 2; ++bj) st8(base + (((((size_t)bh * 2 + mm) * 32 + (t >> 6)) * 8 + (4 * bj + fq)) * 64 + (t & 63)) * 8, acc[ai][bj][m][0] * rinv * gv[bj][0], acc[ai][bj][m][1] * rinv * gv[bj][1]);
                    }
                }
        } else {
            const int col0 = (pn - 8) * 128 + wc * 32 + 8 * fq;
#pragma unroll
            for (int ai = 0; ai < 2; ++ai)
#pragma unroll
                for (int m = 0; m < 4; ++m) { const size_t off = (size_t)(row0 + ai * HALF + m * 16) * 1024 + col0;
                    f32x4 r0, r1, a0, a1;
#pragma unroll
                    for (int i = 0; i < 4; ++i) {
                        const float ea0 = __builtin_amdgcn_exp2f(-acc[ai][1][m][0][i] * LOG2E), ea1 = __builtin_amdgcn_exp2f(-acc[ai][1][m][1][i] * LOG2E);
                        a0[i] = __builtin_amdgcn_rcpf(1.0f + ea0); a1[i] = __builtin_amdgcn_rcpf(1.0f + ea1);
                        r0[i] = sigm(acc[ai][0][m][0][i]) * (1.0f + ea0); r1[i] = sigm(acc[ai][0][m][1][i]) * (1.0f + ea1); }
                    st8(GP + off, r0, r1); st8(GA + off, a0, a1); }
        }
    }
};

struct EpiMerge {
    static constexpr bool PERM = true;
    const bf16_t *GP, *GA; bf16_t* O;
    __device__ __forceinline__ void prefetch(const Unit& u, int wr, int wc, int lane, LAS unsigned* junk) const {
#pragma unroll
        for (int q = 0; q < 4; ++q) { const int idx = q * 64 + lane, ri = idx >> 1, bj = idx & 1; const int row = u.pm * BM + 128 * (ri >> 6) + 64 * wr + (ri & 63);
            const size_t off = (size_t)row * 1024 + u.pn * BM + wc * 32 + bj * HALF; touch(GP + off, junk); touch(GA + off, junk); }
    }
    __device__ __forceinline__ void mid(f32x4 (&acc)[2][2][4][2], const Unit& u, int wr, int wc, int fr, int fq) const {
        int row0 = u.pm * BM + wr * 64 + fr; const int col0 = u.pn * BM + wc * 32 + 8 * fq;
        asm volatile("" : "+v"(row0));
#pragma unroll
        for (int ai = 0; ai < 2; ++ai) {
            u32x4 pv[4][2];
#pragma unroll
            for (int m = 0; m < 4; ++m) { const size_t off = (size_t)(row0 + ai * HALF + m * 16) * 1024 + col0;
#pragma unroll
                for (int bj = 0; bj < 2; ++bj) pv[m][bj] = *(const u32x4*)(GP + off + bj * HALF); }
#pragma unroll
            for (int m = 0; m < 4; ++m)
#pragma unroll
                for (int bj = 0; bj < 2; ++bj) { const u32x4 p = pv[m][bj];
                    const f32x4 r0 = {bflo(p.x), bfhi(p.x), bflo(p.y), bfhi(p.y)}, r1 = {bflo(p.z), bfhi(p.z), bflo(p.w), bfhi(p.w)};
                    acc[ai][bj][m][0] *= r0; acc[ai][bj][m][1] *= r1; }
            asm volatile("" ::: "memory");
        }
    }
    __device__ __forceinline__ void operator()(const f32x4 (&acc)[2][2][4][2], const Unit& u, int wr, int wc, int fr, int fq) const {
        const int row0 = u.pm * BM + wr * 64 + fr, col0 = u.pn * BM + wc * 32 + 8 * fq;
#pragma unroll
        for (int ai = 0; ai < 2; ++ai) {
            u32x4 av[4][2];
#pragma unroll
            for (int m = 0; m < 4; ++m)
#pragma unroll
                for (int bj = 0; bj < 2; ++bj) av[m][bj] = *(const u32x4*)(GA + (size_t)(row0 + ai * HALF + m * 16) * 1024 + col0 + bj * HALF);
#pragma unroll
            for (int m = 0; m < 4; ++m)
#pragma unroll
                for (int bj = 0; bj < 2; ++bj) { const u32x4 a = av[m][bj];
                    const f32x4 g0 = {bflo(a.x), bfhi(a.x), bflo(a.y), bfhi(a.y)}, g1 = {bflo(a.z), bfhi(a.z), bflo(a.w), bfhi(a.w)};
                    st8(O + (size_t)(row0 + ai * HALF + m * 16) * 1024 + col0 + bj * HALF, acc[ai][bj][m][0] * g0, acc[ai][bj][m][1] * g1); }
            asm volatile("" ::: "memory");
        }
    }
};

struct EpiRes {
    static constexpr bool PERM = true;
    const float* X; bf16_t* O;
    __device__ __forceinline__ void prefetch(const Unit& u, int wr, int wc, int lane, LAS unsigned* junk) const {
#pragma unroll
        for (int q = 0; q < 4; ++q) { const int idx = q * 64 + lane, ri = idx >> 1, bj = idx & 1; const int row = u.pm * BM + 128 * (ri >> 6) + 64 * wr + (ri & 63);
            touch(X + (size_t)row * 1024 + u.pn * BM + wc * 32 + bj * HALF, junk); }
    }
    __device__ __forceinline__ void mid(f32x4 (&)[2][2][4][2], const Unit&, int, int, int, int) const {}
    __device__ __forceinline__ void operator()(const f32x4 (&acc)[2][2][4][2], const Unit& u, int wr, int wc, int fr, int fq) const {
        const int row0 = u.pm * BM + wr * 64 + fr, col0 = u.pn * BM + wc * 32 + 8 * fq;
#pragma unroll
        for (int ai = 0; ai < 2; ++ai) {
            f32x4 xv[4][2][2];
#pragma unroll
            for (int m = 0; m < 4; ++m)
#pragma unroll
                for (int bj = 0; bj < 2; ++bj) { const float* xp = X + (size_t)(row0 + ai * HALF + m * 16) * 1024 + col0 + bj * HALF; xv[m][bj][0] = *(const f32x4*)xp; xv[m][bj][1] = *(const f32x4*)(xp + 4); }
#pragma unroll
            for (int m = 0; m < 4; ++m)
#pragma unroll
                for (int bj = 0; bj < 2; ++bj) st8(O + (size_t)(row0 + ai * HALF + m * 16) * 1024 + col0 + bj * HALF, xv[m][bj][0] + acc[ai][bj][m][0], xv[m][bj][1] + acc[ai][bj][m][1]);
            asm volatile("" ::: "memory");
        }
    }
};

struct EpiMoe1 {
    static constexpr bool PERM = true;
    __device__ __forceinline__ void prefetch(const Unit&, int, int, int, LAS unsigned*) const {}
    const float *SR, *SWLO, *SWHI; bf16_t* HDN;
    __device__ __forceinline__ void mid(f32x4 (&)[2][2][4][2], const Unit&, int, int, int, int) const {}
    __device__ __forceinline__ void operator()(const f32x4 (&acc)[2][2][4][2], const Unit& u, int wr, int wc, int fr, int fq) const {
        const int slot0 = u.pm * BM + wr * 64 + fr; const float* SW = (u.pn < 4) ? SWLO : SWHI;
        const int col0 = (u.pn >> 2) * 512 + (u.pn & 3) * 128 + wc * 32 + 8 * fq;
        float rsv[2][4], wv[2][4];
#pragma unroll
        for (int ai = 0; ai < 2; ++ai)
#pragma unroll
            for (int m = 0; m < 4; ++m) { rsv[ai][m] = SR[slot0 + ai * HALF + m * 16]; wv[ai][m] = SW[slot0 + ai * HALF + m * 16]; }
#pragma unroll
        for (int ai = 0; ai < 2; ++ai) { if (ai == 1 && u.half) break;
#pragma unroll
            for (int m = 0; m < 4; ++m) { const int slot = slot0 + ai * HALF + m * 16; const float rs = rsv[ai][m], w = wv[ai][m];
                f32x4 h0, h1;
#pragma unroll
                for (int i = 0; i < 4; ++i) { const float g0 = acc[ai][0][m][0][i] * rs, u0 = acc[ai][1][m][0][i] * rs, g1 = acc[ai][0][m][1][i] * rs, u1 = acc[ai][1][m][1][i] * rs;
                    h0[i] = g0 * sigm(g0) * u0 * w; h1[i] = g1 * sigm(g1) * u1 * w; }
                st8(HDN + (size_t)slot * 1024 + col0, h0, h1); } }
    }
};

struct EpiMoe2 {
    static constexpr bool PERM = true;
    const int* STOK; const bf16_t* X1; float* O;
    __device__ __forceinline__ void prefetch(const Unit& u, int wr, int wc, int lane, LAS unsigned* junk) const {
#pragma unroll
        for (int q = 0; q < 4; ++q) { const int idx = q * 64 + lane, ri = idx >> 1, bj = idx & 1; int tok = STOK[u.pm * BM + 128 * (ri >> 6) + 64 * wr + (ri & 63)]; tok = tok < 0 ? 0 : tok;
            touch(X1 + (size_t)tok * 1024 + u.pn * BM + wc * 32 + bj * HALF, junk); }
    }
    __device__ __forceinline__ void mid(f32x4 (&)[2][2][4][2], const Unit&, int, int, int, int) const {}
    __device__ __forceinline__ void operator()(const f32x4 (&acc)[2][2][4][2], const Unit& u, int wr, int wc, int fr, int fq) const {
        const int slot0 = u.pm * BM + wr * 64 + fr, col0 = u.pn * BM + wc * 32 + 8 * fq;
        int tk[2][4];
#pragma unroll
        for (int ai = 0; ai < 2; ++ai)
#pragma unroll
            for (int m = 0; m < 4; ++m) tk[ai][m] = STOK[slot0 + ai * HALF + m * 16];
#pragma unroll
        for (int ai = 0; ai < 2; ++ai) { if (ai == 1 && u.half) break;
            u32x4 xv[4][2];
#pragma unroll
            for (int m = 0; m < 4; ++m) { const int tok = tk[ai][m] < 0 ? 0 : tk[ai][m];
#pragma unroll
                for (int bj = 0; bj < 2; ++bj) xv[m][bj] = *(const u32x4*)(X1 + (size_t)tok * 1024 + col0 + bj * HALF); }
#pragma unroll
            for (int m = 0; m < 4; ++m) { const int tok = tk[ai][m];
                if (tok >= 0) { const size_t off = (size_t)tok * 1024 + col0;
#pragma unroll
                    for (int bj = 0; bj < 2; ++bj) { const u32x4 x = xv[m][bj];
                        const f32x4 x0 = {bflo(x.x), bfhi(x.x), bflo(x.y), bfhi(x.y)}, x1 = {bflo(x.z), bfhi(x.z), bflo(x.w), bfhi(x.w)};
                        *(f32x4*)(O + off + bj * HALF) = x0 + acc[ai][bj][m][0]; *(f32x4*)(O + off + bj * HALF + 4) = x1 + acc[ai][bj][m][1]; } } }
            asm volatile("" ::: "memory");
        }
    }
};

struct MoeSched {
    const LAS int* tab; const char* A; const char* B; const int* STOK; int mode;
    __device__ __forceinline__ bool next(int i, Unit& u) const {
        if (i >= 16) return false;
        const int tile = __builtin_amdgcn_readfirstlane(tab[i * 8 + 0]); if (tile < 0) return false;
        const int pn = __builtin_amdgcn_readfirstlane(tab[i * 8 + 1]), e0 = __builtin_amdgcn_readfirstlane(tab[i * 8 + 2]), e1 = __builtin_amdgcn_readfirstlane(tab[i * 8 + 3]);
        u.pm = tile; u.pn = pn; u.e0 = e0; u.e1 = e1; u.half = __builtin_amdgcn_readfirstlane(tab[i * 8 + 4]);
        if (mode == 1) { const int e = (pn < 4) ? e0 : e1; u.a = A; u.b0 = B + ((size_t)e * 1024 * 1024 + (size_t)(pn & 3) * 256 * 1024) * 2; u.b1 = u.b0; }
        else { u.a = A + (size_t)tile * 256 * 1024 * 2; u.b0 = B + ((size_t)e0 * 1024 + (size_t)pn * 256) * 512 * 2; u.b1 = B + ((size_t)e1 * 1024 + (size_t)pn * 256) * 512 * 2; }
        return true;
    }
    __device__ __forceinline__ void offs(const Unit& u, const int (&Rr)[2], const int (&Cc)[2], unsigned (&off)[2][2]) const {
#pragma unroll
        for (int h = 0; h < 2; ++h)
#pragma unroll
            for (int i = 0; i < 2; ++i) { int tok = STOK[u.pm * 256 + h * 128 + Rr[i]]; tok = tok < 0 ? 0 : tok; off[h][i] = ((unsigned)tok * 1024u + (unsigned)Cc[i]) * 2u; }
    }
};
}

namespace att {
__device__ __forceinline__ int crow(int r, int hi) { return (r & 3) + 8 * (r >> 2) + 4 * hi; }
__device__ __forceinline__ void glds16(const void* gsrc, unsigned lds_dst) { unsigned keep;
    asm volatile("s_mov_b32 %0, m0\n\ts_mov_b32 m0, %2\n\ts_nop 0\n\tglobal_load_lds_dwordx4 %1, off\n\ts_mov_b32 m0, %0" : "=&s"(keep) : "v"(gsrc), "s"(lds_dst) : "memory"); }
typedef __attribute__((address_space(3))) const char* lds_cptr;
typedef short v4i16_t __attribute__((ext_vector_type(4)));
__device__ __forceinline__ s16x4 vtr(lds_cptr p) { return __builtin_bit_cast(s16x4, __builtin_amdgcn_ds_read_tr16_b64_v4i16((__attribute__((address_space(3))) v4i16_t*)p)); }
#define ATT_WAIT_BAR() asm volatile("s_waitcnt vmcnt(0) lgkmcnt(0)\n\ts_barrier" ::: "memory")
constexpr int SLOT = 32768;
constexpr int WSF_OFF = LDSCTL_OFF + 2048;
constexpr int XCH_OFF = 0;

__device__ __forceinline__ void attn_unit(int b, int h, int qb, const bf16_t* Q, const bf16_t* K, const bf16_t* V, bf16_t* DO, char* shm, float B2, float lam, const float* subg TP_PARAMS) {
    TP_BEGIN(25);
    const int tid = threadIdx.x, lane = tid & 63, r32 = lane & 31, hi = lane >> 5; const int wid = __builtin_amdgcn_readfirstlane(tid >> 6);
    const int mm = wid >> 2, wq = wid & 3;
    const long rowbase = (long)b * SEQ; const int q0 = qb * 128, i0 = q0 + wq * 32;
    const float aslope = LOG2E * __builtin_amdgcn_exp2f(-2.0f * (float)(h + 1));
    const unsigned lds0 = (unsigned)(uintptr_t)shm; const lds_cptr shm3 = (lds_cptr)shm;
    float* wsf = (float*)(shm + WSF_OFF) + wid * 64;
    const bf16_t* Qw = Q + (rowbase + i0 + r32) * 512 + h * 128 + mm * 64 + hi * 8;
    bf16x8 qr[4];
#pragma unroll
    for (int ks = 0; ks < 4; ++ks) qr[ks] = *(const bf16x8*)(Qw + ks * 16);
    const int bh = b * 4 + h;
    const bf16_t* ksrc0 = K + (((size_t)bh * 2 + 0) * 32 * 8 + wid) * 512 + lane * 8;
    const bf16_t* ksrc1 = K + (((size_t)bh * 2 + 1) * 32 * 8 + wid) * 512 + lane * 8;
    const int p0i = 2 * wid, p1i = 2 * wid + 1;
    const bf16_t* vsrc0 = V + ((size_t)bh * 32 * 16 + p0i) * 512 + lane * 8;
    const bf16_t* vsrc1 = vsrc0 + 512;
    const int NTL = 2 * qb + 2;
    int ts; { const int Dk = (int)((2.0f * B2 + 30.2f) / aslope) + 1; ts = q0 - Dk; ts = ts < 0 ? 0 : (ts >> 6); }
#define ATT_DMA(t, slot) do { const unsigned _s = lds0 + (unsigned)(slot) * SLOT; \
        glds16(ksrc0 + (size_t)(t) * 4096, (unsigned)__builtin_amdgcn_readfirstlane(_s + wid * 1024)); glds16(ksrc1 + (size_t)(t) * 4096, (unsigned)__builtin_amdgcn_readfirstlane(_s + 8192 + wid * 1024)); \
        glds16(vsrc0 + (size_t)(t) * 8192, (unsigned)__builtin_amdgcn_readfirstlane(_s + 16384 + p0i * 1024)); glds16(vsrc1 + (size_t)(t) * 8192, (unsigned)__builtin_amdgcn_readfirstlane(_s + 16384 + p1i * 1024)); } while (0)
    ATT_DMA(ts, ts & 3); ATT_DMA(ts + 1, (ts + 1) & 3);
#if defined(ATT_PRIO_YOUNG)
    if (wid >= 4) __builtin_amdgcn_s_setprio(1);
#endif
    f32x16 o[4]; o[0] = f32x16{}; o[1] = f32x16{}; o[2] = f32x16{}; o[3] = f32x16{};
    float l_reg = 0.f;
    const int irow = i0 + r32;
    u32x4 qbias, kbias0, kbias1;
    { const float a_h = bf2f((unsigned short)f2bf(aslope)), r1 = aslope - a_h, a_m = bf2f((unsigned short)f2bf(r1)), a_l = bf2f((unsigned short)f2bf(r1 - a_m));
      const unsigned j0b = f2bf((float)r32), j1b = f2bf((float)(r32 + 32));
      qbias  = hi ? (u32x4){0u, 0u, 0u, 0u} : (u32x4){f2bf(a_h) | (f2bf(a_m) << 16), f2bf(a_l), 0u, 0u};
      kbias0 = hi ? (u32x4){0u, 0u, 0u, 0u} : (u32x4){j0b | (j0b << 16), j0b, 0u, 0u};
      kbias1 = hi ? (u32x4){0u, 0u, 0u, 0u} : (u32x4){j1b | (j1b << 16), j1b, 0u, 0u}; }
    __builtin_amdgcn_s_waitcnt(0x0F70);
    TP_END(25);
    const int vlane = ((lane >> 4) & 1) * 32 + (lane & 3) * 8 + (4 * hi + ((lane & 15) >> 2)) * 64;
    f32x16 cini; { const float c0 = aslope * (float)(64 * ts - irow) - B2; _Pragma("unroll") for (int r = 0; r < 16; ++r) cini[r] = c0; }
    const float cstep = 64.0f * aslope;
#define ATT_VRD(g) vtr(vp + ((g) >> 2) * 4096 + ((g) & 3) * 1024), vtr(vp + ((g) >> 2) * 4096 + ((g) & 3) * 1024 + 512)
#define ATT_PV(SL) do { const lds_cptr vp = shm3 + (SL) * SLOT + 16384 + vlane; \
        s16x4 vf[2][2]; \
        { const s16x4 a0[2] = {ATT_VRD(0)}, a1[2] = {ATT_VRD(1)}; vf[0][0] = a0[0]; vf[0][1] = a0[1]; vf[1][0] = a1[0]; vf[1][1] = a1[1]; } \
        __builtin_amdgcn_sched_barrier(0); \
        _Pragma("unroll") for (int g = 0; g < 16; ++g) {            \
            const s16x4 lo = vf[g & 1][0], hh = vf[g & 1][1]; \
            const bf16x8 vfr = (bf16x8){lo[0], lo[1], lo[2], lo[3], hh[0], hh[1], hh[2], hh[3]}; \
            o[g >> 2] = __builtin_amdgcn_mfma_f32_32x32x16_bf16(__builtin_bit_cast(bf16x8, pw[g & 3]), vfr, o[g >> 2], 0, 0, 0); \
            if (g + 2 < 16) { const s16x4 a3[2] = {ATT_VRD(g + 2)}; vf[g & 1][0] = a3[0]; vf[g & 1][1] = a3[1]; } \
            __builtin_amdgcn_sched_barrier(0); } \
        } while (0)
#define ATT_TILE(MASKED) do { \
        TP_BEGIN(21); \
        if (t + 1 < NTL) asm volatile("s_waitcnt vmcnt(4) lgkmcnt(0)\n\ts_barrier" ::: "memory"); else ATT_WAIT_BAR(); \
        TP_END(21); TP_BEGIN(22); \
        if (t + 2 < NTL) ATT_DMA(t + 2, (t + 2) & 3); \
        TP_END(22); TP_BEGIN(23); \
        const int j0 = 64 * t; \
        if (!(MASKED) || j0 <= i0 + 31) { \
            const char* kb = shm + (t & 3) * SLOT + mm * 8192 + hi * 1024 + r32 * 16; \
            bf16x8 kf[2]; kf[0] = *(const bf16x8*)(kb); kf[1] = *(const bf16x8*)(kb + 512);     \
            __builtin_amdgcn_sched_barrier(0); \
            f32x16 p0 = __builtin_amdgcn_mfma_f32_32x32x16_bf16(__builtin_bit_cast(bf16x8, kbias0), __builtin_bit_cast(bf16x8, qbias), cini, 0, 0, 0); \
            f32x16 p1 = __builtin_amdgcn_mfma_f32_32x32x16_bf16(__builtin_bit_cast(bf16x8, kbias1), __builtin_bit_cast(bf16x8, qbias), cini, 0, 0, 0); \
            __builtin_amdgcn_sched_barrier(0); \
            _Pragma("unroll") for (int f = 0; f < 8; ++f) { \
                if (f & 1) p1 = __builtin_amdgcn_mfma_f32_32x32x16_bf16(kf[1], qr[f >> 1], p1, 0, 0, 0); else p0 = __builtin_amdgcn_mfma_f32_32x32x16_bf16(kf[0], qr[f >> 1], p0, 0, 0, 0); \
                if (f + 2 < 8) kf[f & 1] = *(const bf16x8*)(kb + ((f + 2) >> 1) * 2048 + (f & 1) * 512); \
                __builtin_amdgcn_sched_barrier(0); } \
            if (MASKED) { const int jb = j0 + 4 * hi; \
                _Pragma("unroll") for (int r = 0; r < 16; ++r) { const int j = jb + (r & 3) + 8 * (r >> 2); if (j > irow) p0[r] = -1.0e30f; if (j + 32 > irow) p1[r] = -1.0e30f; } } \
            float sacc = 0.f; \
            _Pragma("unroll") for (int r = 0; r < 16; ++r) { p0[r] = __builtin_amdgcn_exp2f(p0[r]); p1[r] = __builtin_amdgcn_exp2f(p1[r]); sacc += p0[r] + p1[r]; } \
            l_reg += sacc; \
            u32x4 pw[4]; \
            pw[0] = (u32x4){cvt_pk_bf16(p0[0], p0[1]), cvt_pk_bf16(p0[2], p0[3]), cvt_pk_bf16(p0[4], p0[5]), cvt_pk_bf16(p0[6], p0[7])}; \
            pw[1] = (u32x4){cvt_pk_bf16(p0[8], p0[9]), cvt_pk_bf16(p0[10], p0[11]), cvt_pk_bf16(p0[12], p0[13]), cvt_pk_bf16(p0[14], p0[15])}; \
            pw[2] = (u32x4){cvt_pk_bf16(p1[0], p1[1]), cvt_pk_bf16(p1[2], p1[3]), cvt_pk_bf16(p1[4], p1[5]), cvt_pk_bf16(p1[6], p1[7])}; \
            pw[3] = (u32x4){cvt_pk_bf16(p1[8], p1[9]), cvt_pk_bf16(p1[10], p1[11]), cvt_pk_bf16(p1[12], p1[13]), cvt_pk_bf16(p1[14], p1[15])}; \
            TP_END(23); TP_BEGIN(24); \
            ATT_PV(t & 3); \
            TP_END(24); TP_BEGIN(23); \
        } TP_END(23); \
        _Pragma("unroll") for (int r = 0; r < 16; ++r) cini[r] += cstep; } while (0)
    int t = ts;
    for (; t < NTL - 2; ++t) ATT_TILE(false);
    for (; t < NTL; ++t) ATT_TILE(true);
#undef ATT_PV
#undef ATT_VRD
    TP_BEGIN(26);
#undef ATT_TILE
    { auto rr = __builtin_amdgcn_permlane32_swap(__float_as_uint(l_reg), __float_as_uint(l_reg), false, false); l_reg = __uint_as_float(rr[0]) + __uint_as_float(rr[1]); }
    if (hi == 0) wsf[r32] = l_reg;
    asm volatile("s_waitcnt lgkmcnt(0)" ::: "memory");
    const float fac = (mm == 0) ? 1.0f : lam;
#pragma unroll
    for (int r = 0; r < 16; ++r) { const float rl = fac * __builtin_amdgcn_rcpf(wsf[crow(r, hi)]);
#pragma unroll
        for (int d0 = 0; d0 < 4; ++d0) o[d0][r] *= rl; }
    TP_BEGIN(27);
    ATT_WAIT_BAR();
    TP_END(27); TP_BEGIN(28);
    float* xch = (float*)(shm + XCH_OFF) + (size_t)wq * 32 * 128;
    if (mm == 1) {
#pragma unroll
        for (int r = 0; r < 16; ++r)
#pragma unroll
            for (int d0 = 0; d0 < 4; ++d0) xch[crow(r, hi) * 128 + 32 * d0 + r32] = o[d0][r];
    }
    ATT_WAIT_BAR();
    bf16_t* stg = (bf16_t*)(shm + 65536);
    if (mm == 0) {
        float gsub[4];
#pragma unroll
        for (int d0 = 0; d0 < 4; ++d0) gsub[d0] = subg[32 * d0 + r32] * 0.8f;
#pragma unroll
        for (int r = 0; r < 16; ++r) {
            float ss = 0.f;
#pragma unroll
            for (int d0 = 0; d0 < 4; ++d0) { o[d0][r] -= xch[crow(r, hi) * 128 + 32 * d0 + r32]; ss += o[d0][r] * o[d0][r]; }
            ss += __shfl_xor(ss, 1); ss += __shfl_xor(ss, 2); ss += __shfl_xor(ss, 4); ss += __shfl_xor(ss, 8); ss += __shfl_xor(ss, 16);
            const float rinv = __builtin_amdgcn_rsqf(ss * (1.0f / 128.0f) + EPS);
            bf16_t* srow = stg + (wq * 32 + crow(r, hi)) * 128 + r32;
#pragma unroll
            for (int d0 = 0; d0 < 4; ++d0) srow[32 * d0] = (bf16_t)f2bf(o[d0][r] * rinv * gsub[d0]);
        }
    }
    ATT_WAIT_BAR();
    { const int row = tid >> 2, q4 = tid & 3;
      const bf16_t* sp = stg + row * 128 + q4 * 32; bf16_t* gp = DO + (size_t)(rowbase + q0 + row) * 1024 + 512 + h * 128 + q4 * 32;
      u32x4 v[4];
#pragma unroll
      for (int i = 0; i < 4; ++i) v[i] = *(const u32x4*)(sp + i * 8);
#pragma unroll
      for (int i = 0; i < 4; ++i) *(u32x4*)(gp + i * 8) = v[i]; }
    asm volatile("s_waitcnt lgkmcnt(0)" ::: "memory");
    TP_END(28);
    TP_END(26);
#undef ATT_DMA
}
}

struct Args { const float* in[23]; float* out; unsigned char* ws; };

__device__ __forceinline__ float wave_sum(float v) {
#pragma unroll
    for (int o = 1; o < 64; o <<= 1) v += __shfl_xor(v, o);
    return v;
}
__device__ __forceinline__ float wave_max(float v) {
#pragma unroll
    for (int o = 1; o < 64; o <<= 1) v = fmaxf(v, __shfl_xor(v, o));
    return v;
}

template <class DstF>
__device__ __forceinline__ void transpose_item(const float* W, int N, int k0, int n0, LAS float* scr, int lane, const float* ksc, DstF dst) {
    const int kk = lane >> 3, n4 = (lane & 7) * 4;
    f32x4 v[8];
#pragma unroll
    for (int j = 0; j < 8; ++j) v[j] = *(const f32x4*)(W + (size_t)(k0 + kk + 8 * j) * N + n0 + n4);
#pragma unroll
    for (int j = 0; j < 8; ++j) { LAS float* d = scr + (kk + 8 * j) * 33 + n4; d[0] = v[j][0]; d[1] = v[j][1]; d[2] = v[j][2]; d[3] = v[j][3]; }
    LDS_WAIT(); asm volatile("" ::: "memory");
    const int c = lane & 7;
    f32x4 s0 = {1.f, 1.f, 1.f, 1.f}, s1 = s0;
    if (ksc) { s0 = *(const f32x4*)(ksc + k0 + 8 * c); s1 = *(const f32x4*)(ksc + k0 + 8 * c + 4); }
#pragma unroll
    for (int j = 0; j < 4; ++j) { const int n = (lane >> 3) + 8 * j; const LAS float* s = scr + (8 * c) * 33 + n;
        u32x4 o; o.x = pk2(s[0 * 33] * s0[0], s[1 * 33] * s0[1]); o.y = pk2(s[2 * 33] * s0[2], s[3 * 33] * s0[3]); o.z = pk2(s[4 * 33] * s1[0], s[5 * 33] * s1[1]); o.w = pk2(s[6 * 33] * s1[2], s[7 * 33] * s1[3]);
        *(GAS u32x4*)(dst(n0 + n) + k0 + 8 * c) = o; }
    LDS_WAIT(); asm volatile("" ::: "memory");
}

#define PH_BEGIN() unsigned char* ws = args.ws; asm volatile("" : "+s"(ws)); int tid = threadIdx.x; asm volatile("" : "+v"(tid)); \
    const int lane = tid & 63, wave = __builtin_amdgcn_readfirstlane(tid >> 6); const int G = gridDim.x, bx = blockIdx.x; \
    const int vcu = (G % 8 == 0) ? (bx % 8) * (G / 8) + bx / 8 : bx; const int gw = vcu * NWAVES + wave, NGW = G * NWAVES; \
    gu32* ctl = (gu32*)(ws + WS_CTL); (void)lane; (void)wave; (void)gw; (void)NGW; (void)ctl; (void)vcu
#define WSP(T, off) ((T*)(ws + (off)))

#ifndef DEPHASE3
#define DEPHASE3 0
#endif
#ifndef DEPHASE4
#define DEPHASE4 0
#endif
#ifndef DEPHASE8
#define DEPHASE8 0
#endif
__device__ __forceinline__ void dephase(int vcu, unsigned ticks) {
    if ((vcu & 1) && ticks) { const unsigned long long t0 = __builtin_amdgcn_s_memrealtime(); while (__builtin_amdgcn_s_memrealtime() - t0 < ticks) __builtin_amdgcn_s_sleep(16); }
}
__global__ void __launch_bounds__(NWAVES * 64, 2) hybrid_fwd(Args args) {
    extern __shared__ __attribute__((aligned(16))) unsigned char lds[];
    LAS unsigned char* L = (LAS unsigned char*)lds;
    volatile LAS unsigned* MISC = (volatile LAS unsigned*)(L + MISC_OFF);
    for (int u = threadIdx.x; u < (LDS_BYTES - LDSCTL_OFF) / 4; u += NWAVES * 64) ((LAS unsigned*)(L + LDSCTL_OFF))[u] = 0u;
    __syncthreads();
    XcdBarrier bar = xcd_barrier_post((unsigned*)((gu32*)(args.ws + WS_CTL) + CW_BAR), MISC + 8);
    TP_DECL();

    TP_BEGIN(10);
    if (PHASE_MASK & 1) REPS(1) {
        PH_BEGIN();
        bf16_t* WinT = WSP(bf16_t, WS_WIN); bf16_t* WmT = WSP(bf16_t, WS_WM); bf16_t* WoT = WSP(bf16_t, WS_WO); bf16_t* WguT = WSP(bf16_t, WS_WGU); bf16_t* WdT = WSP(bf16_t, WS_WD);
        bf16_t* WrH = WSP(bf16_t, WS_WRH); bf16_t* WrL = WSP(bf16_t, WS_WRL); bf16_t* Hb = WSP(bf16_t, WS_H);
        LAS float* scr = (LAS float*)(L + wave * 16384);
        constexpr int I_IN = 16 * 128, I_AU = 8 * 32, I_OUT = 16 * 32, I_G = 32 * 256, I_U = 32 * 256, I_D = 32 * 256;
        constexpr int NITEMS = I_IN + I_AU + I_OUT + I_G + I_U + I_D;
        TP_BEGIN(30);
        for (int it = gw; it < NITEMS; it += NGW) {
            int r = it;
            if (r < I_IN) { const int kb = r / 128, nb = r % 128;
                transpose_item(args.in[2], 4096, kb * 64, nb * 32, scr, lane, nullptr, [&](int n) -> bf16_t* {
                    int v = n; if (n >= 512 && n < 1536) { const int l = n & 255; v = (n & ~255) + 128 * ((l >> 5) & 1) + 32 * (l >> 6) + (l & 31); }
                    else if (n >= 2048) { const int c = (n - 2048) & 1023; v = 2048 + 256 * (c >> 7) + (c & 127) + ((n >= 3072) ? 128 : 0); }
                    return WinT + (size_t)v * 1024; });
                continue; } r -= I_IN;
            if (r < I_AU) { const int kb = r / 32, nb = r % 32;
                transpose_item(args.in[13], 1024, kb * 64, nb * 32, scr, lane, nullptr, [&](int n) -> bf16_t* { return WmT + (size_t)n * 1024 + 512; }); continue; } r -= I_AU;
            if (r < I_OUT) { const int kb = r / 32, nb = r % 32;
                transpose_item(args.in[14], 1024, kb * 64, nb * 32, scr, lane, nullptr, [&](int n) -> bf16_t* { return WoT + (size_t)n * 1024; }); continue; } r -= I_OUT;
            if (r < I_G) { const int e = r / 256, q = r % 256, kb = q / 16, nb = q % 16;
                transpose_item(args.in[20] + (size_t)e * 1024 * 512, 512, kb * 64, nb * 32, scr, lane, args.in[15], [&](int n) -> bf16_t* { return WguT + (size_t)e * 1024 * 1024 + (size_t)(256 * (n >> 7) + (n & 127)) * 1024; }); continue; } r -= I_G;
            if (r < I_U) { const int e = r / 256, q = r % 256, kb = q / 16, nb = q % 16;
                transpose_item(args.in[21] + (size_t)e * 1024 * 512, 512, kb * 64, nb * 32, scr, lane, args.in[15], [&](int n) -> bf16_t* { return WguT + (size_t)e * 1024 * 1024 + (size_t)(256 * (n >> 7) + 128 + (n & 127)) * 1024; }); continue; } r -= I_U;
            { const int e = r / 256, q = r % 256, kb = q / 32, nb = q % 32;
                transpose_item(args.in[22] + (size_t)e * 512 * 1024, 1024, kb * 64, nb * 32, scr, lane, nullptr, [&](int n) -> bf16_t* { return WdT + ((size_t)e * 1024 + n) * 512; }); }
        }
        TP_END(30); TP_BEGIN(31);
        for (int it = gw; it < 2048; it += NGW) {
            const int kq = it >> 4, nb = it & 15, n = 64 * nb + lane, k = 4 * kq, g = k >> 7, kl = k & 127;
            const float* pw = args.in[3] + (size_t)(g * 128 + kl) * 128; const float* sc = args.in[4] + g * 128; const float* wu = args.in[5] + (size_t)(g * 128) * 1024 + n;
            float a0 = 0.f, a1 = 0.f, a2 = 0.f, a3 = 0.f;
            for (int c0 = 0; c0 < 128; c0 += 16) { float wv[16];
#pragma unroll
                for (int c = 0; c < 16; ++c) wv[c] = wu[(size_t)(c0 + c) * 1024];
#pragma unroll
                for (int c = 0; c < 16; ++c) { const float w2 = wv[c] * sc[c0 + c]; a0 += pw[c0 + c] * w2; a1 += pw[128 + c0 + c] * w2; a2 += pw[256 + c0 + c] * w2; a3 += pw[384 + c0 + c] * w2; } }
            u32x2 o; o.x = pk2(a0, a1); o.y = pk2(a2, a3);
            *(u32x2*)(WmT + (size_t)n * 1024 + k) = o;
        }
        TP_END(31); TP_BEGIN(32);
        for (int it = gw * 64 + lane; it < 48 * 1024; it += NGW * 64) {
            const int n = it >> 10, k = it & 1023; float w = 0.f;
            if (n < 4) w = args.in[16][k * 4 + n]; else if (n < 36) w = args.in[18][k * 32 + (n - 4)];
            w *= args.in[15][k];
            const unsigned hb = f2bf(w); const float lo = w - __builtin_bit_cast(float, hb << 16);
            WrH[it] = (bf16_t)hb; WrL[it] = (bf16_t)f2bf(lo);
        }
        TP_END(32); TP_BEGIN(33);
        { const float* x = args.in[0]; const GAS f32x4* g4 = (const GAS f32x4*)args.in[1] + lane; f32x4 gg[4];
#pragma unroll
          for (int j = 0; j < 4; ++j) gg[j] = g4[64 * j];
          for (int m = gw * 2; m < NTOK; m += NGW * 2) {
            const GAS f32x4* xr = (const GAS f32x4*)(x + (size_t)m * DM) + lane;
            f32x4 v[8]; float s0 = 0.f, s1 = 0.f;
#pragma unroll
            for (int j = 0; j < 8; ++j) v[j] = xr[64 * j];
#pragma unroll
            for (int j = 0; j < 4; ++j) { s0 += (v[j].x * v[j].x + v[j].y * v[j].y) + (v[j].z * v[j].z + v[j].w * v[j].w); s1 += (v[4 + j].x * v[4 + j].x + v[4 + j].y * v[4 + j].y) + (v[4 + j].z * v[4 + j].z + v[4 + j].w * v[4 + j].w); }
            const float r0 = __builtin_amdgcn_rsqf(wave_sum(s0) * (1.f / DM) + EPS), r1 = __builtin_amdgcn_rsqf(wave_sum(s1) * (1.f / DM) + EPS);
            GAS unsigned long long* o8 = (GAS unsigned long long*)(Hb + (size_t)m * DM) + lane;
#pragma unroll
            for (int j = 0; j < 8; ++j) { const f32x4 y = v[j] * (j < 4 ? r0 : r1) * gg[j & 3]; o8[64 * j] = (unsigned long long)pk2(y.x, y.y) | ((unsigned long long)pk2(y.z, y.w) << 32); }
          } }
        TP_END(33);
    }
    xcd_barrier(bar);
    TP_END(10);

    TP_BEGIN(11);
    if (PHASE_MASK & 2) REPS(2) {
        PH_BEGIN();
        gm::StaticOrder S; S.init(WSP(bf16_t, WS_H), WSP(bf16_t, WS_WIN), 1024, 1024, NTOK, 4096, G, bx);
        gm::EpiProj E{WSP(bf16_t, WS_U), WSP(bf16_t, WS_Q), WSP(bf16_t, WS_K), WSP(bf16_t, WS_V), WSP(bf16_t, WS_GP), WSP(bf16_t, WS_GA), args.in[6], args.in[7]};
        gm::gemm_phase<1, gm::EpiProj, gm::StaticOrder, gm::NT, false, false>(L, S, E, 1024, 1024 TP_ARGS);
    }
    xcd_barrier(bar);
    TP_END(11);

    TP_BEGIN(12);
    if (PHASE_MASK & 4) REPS(4) {
        PH_BEGIN();
        bf16_t* Ub = WSP(bf16_t, WS_U); bf16_t* DOb = WSP(bf16_t, WS_DO);
        float lam, B2;
        { const float a1 = args.in[8][lane] * args.in[9][lane], a2 = args.in[10][lane] * args.in[11][lane];
          lam = __expf(wave_sum(a1)) - __expf(wave_sum(a2)) + 0.2f;
          const float mq = wave_max(fabsf(args.in[6][lane])), mk = wave_max(fabsf(args.in[7][lane]));
          B2 = 8.0f * mq * mk * LOG2E * 1.02f + 0.5f; }
        TP_BEGIN(20);
        { LAS int* tick = (LAS int*)(L + LDSCTL_OFF + 512);
          const int bq = vcu >> 3; unsigned* qh = (unsigned*)(ctl + CW_ATTQ) + bq * 16;
          if (tid == 0) tick[0] = (int)atomicAdd(qh, 1u);
          __syncthreads();
          int idx = tick[0];
          while (idx < 64) {
              __syncthreads();
              if (tid == 0) tick[0] = (int)atomicAdd(qh, 1u);
              int h, qb; if (idx < 32) { h = 3 - (idx & 1); qb = 15 - (idx >> 1); } else if (idx < 48) { h = 1; qb = 47 - idx; } else { h = 0; qb = 63 - idx; }
              att::attn_unit(bq, h, qb, WSP(bf16_t, WS_Q), WSP(bf16_t, WS_K), WSP(bf16_t, WS_V), DOb, (char*)lds, B2, lam, args.in[12] TP_ARGS);
              __syncthreads();
              idx = tick[0];
          } }
        TP_END(20);
        { const int w = 2 << (lane >> 4);
          const bf16_t* Ul = Ub + lane * 8;
          for (int blk = gw; blk < NTOK / 8; blk += NGW) {
            const int tok0 = blk * 8, t0 = tok0 & (SEQ - 1);
            u32x4 hist[15], curv[8], oldv[8];
#pragma unroll
            for (int s = 1; s <= 15; ++s) { const int ok = (s < w) && (t0 - s >= 0); hist[s - 1] = *(const u32x4*)(Ul + (size_t)(ok ? tok0 - s : tok0) * 512); if (!ok) hist[s - 1] = (u32x4){0u, 0u, 0u, 0u}; }
#pragma unroll
            for (int tt = 0; tt < 8; ++tt) { curv[tt] = *(const u32x4*)(Ul + (size_t)(tok0 + tt) * 512);
                const int ok = (t0 + tt - w + 1 >= 0); oldv[tt] = *(const u32x4*)(Ul + (size_t)(ok ? tok0 + tt - w + 1 : tok0) * 512); if (!ok) oldv[tt] = (u32x4){0u, 0u, 0u, 0u}; }
            float S[8];
#pragma unroll
            for (int c = 0; c < 8; ++c) S[c] = 0.f;
#pragma unroll
            for (int s = 0; s < 15; ++s) { const u32x4 v = hist[s];
                S[0] += bflo(v.x); S[1] += bfhi(v.x); S[2] += bflo(v.y); S[3] += bfhi(v.y); S[4] += bflo(v.z); S[5] += bfhi(v.z); S[6] += bflo(v.w); S[7] += bfhi(v.w); }
#pragma unroll
            for (int tt = 0; tt < 8; ++tt) { const u32x4 v = curv[tt], q = oldv[tt]; const int t = t0 + tt;
                const float c0 = bflo(v.x), c1 = bfhi(v.x), c2 = bflo(v.y), c3 = bfhi(v.y), c4 = bflo(v.z), c5 = bfhi(v.z), c6 = bflo(v.w), c7 = bfhi(v.w);
                S[0] += c0; S[1] += c1; S[2] += c2; S[3] += c3; S[4] += c4; S[5] += c5; S[6] += c6; S[7] += c7;
                const float inv = 1.0f / (float)((t + 1 < w) ? t + 1 : w);
                u32x4 o; o.x = pk2(S[0] * inv - c0, S[1] * inv - c1); o.y = pk2(S[2] * inv - c2, S[3] * inv - c3); o.z = pk2(S[4] * inv - c4, S[5] * inv - c5); o.w = pk2(S[6] * inv - c6, S[7] * inv - c7);
                *(u32x4*)(DOb + (size_t)(tok0 + tt) * 1024 + lane * 8) = o;
                S[0] -= bflo(q.x); S[1] -= bfhi(q.x); S[2] -= bflo(q.y); S[3] -= bfhi(q.y); S[4] -= bflo(q.z); S[5] -= bfhi(q.z); S[6] -= bflo(q.w); S[7] -= bfhi(q.w); }
          } }
    }
    xcd_barrier(bar);
    TP_END(12);

    TP_BEGIN(13);
    if (PHASE_MASK & 8) REPS(8) {
        PH_BEGIN();
        gm::StaticOrder S; S.init(WSP(bf16_t, WS_DO), WSP(bf16_t, WS_WM), 1024, 1024, NTOK, 1024, G, bx);
        gm::EpiMerge E{WSP(bf16_t, WS_GP), WSP(bf16_t, WS_GA), WSP(bf16_t, WS_MERGED)};
        dephase(vcu, DEPHASE3);
        gm::gemm_phase<3, gm::EpiMerge, gm::StaticOrder, gm::NT, false, true>(L, S, E, 1024, 1024 TP_ARGS);
    }
    xcd_barrier(bar);
    TP_END(13);

    TP_BEGIN(14);
    if (PHASE_MASK & 16) REPS(16) {
        PH_BEGIN();
        gm::StaticOrder S; S.init(WSP(bf16_t, WS_MERGED), WSP(bf16_t, WS_WO), 1024, 1024, NTOK, 1024, G, bx);
        gm::EpiRes E{args.in[0], WSP(bf16_t, WS_X1)};
        dephase(vcu, DEPHASE4);
        gm::gemm_phase<4, gm::EpiRes, gm::StaticOrder, gm::NT, false, false>(L, S, E, 1024, 1024 TP_ARGS);
    }
    xcd_barrier(bar);
    TP_END(14);

    TP_BEGIN(15);
    if (PHASE_MASK & 32) {
        PH_BEGIN();
        float* rstd2 = WSP(float, WS_RSTD); int* tcls = WSP(int, WS_TCLS); float* twlo = WSP(float, WS_TWLO); float* twhi = WSP(float, WS_TWHI);
        int* stok = WSP(int, WS_STOK); float* swlo = WSP(float, WS_SWLO); float* swhi = WSP(float, WS_SWHI); float* srstd = WSP(float, WS_SRSTD);
        const bf16_t* X1 = WSP(bf16_t, WS_X1); const bf16_t* WrH = WSP(bf16_t, WS_WRH); const bf16_t* WrL = WSP(bf16_t, WS_WRL);
        for (int i = gw * 64 + lane; i < MAXT * 256; i += NGW * 64) { stok[i] = -1; swlo[i] = 0.f; swhi[i] = 0.f; srstd[i] = 0.f; }
        constexpr int TROW = 1040, LG_OFF = 96 * TROW;
        const int row = lane & 15, kg = lane >> 4;
        const int tok0 = gw * 32;
        f32x4 acc[2][3];
#pragma unroll
        for (int rg = 0; rg < 2; ++rg)
#pragma unroll
            for (int nf = 0; nf < 3; ++nf) acc[rg][nf] = (f32x4){0.f, 0.f, 0.f, 0.f};
        float ss[2] = {0.f, 0.f};
        for (int blk0 = 0; blk0 < NTOK; blk0 += NGW * 32) {
          const int tb = blk0 + tok0; const bool live = tb < NTOK;
          for (int half = 0; half < 2; ++half) {
            __syncthreads();
            for (int i = tid; i < 96 * 64; i += NWAVES * 64) { const int r = i >> 6, c = i & 63;
                const bf16_t* src = (r < 48 ? WrH + (size_t)r * 1024 : WrL + (size_t)(r - 48) * 1024) + half * 512 + c * 8;
                *(LAS u32x4*)(L + r * TROW + c * 16) = *(const u32x4*)src; }
            __syncthreads();
            if (live) {
                const bf16_t* xa = X1 + (size_t)(tb + row) * 1024 + half * 512 + kg * 16;
#pragma unroll 4
                for (int sp = 0; sp < 8; ++sp) {
                    u32x4 A[2][2];
#pragma unroll
                    for (int rg = 0; rg < 2; ++rg) { A[rg][0] = *(const u32x4*)(xa + (size_t)rg * 16 * 1024 + sp * 64); A[rg][1] = *(const u32x4*)(xa + (size_t)rg * 16 * 1024 + sp * 64 + 8); }
#pragma unroll
                    for (int rg = 0; rg < 2; ++rg)
#pragma unroll
                        for (int hh = 0; hh < 2; ++hh) { const u32x4 v = A[rg][hh];
                            const float f0 = bflo(v.x), f1 = bfhi(v.x), f2 = bflo(v.y), f3 = bfhi(v.y), f4 = bflo(v.z), f5 = bfhi(v.z), f6 = bflo(v.w), f7 = bfhi(v.w);
                            ss[rg] += (f0 * f0 + f1 * f1) + (f2 * f2 + f3 * f3) + (f4 * f4 + f5 * f5) + (f6 * f6 + f7 * f7); }
#pragma unroll
                    for (int hh = 0; hh < 2; ++hh)
#pragma unroll
                        for (int nf = 0; nf < 3; ++nf) {
                            const bf16x8 Bh = *(const LAS bf16x8*)(L + (nf * 16 + row) * TROW + (sp * 64 + kg * 16 + hh * 8) * 2);
                            const bf16x8 Bl = *(const LAS bf16x8*)(L + (48 + nf * 16 + row) * TROW + (sp * 64 + kg * 16 + hh * 8) * 2);
#pragma unroll
                            for (int rg = 0; rg < 2; ++rg) { const bf16x8 Af = __builtin_bit_cast(bf16x8, A[rg][hh]);
                                acc[rg][nf] = __builtin_amdgcn_mfma_f32_16x16x32_bf16(Af, Bh, acc[rg][nf], 0, 0, 0);
                                acc[rg][nf] = __builtin_amdgcn_mfma_f32_16x16x32_bf16(Af, Bl, acc[rg][nf], 0, 0, 0); }
                        }
                }
            }
          }
          if (live) {
            LAS float* lg = (LAS float*)(L + LG_OFF + wave * 3072);
#pragma unroll
            for (int rg = 0; rg < 2; ++rg) {
                float s2 = ss[rg]; s2 += __shfl_xor(s2, 16); s2 += __shfl_xor(s2, 32);
                const float rstd = __builtin_amdgcn_rsqf(s2 * (1.0f / 1024.0f) + EPS);
#pragma unroll
                for (int nf = 0; nf < 3; ++nf)
#pragma unroll
                    for (int r = 0; r < 4; ++r) lg[(4 * kg + r) * 48 + 16 * nf + row] = acc[rg][nf][r];
                LDS_WAIT(); asm volatile("" ::: "memory");
                if (lane < 16) {
                    const int tok = tb + rg * 16 + lane;
                    const LAS float* my = lg + lane * 48;
                    float gl[4]; int g = 0;
#pragma unroll
                    for (int j = 0; j < 4; ++j) gl[j] = rstd * my[j] + args.in[17][j];
                    float gmx = gl[0];
#pragma unroll
                    for (int j = 1; j < 4; ++j) if (gl[j] > gmx) { gmx = gl[j]; g = j; }
                    float den = 0.f;
#pragma unroll
                    for (int j = 0; j < 4; ++j) den += __expf(gl[j] - gmx);
                    const float ptop = 1.0f / den;
                    float le[8];
#pragma unroll
                    for (int e = 0; e < 8; ++e) le[e] = rstd * my[4 + g * 8 + e] + args.in[19][g * 8 + e];
                    int e1 = 0; float v1 = le[0];
#pragma unroll
                    for (int e = 1; e < 8; ++e) if (le[e] > v1) { v1 = le[e]; e1 = e; }
                    int e2 = -1; float v2 = -3.0e38f;
#pragma unroll
                    for (int e = 0; e < 8; ++e) if (e != e1 && le[e] > v2) { v2 = le[e]; e2 = e; }
                    const float rr = __expf(v2 - v1), w1 = ptop / (1.0f + rr), w2 = ptop * rr / (1.0f + rr);
                    const int lo = e1 < e2 ? e1 : e2, hi2 = e1 < e2 ? e2 : e1;
                    const float wlo = e1 < e2 ? w1 : w2, whi = e1 < e2 ? w2 : w1;
                    const int cls = g * 28 + lo * 8 - (lo * (lo + 1)) / 2 + (hi2 - lo - 1);
                    tcls[tok] = cls; twlo[tok] = wlo; twhi[tok] = whi; rstd2[tok] = rstd;
                    atomicAdd((unsigned*)(ctl + CW_CNT) + cls * 16, 1u);
                }
                LDS_WAIT(); asm volatile("" ::: "memory");
                ss[rg] = 0.f;
#pragma unroll
                for (int nf = 0; nf < 3; ++nf) acc[rg][nf] = (f32x4){0.f, 0.f, 0.f, 0.f};
            }
          }
        }
    }
    xcd_barrier(bar);
    TP_END(15);

    TP_BEGIN(16);
    if (PHASE_MASK & 64) {
        PH_BEGIN();
        float* rstd2 = WSP(float, WS_RSTD); int* tcls = WSP(int, WS_TCLS); float* twlo = WSP(float, WS_TWLO); float* twhi = WSP(float, WS_TWHI);
        int* stok = WSP(int, WS_STOK); float* swlo = WSP(float, WS_SWLO); float* swhi = WSP(float, WS_SWHI); float* srstd = WSP(float, WS_SRSTD);
        int* tilecls = WSP(int, WS_TILECLS);
        LAS int* fstart = (LAS int*)(L);
        LAS int* hidx = (LAS int*)(L + 512);
        LAS int* nfull = (LAS int*)(L + 1024);
        LAS int* cntl = (LAS int*)(L + 1536);
        LAS int* tot = (LAS int*)(L + 2048);
        if (tid < NCLS) cntl[tid] = (int)__hip_atomic_load((unsigned*)(ctl + CW_CNT) + tid * 16, RLX_AGENT);
        __syncthreads();
        if (tid == 0) { int f = 0, h = 0;
            for (int c = 0; c < NCLS; ++c) { const int n = cntl[c], nt = (n + 255) >> 8, lr = n - 256 * (nt - 1); const int hf = (nt > 0 && lr <= 128) ? 1 : 0; nfull[c] = nt - hf; fstart[c] = f; f += nt - hf; hidx[c] = hf ? h : -1; h += hf; }
            for (int c = 0; c < NCLS; ++c) if (hidx[c] >= 0) hidx[c] += f;
            tot[0] = f; tot[1] = f + h; }
        __syncthreads();
        if (bx == 0) {
            if (tid < NCLS) { const int t0 = fstart[tid], nf = nfull[tid]; for (int t = 0; t < nf; ++t) tilecls[t0 + t] = tid; if (hidx[tid] >= 0) tilecls[hidx[tid]] = tid; }
            if (tid == 0) { __hip_atomic_store((unsigned*)(ctl + CW_NTILES), (unsigned)tot[1], RLX_AGENT); __hip_atomic_store((unsigned*)(ctl + CW_NTILES) + 1, (unsigned)tot[0], RLX_AGENT); }
        }
        for (int tok = bx * 512 + tid; tok < NTOK; tok += G * 512) {
            const int c = tcls[tok];
            const unsigned pos = atomicAdd((unsigned*)(ctl + CW_CUR) + c * 16, 1u);
            const int j = (int)(pos >> 8); const int tile = (j < nfull[c]) ? fstart[c] + j : hidx[c];
            const int slot = tile * 256 + (int)(pos & 255u);
            stok[slot] = tok; swlo[slot] = twlo[tok]; swhi[slot] = twhi[tok]; srstd[slot] = rstd2[tok];
        }
    }
    xcd_barrier(bar);
    TP_END(16);

    TP_BEGIN(17);
    if (PHASE_MASK & 128) REPS(128) {
        PH_BEGIN();
        LAS int* utab = (LAS int*)(L + UTAB_OFF); const int* tilecls = WSP(int, WS_TILECLS);
        const int ntiles = (int)__hip_atomic_load((unsigned*)(ctl + CW_NTILES), RLX_AGENT);
        const int nfullt = (int)__hip_atomic_load((unsigned*)(ctl + CW_NTILES) + 1, RLX_AGENT);
        if (tid < 16) { const int Lx = tid * G + vcu; const int tile = Lx >> 3, pn = Lx & 7; int e0 = 0, e1 = 0, tl = -1;
            if (tile < ntiles) { const int cls = tilecls[tile]; const int g = cls / 28; int rem = cls % 28, lo = 0; while (rem >= 7 - lo) { rem -= 7 - lo; ++lo; } e0 = g * 8 + lo; e1 = g * 8 + lo + 1 + rem; tl = tile; }
            utab[tid * 8 + 0] = tl; utab[tid * 8 + 1] = pn; utab[tid * 8 + 2] = e0; utab[tid * 8 + 3] = e1; utab[tid * 8 + 4] = (tile >= nfullt) ? 1 : 0; }
        __syncthreads();
        gm::MoeSched S{utab, (const char*)WSP(bf16_t, WS_X1), (const char*)WSP(bf16_t, WS_WGU), WSP(int, WS_STOK), 1};
        gm::EpiMoe1 E{WSP(float, WS_SRSTD), WSP(float, WS_SWLO), WSP(float, WS_SWHI), WSP(bf16_t, WS_HDN)};
        gm::gemm_phase<7, gm::EpiMoe1, gm::MoeSched, gm::NT, true, false>(L, S, E, 1024, 1024 TP_ARGS);
    }
    xcd_barrier(bar);
    TP_END(17);
    TP_BEGIN(18);
    if (PHASE_MASK & 256) {
        PH_BEGIN();
        LAS int* utab = (LAS int*)(L + UTAB_OFF); const int* tilecls = WSP(int, WS_TILECLS);
        const int ntiles = (int)__hip_atomic_load((unsigned*)(ctl + CW_NTILES), RLX_AGENT);
        const int nfullt = (int)__hip_atomic_load((unsigned*)(ctl + CW_NTILES) + 1, RLX_AGENT);
        if (tid < 16) { const int Lx = tid * G + vcu; const int tile = Lx >> 2, pn = Lx & 3; int e0 = 0, e1 = 0, tl = -1;
            if (tile < ntiles) { const int cls = tilecls[tile]; const int g = cls / 28; int rem = cls % 28, lo = 0; while (rem >= 7 - lo) { rem -= 7 - lo; ++lo; } e0 = g * 8 + lo; e1 = g * 8 + lo + 1 + rem; tl = tile; }
            utab[tid * 8 + 0] = tl; utab[tid * 8 + 1] = pn; utab[tid * 8 + 2] = e0; utab[tid * 8 + 3] = e1; utab[tid * 8 + 4] = (tile >= nfullt) ? 1 : 0; }
        __syncthreads();
        gm::MoeSched S{utab, (const char*)WSP(bf16_t, WS_HDN), (const char*)WSP(bf16_t, WS_WD), WSP(int, WS_STOK), 2};
        gm::EpiMoe2 E{WSP(int, WS_STOK), WSP(bf16_t, WS_X1), args.out};
        dephase(vcu, DEPHASE8);
        gm::gemm_phase<8, gm::EpiMoe2, gm::MoeSched, 8, false, false>(L, S, E, 1024, 512 TP_ARGS);
    }
    TP_END(18);
    TP_FINISH();
}

extern "C" void kernel_launch(void* const* d_in, const int* in_sizes, int n_in, void* d_out, int out_size, void* d_ws, size_t ws_size, hipStream_t stream) {
    static int grid = 0;
    if (grid == 0) {
        if (n_in != 23 || out_size != NTOK * DM || ws_size < WS_END) { fprintf(stderr, "kernel_launch: unexpected shapes (n_in %d, out %d, ws %zu)\n", n_in, out_size, ws_size); grid = -1; return; }
        int dev = 0, cus = 0;
        if (hipGetDevice(&dev) != hipSuccess || hipDeviceGetAttribute(&cus, hipDeviceAttributeMultiprocessorCount, dev) != hipSuccess) { grid = -1; return; }
        if (hipFuncSetAttribute((const void*)hybrid_fwd, hipFuncAttributeMaxDynamicSharedMemorySize, LDS_BYTES) != hipSuccess) { fprintf(stderr, "kernel_launch: hipFuncSetAttribute failed\n"); grid = -1; return; }
        int per_cu = 0;
        if (hipOccupancyMaxActiveBlocksPerMultiprocessor(&per_cu, (const void*)hybrid_fwd, NWAVES * 64, LDS_BYTES) != hipSuccess || per_cu < 1) fprintf(stderr, "kernel_launch: occupancy query says %d\n", per_cu);
        (void)hipGetLastError();
        grid = cus;
        if (grid != 256) fprintf(stderr, "kernel_launch: %d CUs (built for 256)\n", grid);
    }
    if (grid < 0) return;
    if (hipMemsetAsync((char*)d_ws + WS_CTL, 0, CTL_ZERO_BYTES, stream) != hipSuccess) return;
    Args a{};
    for (int i = 0; i < 23; ++i) a.in[i] = (const float*)d_in[i];
    a.out = (float*)d_out; a.ws = (unsigned char*)d_ws;
    hipLaunchKernelGGL(hybrid_fwd, dim3(grid), dim3(NWAVES * 64), LDS_BYTES, stream, a);
}
```

```cpp
#include <hip/hip_runtime.h>
#include <hip/hip_bf16.h>
#include <cstdio>
#include <cstdint>

#define LAS __attribute__((address_space(3)))
#define GAS __attribute__((address_space(1)))
typedef unsigned short bf16_t;
typedef short bf16x8 __attribute__((ext_vector_type(8)));
typedef short s16x4 __attribute__((ext_vector_type(4)));
typedef float f32x2 __attribute__((ext_vector_type(2)));
typedef float f32x4 __attribute__((ext_vector_type(4)));
typedef float f32x16 __attribute__((ext_vector_type(16)));
typedef unsigned u32x4 __attribute__((ext_vector_type(4)));
typedef unsigned u32x2 __attribute__((ext_vector_type(2)));
typedef GAS unsigned gu32;
typedef int i32x4 __attribute__((ext_vector_type(4)));
typedef int i32x8 __attribute__((ext_vector_type(8)));
#define RLX_AGENT __ATOMIC_RELAXED, __HIP_MEMORY_SCOPE_AGENT
#define LDS_WAIT() asm volatile("s_waitcnt lgkmcnt(0)" ::: "memory")
#define VM_WAIT() asm volatile("s_waitcnt vmcnt(0)" ::: "memory")

#ifndef PHASE_MASK
#define PHASE_MASK 0x1ff
#endif
#ifndef DUP_MASK
#define DUP_MASK 0
#endif
#ifdef TPROBE
#ifndef TP_AMP
#define TP_AMP 4
#endif
#ifndef TP_WAVE
#define TP_WAVE 0
#endif
__device__ __forceinline__ unsigned long long tp_now() { unsigned long long t; __builtin_amdgcn_sched_barrier(0); asm volatile("s_memrealtime %0\n\ts_waitcnt lgkmcnt(0)" : "=s"(t) :: "memory"); __builtin_amdgcn_sched_barrier(0); return t; }
#define TP_DECL() unsigned long long tp_t0 = 0, tp_acc = 0; (void)tp_t0
#define TP_PARAMS , unsigned long long& tp_t0, unsigned long long& tp_acc
#define TP_ARGS , tp_t0, tp_acc
#define TP_BEGIN(k) do { if ((k) == TPROBE) tp_t0 = tp_now(); } while (0)
#define TP_END(k) do { if ((k) == TPROBE) tp_acc += tp_now() - tp_t0; } while (0)
#define TP_FINISH() do { if (blockIdx.x == 0 && threadIdx.x == TP_WAVE * 64) { const unsigned long long s0 = tp_now(); while (tp_now() - s0 < tp_acc * TP_AMP) __builtin_amdgcn_s_sleep(8); } } while (0)
#else
#define TP_DECL()
#define TP_PARAMS
#define TP_ARGS
#define TP_BEGIN(k)
#define TP_END(k)
#define TP_FINISH()
#endif
#define REPS(bit) for (int rep_ = 0; rep_ < ((DUP_MASK & (bit)) ? 2 : 1); ++rep_)

constexpr int NTOK = 65536, DM = 1024, SEQ = 2048;
constexpr float LOG2E = 1.4426950408889634f;
constexpr float EPS = 1e-6f;
constexpr int NCLS = 112, MAXT = 368;
constexpr int NWAVES = 8;

constexpr size_t MiB = 1u << 20;
constexpr size_t WS_CTL = 0, CTL_ZERO_BYTES = 1 * MiB;
constexpr size_t WS_RSTD = 1 * MiB, WS_TCLS = WS_RSTD + 256 * 1024, WS_TWLO = WS_TCLS + 256 * 1024, WS_TWHI = WS_TWLO + 256 * 1024;
constexpr size_t WS_STOK = 2 * MiB, WS_SWLO = WS_STOK + 512 * 1024, WS_SWHI = WS_SWLO + 512 * 1024, WS_SRSTD = WS_SWHI + 512 * 1024;
constexpr size_t WS_TILECLS = 4 * MiB;
constexpr size_t WS_WRH = 5 * MiB, WS_WRL = WS_WRH + 128 * 1024;
constexpr size_t WS_WIN = 16 * MiB, WS_WM = 24 * MiB, WS_WO = 26 * MiB;
constexpr size_t WS_WGU = 32 * MiB, WS_WD = 96 * MiB;
constexpr size_t WS_H = 128 * MiB;
constexpr size_t WS_U = 256 * MiB, WS_Q = 320 * MiB, WS_K = 384 * MiB, WS_V = 448 * MiB;
constexpr size_t WS_GP = 512 * MiB, WS_GA = 640 * MiB;
constexpr size_t WS_DO = 768 * MiB;
constexpr size_t WS_END = 896 * MiB;
constexpr size_t WS_MERGED = WS_H, WS_X1 = WS_U, WS_HDN = WS_GP, WS_X1F8 = WS_K;
constexpr int CW_TMO = 0, CW_NTILES = 16, CW_BAR = 4096, CW_CNT = 8192, CW_CUR = 10240, CW_ATTQ = 12288;

constexpr int RING_BYTES = 131072;
constexpr int LDSCTL_OFF = RING_BYTES, MISC_OFF = LDSCTL_OFF + 320, UTAB_OFF = LDSCTL_OFF + 1024;
constexpr int JUNK_OFF = LDSCTL_OFF + 8192;
constexpr int LDS_BYTES = 147456;

__device__ __forceinline__ unsigned f2bf(float f) { unsigned u = __builtin_bit_cast(unsigned, f); return (u + 0x7fffu + ((u >> 16) & 1u)) >> 16; }
__device__ __forceinline__ unsigned pk2(float lo, float hi) { return f2bf(lo) | (f2bf(hi) << 16); }
__device__ __forceinline__ float bf2f(unsigned short b) { return __builtin_bit_cast(float, (unsigned)b << 16); }
__device__ __forceinline__ float bflo(unsigned w) { return __builtin_bit_cast(float, w << 16); }
__device__ __forceinline__ float bfhi(unsigned w) { return __builtin_bit_cast(float, w & 0xffff0000u); }
__device__ __forceinline__ unsigned cvt_pk_bf16(float lo, float hi) { unsigned r; asm("v_cvt_pk_bf16_f32 %0, %1, %2" : "=v"(r) : "v"(lo), "v"(hi)); return r; }

__device__ __forceinline__ unsigned pk4_f8(float a, float b, float c, float d) { int w = 0; w = __builtin_amdgcn_cvt_pk_fp8_f32(a, b, w, false); w = __builtin_amdgcn_cvt_pk_fp8_f32(c, d, w, true); return (unsigned)w; }
constexpr float F8_WSCALE = 32.0f, F8_HSCALE = 16.0f;

#define XB_TMO      128
#define XB_XCNT(j)  (256  + 64 * (j))
#define XB_XSUB(j)  (1280 + 64 * (j))
#define XB_XGEN(j)  (2304 + 64 * (j))
#define XB_TOP      3328
#define XB_TOPGEN   3392
#define XCD_BAR_WORDS 3456
#define XB_SPIN_CAP (1u << 18)
__device__ __forceinline__ unsigned xb_ld(unsigned* p)              { return __hip_atomic_load(p, __ATOMIC_RELAXED, __HIP_MEMORY_SCOPE_AGENT); }
__device__ __forceinline__ unsigned xb_add(unsigned* p, unsigned v) { return __hip_atomic_fetch_add(p, v, __ATOMIC_RELAXED, __HIP_MEMORY_SCOPE_AGENT); }
__device__ __forceinline__ unsigned xb_xcc_id() { return (unsigned)__builtin_amdgcn_s_getreg((3 << 11) | 20) & 0xFu; }
#define XB_SPIN(cond, bar) do { unsigned _sp = 0; while (cond) { __builtin_amdgcn_s_sleep(1); \
    if ((++_sp & 255u) == 0u) { if (xb_ld(&(bar)[XB_TMO])) break; if (_sp > XB_SPIN_CAP) { atomicAdd(&(bar)[XB_TMO], 1u); break; } } } } while (0)
struct XcdBarrier { unsigned* bar; unsigned x; volatile LAS unsigned* st; };
__device__ __forceinline__ XcdBarrier xcd_barrier_post(unsigned* bar, volatile LAS unsigned* st) {
    XcdBarrier b; b.bar = bar; b.x = xb_xcc_id(); b.st = st;
    if (threadIdx.x == 0) (void)xb_add(&bar[XB_XCNT(b.x)], 1u);
    return b;
}
__device__ __forceinline__ void xcd_barrier_complete(unsigned* bar, unsigned x, unsigned& nloc, unsigned& nx) {
    const unsigned G = gridDim.x * gridDim.y * gridDim.z;
    unsigned sum, cnt, mine, sp = 0u;
    for (;;) {
        sum = 0u; cnt = 0u; mine = 0u;
#pragma unroll
        for (unsigned j = 0; j < 16; ++j) { const unsigned c = xb_ld(&bar[XB_XCNT(j)]); sum += c; cnt += (c > 0u) ? 1u : 0u; mine = (j == x) ? c : mine; }
        if (sum == G) break;
        __builtin_amdgcn_s_sleep(1);
        if ((++sp & 255u) == 0u) { if (xb_ld(&bar[XB_TMO])) break; if (sp > XB_SPIN_CAP) { atomicAdd(&bar[XB_TMO], 1u); break; } }
    }
    nloc = mine > 0u ? mine : 1u; nx = cnt > 0u ? cnt : 1u;
}
__device__ __forceinline__ void xcd_barrier(const XcdBarrier& b) {
    asm volatile("s_waitcnt vmcnt(0)" ::: "memory");
    __syncthreads();
    if (threadIdx.x == 0) {
        unsigned* bar = b.bar;
        __builtin_amdgcn_s_waitcnt(0);
        unsigned nloc = b.st[0], nx = b.st[1];
        if (nloc == 0u) { xcd_barrier_complete(bar, b.x, nloc, nx); b.st[0] = nloc; b.st[1] = nx; }
        const unsigned old = xb_add(&bar[XB_XSUB(b.x)], 1u);
        const unsigned gen = old / nloc;
        if (old + 1u == (gen + 1u) * nloc) {
            __builtin_amdgcn_fence(__ATOMIC_RELEASE, "agent");
            asm volatile("s_waitcnt vmcnt(0)" ::: "memory");
            const unsigned og = xb_add(&bar[XB_TOP], 1u);
            const unsigned tg = og / nx;
            if (og + 1u == (tg + 1u) * nx) xb_add(&bar[XB_TOPGEN], 1u);
            else XB_SPIN(xb_ld(&bar[XB_TOPGEN]) == tg, bar);
            __builtin_amdgcn_fence(__ATOMIC_ACQUIRE, "agent");
            xb_add(&bar[XB_XGEN(b.x)], 1u);
            asm volatile("s_waitcnt vmcnt(0)" ::: "memory");
        } else {
            XB_SPIN(xb_ld(&bar[XB_XGEN(b.x)]) == gen, bar);
            __builtin_amdgcn_fence(__ATOMIC_ACQUIRE, "agent");
            asm volatile("s_waitcnt vmcnt(0)" ::: "memory");
        }
    }
    __syncthreads();
}

namespace gm {
constexpr int BM = 256, BK = 64, HALF = 128, HTB = HALF * BK * 2, NXCD = 8, WGM = 8, NT = 16;
__host__ __device__ __forceinline__ int lds_byte(int r, int c) { const int st = (r >> 4) * 2 + (c >> 5), rr = r & 15, cc = c & 31, ob = rr * 64 + cc * 2; return st * 1024 + (ob ^ (((ob >> 9) & 1) << 5)); }
__host__ __device__ __forceinline__ void stage_rc(int b, int& R, int& C) { const int st = b / 1024, sb = b % 1024, swz = sb ^ (((sb >> 9) & 1) << 5); R = (st >> 1) * 16 + swz / 64; C = (st & 1) * 32 + (swz % 64) / 2; }
__host__ __device__ __forceinline__ int perm32(int rho) { const int n = rho >> 4, i = rho & 15; return 8 * (i >> 2) + 4 * n + (i & 3); }

struct Unit { const char* a; const char* b0; const char* b1; int pm, pn, e0, e1, half; };

struct StaticOrder {
    const char* A; const char* Bt; int lda, ldb; int nM, nN, nwg, G, c;
    __device__ void init(const void* A_, const void* Bt_, int lda_, int ldb_, int M, int N, int G_, int c_) { A = (const char*)A_; Bt = (const char*)Bt_; lda = lda_; ldb = ldb_; nM = M / BM; nN = N / BM; nwg = nM * nN; G = G_; c = c_; }
    __device__ __forceinline__ bool next(int i, Unit& u) const {
        const long L = (long)i * G + c; if (L >= nwg) return false;
        int wgid = (int)L; { const int q = nwg / NXCD, r = nwg % NXCD, xcd = wgid % NXCD, off = wgid / NXCD; wgid = (xcd < r ? xcd * (q + 1) : r * (q + 1) + (xcd - r) * q) + off; }
        const int nig = WGM * nN, gid = wgid / nig, fm = gid * WGM, gsz = (nM - fm) < WGM ? (nM - fm) : WGM;
        u.pm = fm + ((wgid % nig) % gsz); u.pn = (wgid % nig) / gsz; u.e0 = 0; u.e1 = 0; u.half = 0;
        u.a = A + (size_t)u.pm * BM * lda * 2; u.b0 = Bt + (size_t)u.pn * BM * ldb * 2; u.b1 = u.b0;
        return true;
    }
    __device__ __forceinline__ void offs(const Unit&, const int (&)[2], const int (&)[2], unsigned (&)[2][2]) const {}
};

template <int PH, class Epi, class Sched, int KS, bool GATHER, bool MID, bool F8 = false, int NTT = 16>
__device__ __forceinline__ void gemm_phase(LAS unsigned char* lds, const Sched& S, const Epi& E, const int lda, const int ldb TP_PARAMS) {
    int tid = threadIdx.x; asm volatile("" : "+v"(tid));
    const int wid = __builtin_amdgcn_readfirstlane(tid >> 6), lane = tid & 63, wr = wid >> 2, wc = wid & 3, fr = lane & 15, fq = lane >> 4;
    int Rr[2], Cc[2]; unsigned offA[2][2], offAn[2][2], voffB[2];
#pragma unroll
    for (int i = 0; i < 2; ++i) { int R, C; stage_rc(tid * 16 + i * 8192, R, C); Rr[i] = R; Cc[i] = C; const int Rb = Epi::PERM ? ((R & ~31) + perm32(R & 31)) : R;
        voffB[i] = (unsigned)(Rb * ldb + C) * 2u;
        offA[0][i] = (unsigned)(R * lda + C) * 2u; offA[1][i] = (unsigned)((R + HALF) * lda + C) * 2u; offAn[0][i] = offA[0][i]; offAn[1][i] = offA[1][i]; }
    const size_t kstep = (size_t)(BK * 2);
    const size_t hstepB = (size_t)HALF * ldb * 2;
    const unsigned ldsw = (unsigned)wid * 1024u;
    const int aoff = lds_byte(wr * 64 + fr, fq * 8), boff = lds_byte(wc * 32 + fr, fq * 8);
#define G_SA(b, h) (((b) * 2 + (h)) * HTB)
#define G_SB(b, h) ((4 + (b) * 2 + (h)) * HTB)
#define G_STAGE_A(bufoff, gbase, OFF, h) do { _Pragma("unroll") for (int _i = 0; _i < 2; ++_i) \
        __builtin_amdgcn_global_load_lds((const unsigned*)((const char*)(gbase) + (OFF)[h][_i]), (LAS unsigned*)(lds + (bufoff) + ldsw + _i * 8192), 16, 0, 0); } while (0)
#define G_STAGE_B(bufoff, gbase) do { _Pragma("unroll") for (int _i = 0; _i < 2; ++_i) \
        __builtin_amdgcn_global_load_lds((const unsigned*)((const char*)(gbase) + voffB[_i]), (LAS unsigned*)(lds + (bufoff) + ldsw + _i * 8192), 16, 0, 0); } while (0)
#define G_LD16(off) (*(const LAS bf16x8*)(lds + (off)))
#define G_CAT2(x, y) __builtin_shufflevector(__builtin_bit_cast(i32x4, x), __builtin_bit_cast(i32x4, y), 0, 1, 2, 3, 4, 5, 6, 7)
#define G_LDA(dst, b, h) do { _Pragma("unroll") for (int m = 0; m < 4; ++m) { if constexpr (F8) { dst##8[m] = G_CAT2(G_LD16(G_SA(b, h) + aoff + m * 2048), G_LD16(G_SA(b, h) + aoff + m * 2048 + 1024)); } \
        else { _Pragma("unroll") for (int k = 0; k < 2; ++k) dst[m][k] = G_LD16(G_SA(b, h) + aoff + m * 2048 + k * 1024); } } } while (0)
#define G_LDB(dst, b, h) do { _Pragma("unroll") for (int n = 0; n < 2; ++n) { if constexpr (F8) { dst##8[n] = G_CAT2(G_LD16(G_SB(b, h) + boff + n * 2048), G_LD16(G_SB(b, h) + boff + n * 2048 + 1024)); } \
        else { _Pragma("unroll") for (int k = 0; k < 2; ++k) dst[n][k] = G_LD16(G_SB(b, h) + boff + n * 2048 + k * 1024); } } } while (0)
#define G_MMA(ai, bj, At, Bt) do { __builtin_amdgcn_s_setprio(1); \
        if constexpr (F8) { _Pragma("unroll") for (int m = 0; m < 4; ++m) _Pragma("unroll") for (int n = 0; n < 2; ++n) \
            acc[ai][bj][m][n] = __builtin_amdgcn_mfma_scale_f32_16x16x128_f8f6f4(Bt##8[n], At##8[m], acc[ai][bj][m][n], 0, 0, 0, 0x7F7F7F7F, 0, 0x7F7F7F7F); } \
        else { _Pragma("unroll") for (int m = 0; m < 4; ++m) _Pragma("unroll") for (int n = 0; n < 2; ++n) _Pragma("unroll") for (int k = 0; k < 2; ++k) \
            acc[ai][bj][m][n] = __builtin_amdgcn_mfma_f32_16x16x32_bf16(Bt[n][k], At[m][k], acc[ai][bj][m][n], 0, 0, 0); } \
        __builtin_amdgcn_s_setprio(0); } while (0)
#define G_WAIT_V(n) asm volatile("s_waitcnt vmcnt(" #n ")" ::: "memory")
#define G_WAIT_L(n) asm volatile("s_waitcnt lgkmcnt(" #n ")" ::: "memory")
#define G_BAR __builtin_amdgcn_s_barrier()
#define G_SCHED __builtin_amdgcn_sched_barrier(0)
#define G_BP(u, t) ((t) < KS ? (u).b0 + (size_t)(t) * kstep : (u).b1 + (size_t)((t) - KS) * kstep)
    Unit cur, nxt; int ui = 0;
    if (!S.next(0, cur)) return;
    if constexpr (GATHER) S.offs(cur, Rr, Cc, offA);
    f32x4 acc[2][2][4][2];
#pragma unroll
    for (int a = 0; a < 2; ++a)
#pragma unroll
        for (int b = 0; b < 2; ++b)
#pragma unroll
            for (int m = 0; m < 4; ++m)
#pragma unroll
                for (int n = 0; n < 2; ++n) acc[a][b][m][n] = (f32x4){0.f, 0.f, 0.f, 0.f};
    bf16x8 At[4][2], B0[2][2], B1[2][2]; i32x8 At8[4], B08[2], B18[2];
    {
        const char* cA = cur.a; const char* cB = cur.b0; const char* cB1 = G_BP(cur, 1);
        G_STAGE_B(G_SB(0, 0), cB); G_STAGE_B(G_SB(0, 1), cB + hstepB); G_STAGE_A(G_SA(0, 0), cA, offA, 0); G_STAGE_A(G_SA(0, 1), cA, offA, 1);
        if (wr == 1) G_BAR;
        G_WAIT_V(2); G_BAR;
        G_STAGE_B(G_SB(1, 0), cB1); G_STAGE_A(G_SA(1, 0), cA + kstep, offA, 0); G_STAGE_B(G_SB(1, 1), cB1 + hstepB);
        G_WAIT_V(6); G_BAR;
    }
    for (;;) {
        const bool has_next = S.next(ui + 1, nxt);
#if defined(EPI_PREFETCH)
        E.prefetch(cur, wr, wc, lane, (LAS unsigned*)(lds + JUNK_OFF + wid * 256));
#endif
        TP_BEGIN(100 + PH * 10);
#pragma nounroll
        for (int t = 0; t < NTT; t += 2) {
            const bool last = (t == NTT - 2);
            if constexpr (MID) { if (t == NTT / 2) { TP_BEGIN(102 + PH * 10); E.mid(acc, cur, wr, wc, fr, fq); TP_END(102 + PH * 10); } }
            if constexpr (GATHER) { if (t == NTT - 4 && has_next) S.offs(nxt, Rr, Cc, offAn); }
            const char* a1 = cur.a + (size_t)(t + 1) * kstep;
            const bool sw = last && has_next;
            const int t2 = last ? 0 : t + 2;
            const char* ua = sw ? nxt.a : cur.a; const char* ub0 = sw ? nxt.b0 : cur.b0; const char* ub1 = sw ? nxt.b1 : cur.b1;
            const char* a2 = ua + (size_t)t2 * kstep; const char* a3 = a2 + kstep;
            const char* b2 = (t2 < KS) ? ub0 + (size_t)t2 * kstep : ub1 + (size_t)(t2 - KS) * kstep;
            const char* b3 = (t2 + 1 < KS) ? ub0 + (size_t)(t2 + 1) * kstep : ub1 + (size_t)(t2 + 1 - KS) * kstep;
            G_LDB(B0, 0, 0); G_LDB(B1, 0, 1); G_SCHED; G_LDA(At, 0, 0); G_STAGE_A(G_SA(1, 1), a1, offA, 1);
            G_WAIT_V(8); G_WAIT_L(0); G_BAR; G_MMA(0, 0, At, B0); G_MMA(0, 1, At, B1); G_BAR; G_SCHED;
            if constexpr (GATHER) { if (sw) {
#pragma unroll
                for (int h = 0; h < 2; ++h)
#pragma unroll
                    for (int i = 0; i < 2; ++i) offA[h][i] = offAn[h][i]; } }
            G_LDA(At, 0, 1); G_STAGE_B(G_SB(0, 0), b2); G_STAGE_B(G_SB(0, 1), b2 + hstepB); G_STAGE_A(G_SA(0, 0), a2, offA, 0);
            G_WAIT_V(8); G_WAIT_L(0); G_BAR; if (F8 || !cur.half) { G_MMA(1, 0, At, B0); G_MMA(1, 1, At, B1); } G_BAR; G_SCHED;
            G_LDB(B0, 1, 0); G_LDB(B1, 1, 1); G_SCHED; G_LDA(At, 1, 0); G_STAGE_A(G_SA(0, 1), a2, offA, 1);
            G_WAIT_V(8); G_WAIT_L(0); G_BAR; G_MMA(0, 0, At, B0); G_MMA(0, 1, At, B1); G_BAR; G_SCHED;
            G_LDA(At, 1, 1); G_STAGE_B(G_SB(1, 0), b3); G_STAGE_B(G_SB(1, 1), b3 + hstepB); G_STAGE_A(G_SA(1, 0), a3, offA, 0);
            G_WAIT_V(8); G_WAIT_L(0); G_BAR; if (F8 || !cur.half) { G_MMA(1, 0, At, B0); G_MMA(1, 1, At, B1); } G_BAR; G_SCHED;
        }
        TP_END(100 + PH * 10); TP_BEGIN(101 + PH * 10);
        if (wr == 0) G_BAR;
        E(acc, cur, wr, wc, fr, fq);
        TP_END(101 + PH * 10);
        if (!has_next) break;
#pragma unroll
        for (int a = 0; a < 2; ++a)
#pragma unroll
            for (int b = 0; b < 2; ++b)
#pragma unroll
                for (int m = 0; m < 4; ++m)
#pragma unroll
                    for (int n = 0; n < 2; ++n) acc[a][b][m][n] = (f32x4){0.f, 0.f, 0.f, 0.f};
        cur = nxt; ++ui;
        if (wr == 1) G_BAR;
    }
    G_WAIT_V(0);
    G_BAR;
#undef G_SA
#undef G_SB
#undef G_STAGE_A
#undef G_STAGE_B
#undef G_LDA
#undef G_LDB
#undef G_MMA
#undef G_CAT2
#undef G_LD16
#undef G_WAIT_V
#undef G_WAIT_L
#undef G_BAR
#undef G_SCHED
#undef G_BP
}

__device__ __forceinline__ void st8(bf16_t* p, f32x4 v0, f32x4 v1) { u32x4 w; w.x = cvt_pk_bf16(v0[0], v0[1]); w.y = cvt_pk_bf16(v0[2], v0[3]); w.z = cvt_pk_bf16(v1[0], v1[1]); w.w = cvt_pk_bf16(v1[2], v1[3]); *(u32x4*)p = w; }
__device__ __forceinline__ float sigm(float z) { return __builtin_amdgcn_rcpf(1.0f + __builtin_amdgcn_exp2f(-z * LOG2E)); }

__device__ __forceinline__ void touch(const void* p, LAS unsigned* junk) { __builtin_amdgcn_global_load_lds((const unsigned*)p, junk, 4, 0, 0); }

struct EpiProj {
    static constexpr bool PERM = true;
    __device__ __forceinline__ void prefetch(const Unit&, int, int, int, LAS unsigned*) const {}
    bf16_t *U, *Q, *K, *V, *GP, *GA; const float *gq, *gk;
    __device__ __forceinline__ void mid(f32x4 (&)[2][2][4][2], const Unit&, int, int, int, int) const {}
    __device__ __forceinline__ void operator()(const f32x4 (&acc)[2][2][4][2], const Unit& u, int wr, int wc, int fr, int fq) const {
        const int pn = u.pn; const int row0 = u.pm * BM + wr * 64 + fr;
        if (pn < 2) {
            const int col0 = (pn & 1) * 256 + wc * 32 + 8 * fq;
#pragma unroll
            for (int ai = 0; ai < 2; ++ai)
#pragma unroll
                for (int m = 0; m < 4; ++m) { bf16_t* rowp = U + (size_t)(row0 + ai * HALF + m * 16) * 512 + col0;
#pragma unroll
                    for (int bj = 0; bj < 2; ++bj) st8(rowp + bj * HALF, acc[ai][bj][m][0], acc[ai][bj][m][1]); }
        } else if (pn == 6 || pn == 7) {
#pragma unroll
            for (int ai = 0; ai < 2; ++ai)
#pragma unroll
                for (int m = 0; m < 4; ++m) { const int row = row0 + ai * HALF + m * 16, b = row >> 11, t = row & 2047;
#pragma unroll
                    for (int bj = 0; bj < 2; ++bj) { const int bh = b * 4 + 2 * (pn - 6) + bj;
                        st8(V + ((((size_t)bh * 32 + (t >> 6)) * 16 + (wc * 4 + ((t >> 4) & 3))) * 16 + (t & 15)) * 32 + 8 * fq, acc[ai][bj][m][0], acc[ai][bj][m][1]); } }
        } else if (pn < 6) {
            const bool isq = pn < 4; bf16_t* base = isq ? Q : K; const float* g = isq ? gq : gk; const float sc = isq ? (0.125f * LOG2E) : 1.0f;
            f32x4 gv[2][2];
#pragma unroll
            for (int bj = 0; bj < 2; ++bj) { gv[bj][0] = *(const f32x4*)(g + 32 * bj + 8 * fq); gv[bj][1] = *(const f32x4*)(g + 32 * bj + 8 * fq + 4); }
            const int col0 = (pn & 1) * 256 + 64 * wc + 8 * fq;
#pragma unroll
            for (int ai = 0; ai < 2; ++ai)
#pragma unroll
                for (int m = 0; m < 4; ++m) {
                    float ss = 0.f;
#pragma unroll
                    for (int bj = 0; bj < 2; ++bj)
#pragma unroll
                        for (int n = 0; n < 2; ++n) { const f32x4 x = acc[ai][bj][m][n]; ss += (x[0] * x[0] + x[1] * x[1]) + (x[2] * x[2] + x[3] * x[3]); }
                    ss += __shfl_xor(ss, 16); ss += __shfl_xor(ss, 32);
                    const float rinv = __builtin_amdgcn_rsqf(ss * (1.0f / 64.0f) + EPS) * sc;
                    const int row = row0 + ai * HALF + m * 16;
                    if (isq) { bf16_t* rowp = base + (size_t)row * 512 + col0;
#pragma unroll
                        for (int bj = 0; bj < 2; ++bj) st8(rowp + 32 * bj, acc[ai][bj][m][0] * rinv * gv[bj][0], acc[ai][bj][m][1] * rinv * gv[bj][1]);
                    } else {
                        const int b = row >> 11, t = row & 2047, sh = (pn - 4) * 4 + wc, bh = b * 4 + (sh >> 1), mm = sh & 1;
#pragma unroll
                        for (int bj = 0; bj < 2; ++bj) st8(base + (((((size_t)bh * 2 + mm) * 32 + (t >> 6)) * 8 + (4 * bj + fq)) * 64 + (t & 63)) * 8, acc[ai][bj][m][0] * rinv * gv[bj][0], acc[ai][bj][m][1] * rinv * gv[bj][1]);
                    }
                }
        } else {
            const int col0 = (pn - 8) * 128 + wc * 32 + 8 * fq;
#pragma unroll
            for (int ai = 0; ai < 2; ++ai)
#pragma unroll
                for (int m = 0; m < 4; ++m) { const size_t off = (size_t)(row0 + ai * HALF + m * 16) * 1024 + col0;
                    f32x4 r0, r1, a0, a1;
#pragma unroll
                    for (int i = 0; i < 4; ++i) {
                        const float ea0 = __builtin_amdgcn_exp2f(-acc[ai][1][m][0][i] * LOG2E), ea1 = __builtin_amdgcn_exp2f(-acc[ai][1][m][1][i] * LOG2E);
                        a0[i] = __builtin_amdgcn_rcpf(1.0f + ea0); a1[i] = __builtin_amdgcn_rcpf(1.0f + ea1);
                        r0[i] = sigm(acc[ai][0][m][0][i]) * (1.0f + ea0); r1[i] = sigm(acc[ai][0][m][1][i]) * (1.0f + ea1); }
                    st8(GP + off, r0, r1); st8(GA + off, a0, a1); }
        }
    }
};

struct EpiMerge {
    static constexpr bool PERM = true;
    const bf16_t *GP, *GA; bf16_t* O;
    __device__ __forceinline__ void prefetch(const Unit& u, int wr, int wc, int lane, LAS unsigned* junk) const {
#pragma unroll
        for (int q = 0; q < 4; ++q) { const int idx = q * 64 + lane, ri = idx >> 1, bj = idx & 1; const int row = u.pm * BM + 128 * (ri >> 6) + 64 * wr + (ri & 63);
            const size_t off = (size_t)row * 1024 + u.pn * BM + wc * 32 + bj * HALF; touch(GP + off, junk); touch(GA + off, junk); }
    }
    __device__ __forceinline__ void mid(f32x4 (&acc)[2][2][4][2], const Unit& u, int wr, int wc, int fr, int fq) const {
        int row0 = u.pm * BM + wr * 64 + fr; const int col0 = u.pn * BM + wc * 32 + 8 * fq;
        asm volatile("" : "+v"(row0));
#pragma unroll
        for (int ai = 0; ai < 2; ++ai) {
            u32x4 pv[4][2];
#pragma unroll
            for (int m = 0; m < 4; ++m) { const size_t off = (size_t)(row0 + ai * HALF + m * 16) * 1024 + col0;
#pragma unroll
                for (int bj = 0; bj < 2; ++bj) pv[m][bj] = *(const u32x4*)(GP + off + bj * HALF); }
#pragma unroll
            for (int m = 0; m < 4; ++m)
#pragma unroll
                for (int bj = 0; bj < 2; ++bj) { const u32x4 p = pv[m][bj];
                    const f32x4 r0 = {bflo(p.x), bfhi(p.x), bflo(p.y), bfhi(p.y)}, r1 = {bflo(p.z), bfhi(p.z), bflo(p.w), bfhi(p.w)};
                    acc[ai][bj][m][0] *= r0; acc[ai][bj][m][1] *= r1; }
            asm volatile("" ::: "memory");
        }
    }
    __device__ __forceinline__ void operator()(const f32x4 (&acc)[2][2][4][2], const Unit& u, int wr, int wc, int fr, int fq) const {
        const int row0 = u.pm * BM + wr * 64 + fr, col0 = u.pn * BM + wc * 32 + 8 * fq;
#pragma unroll
        for (int ai = 0; ai < 2; ++ai) {
            u32x4 av[4][2];
#pragma unroll
            for (int m = 0; m < 4; ++m)
#pragma unroll
                for (int bj = 0; bj < 2; ++bj) av[m][bj] = *(const u32x4*)(GA + (size_t)(row0 + ai * HALF + m * 16) * 1024 + col0 + bj * HALF);
#pragma unroll
            for (int m = 0; m < 4; ++m)
#pragma unroll
                for (int bj = 0; bj < 2; ++bj) { const u32x4 a = av[m][bj];
                    const f32x4 g0 = {bflo(a.x), bfhi(a.x), bflo(a.y), bfhi(a.y)}, g1 = {bflo(a.z), bfhi(a.z), bflo(a.w), bfhi(a.w)};
                    st8(O + (size_t)(row0 + ai * HALF + m * 16) * 1024 + col0 + bj * HALF, acc[ai][bj][m][0] * g0, acc[ai][bj][m][1] * g1); }
            asm volatile("" ::: "memory");
        }
    }
};

struct EpiRes {
    static constexpr bool PERM = true;
    const float* X; bf16_t* O; unsigned char* O8;
    __device__ __forceinline__ void prefetch(const Unit& u, int wr, int wc, int lane, LAS unsigned* junk) const {
#pragma unroll
        for (int q = 0; q < 4; ++q) { const int idx = q * 64 + lane, ri = idx >> 1, bj = idx & 1; const int row = u.pm * BM + 128 * (ri >> 6) + 64 * wr + (ri & 63);
            touch(X + (size_t)row * 1024 + u.pn * BM + wc * 32 + bj * HALF, junk); }
    }
    __device__ __forceinline__ void mid(f32x4 (&)[2][2][4][2], const Unit&, int, int, int, int) const {}
    __device__ __forceinline__ void operator()(const f32x4 (&acc)[2][2][4][2], const Unit& u, int wr, int wc, int fr, int fq) const {
        const int row0 = u.pm * BM + wr * 64 + fr, col0 = u.pn * BM + wc * 32 + 8 * fq;
#pragma unroll
        for (int ai = 0; ai < 2; ++ai) {
            f32x4 xv[4][2][2];
#pragma unroll
            for (int m = 0; m < 4; ++m)
#pragma unroll
                for (int bj = 0; bj < 2; ++bj) { const float* xp = X + (size_t)(row0 + ai * HALF + m * 16) * 1024 + col0 + bj * HALF; xv[m][bj][0] = *(const f32x4*)xp; xv[m][bj][1] = *(const f32x4*)(xp + 4); }
#pragma unroll
            for (int m = 0; m < 4; ++m)
#pragma unroll
                for (int bj = 0; bj < 2; ++bj) { const size_t off = (size_t)(row0 + ai * HALF + m * 16) * 1024 + col0 + bj * HALF; const f32x4 y0 = xv[m][bj][0] + acc[ai][bj][m][0], y1 = xv[m][bj][1] + acc[ai][bj][m][1];
                    st8(O + off, y0, y1); u32x2 w; w.x = pk4_f8(y0[0], y0[1], y0[2], y0[3]); w.y = pk4_f8(y1[0], y1[1], y1[2], y1[3]); *(u32x2*)(O8 + off) = w; }
            asm volatile("" ::: "memory");
        }
    }
};

struct EpiMoe1 {
    static constexpr bool PERM = true;
    __device__ __forceinline__ void prefetch(const Unit&, int, int, int, LAS unsigned*) const {}
    const float *SR, *SWLO, *SWHI; bf16_t* HDN;
    __device__ __forceinline__ void mid(f32x4 (&)[2][2][4][2], const Unit&, int, int, int, int) const {}
    __device__ __forceinline__ void operator()(const f32x4 (&acc)[2][2][4][2], const Unit& u, int wr, int wc, int fr, int fq) const {
        const int slot0 = u.pm * BM + wr * 64 + fr; const float* SW = (u.pn < 4) ? SWLO : SWHI;
        const int col0 = (u.pn >> 2) * 512 + (u.pn & 3) * 128 + wc * 32 + 8 * fq;
        float rsv[2][4], wv[2][4];
#pragma unroll
        for (int ai = 0; ai < 2; ++ai)
#pragma unroll
            for (int m = 0; m < 4; ++m) { rsv[ai][m] = SR[slot0 + ai * HALF + m * 16]; wv[ai][m] = SW[slot0 + ai * HALF + m * 16]; }
#pragma unroll
        for (int ai = 0; ai < 2; ++ai) { if (ai == 1 && u.half) break;
#pragma unroll
            for (int m = 0; m < 4; ++m) { const int slot = slot0 + ai * HALF + m * 16; const float rs = rsv[ai][m] * (1.0f / F8_WSCALE), w = wv[ai][m];
                f32x4 h0, h1;
#pragma unroll
                for (int i = 0; i < 4; ++i) { const float g0 = acc[ai][0][m][0][i] * rs, u0 = acc[ai][1][m][0][i] * rs, g1 = acc[ai][0][m][1][i] * rs, u1 = acc[ai][1][m][1][i] * rs;
                    h0[i] = g0 * sigm(g0) * u0 * w; h1[i] = g1 * sigm(g1) * u1 * w; }
                st8(HDN + (size_t)slot * 1024 + col0, h0, h1); } }
    }
};

struct EpiMoe2 {
    static constexpr bool PERM = true;
    const int* STOK; const bf16_t* X1; float* O;
    __device__ __forceinline__ void prefetch(const Unit& u, int wr, int wc, int lane, LAS unsigned* junk) const {
#pragma unroll
        for (int q = 0; q < 4; ++q) { const int idx = q * 64 + lane, ri = idx >> 1, bj = idx & 1; int tok = STOK[u.pm * BM + 128 * (ri >> 6) + 64 * wr + (ri & 63)]; tok = tok < 0 ? 0 : tok;
            touch(X1 + (size_t)tok * 1024 + u.pn * BM + wc * 32 + bj * HALF, junk); }
    }
    __device__ __forceinline__ void mid(f32x4 (&)[2][2][4][2], const Unit&, int, int, int, int) const {}
    __device__ __forceinline__ void operator()(const f32x4 (&acc)[2][2][4][2], const Unit& u, int wr, int wc, int fr, int fq) const {
        int fr_ = fr, fq_ = fq; asm volatile("" : "+v"(fr_), "+v"(fq_));
        const int slot0 = u.pm * BM + wr * 64 + fr_, col0 = u.pn * BM + wc * 32 + 8 * fq_;
        int tk[2][4];
#pragma unroll
        for (int ai = 0; ai < 2; ++ai)
#pragma unroll
            for (int m = 0; m < 4; ++m) tk[ai][m] = STOK[slot0 + ai * HALF + m * 16];
#pragma unroll
        for (int ai = 0; ai < 2; ++ai) { if (ai == 1 && u.half) break;
#pragma unroll
            for (int mp = 0; mp < 2; ++mp) {
                u32x4 xv[2][2];
#pragma unroll
                for (int mi = 0; mi < 2; ++mi) { const int m = mp * 2 + mi; const int tok = tk[ai][m] < 0 ? 0 : tk[ai][m];
#pragma unroll
                    for (int bj = 0; bj < 2; ++bj) xv[mi][bj] = *(const u32x4*)(X1 + (size_t)tok * 1024 + col0 + bj * HALF); }
#pragma unroll
                for (int mi = 0; mi < 2; ++mi) { const int m = mp * 2 + mi; const int tok = tk[ai][m];
                    if (tok >= 0) { const size_t off = (size_t)tok * 1024 + col0;
#pragma unroll
                        for (int bj = 0; bj < 2; ++bj) { const u32x4 x = xv[mi][bj];
                            const f32x4 x0 = {bflo(x.x), bfhi(x.x), bflo(x.y), bfhi(x.y)}, x1 = {bflo(x.z), bfhi(x.z), bflo(x.w), bfhi(x.w)};
                            constexpr float SC = 1.0f;
                            *(f32x4*)(O + off + bj * HALF) = x0 + acc[ai][bj][m][0] * SC; *(f32x4*)(O + off + bj * HALF + 4) = x1 + acc[ai][bj][m][1] * SC; } } }
                asm volatile("" ::: "memory");
            }
        }
    }
};

struct MoeSched {
    const LAS int* tab; const char* A; const char* B; const int* STOK; int mode;
    __device__ __forceinline__ bool next(int i, Unit& u) const {
        if (i >= 16) return false;
        const int tile = __builtin_amdgcn_readfirstlane(tab[i * 8 + 0]); if (tile < 0) return false;
        const int pn = __builtin_amdgcn_readfirstlane(tab[i * 8 + 1]), e0 = __builtin_amdgcn_readfirstlane(tab[i * 8 + 2]), e1 = __builtin_amdgcn_readfirstlane(tab[i * 8 + 3]);
        u.pm = tile; u.pn = pn; u.e0 = e0; u.e1 = e1; u.half = __builtin_amdgcn_readfirstlane(tab[i * 8 + 4]);
        if (mode == 1) { const int e = (pn < 4) ? e0 : e1; u.a = A; u.b0 = B + ((size_t)e * 1024 * 1024 + (size_t)(pn & 3) * 256 * 1024); u.b1 = u.b0; }
        else { u.a = A + (size_t)tile * 256 * 1024 * 2; u.b0 = B + ((size_t)e0 * 1024 + (size_t)pn * 256) * 512 * 2; u.b1 = B + ((size_t)e1 * 1024 + (size_t)pn * 256) * 512 * 2; }
        return true;
    }
    __device__ __forceinline__ void offs(const Unit& u, const int (&Rr)[2], const int (&Cc)[2], unsigned (&off)[2][2]) const {
#pragma unroll
        for (int h = 0; h < 2; ++h)
#pragma unroll
            for (int i = 0; i < 2; ++i) { int tok = STOK[u.pm * 256 + h * 128 + Rr[i]]; tok = tok < 0 ? 0 : tok; off[h][i] = (unsigned)tok * 1024u + (unsigned)Cc[i] * 2u; }
    }
};
}

namespace att {
__device__ __forceinline__ int crow(int r, int hi) { return (r & 3) + 8 * (r >> 2) + 4 * hi; }
__device__ __forceinline__ void glds16(const void* gsrc, unsigned lds_dst) { unsigned keep;
    asm volatile("s_mov_b32 %0, m0\n\ts_mov_b32 m0, %2\n\ts_nop 0\n\tglobal_load_lds_dwordx4 %1, off\n\ts_mov_b32 m0, %0" : "=&s"(keep) : "v"(gsrc), "s"(lds_dst) : "memory"); }
typedef __attribute__((address_space(3))) const char* lds_cptr;
typedef short v4i16_t __attribute__((ext_vector_type(4)));
__device__ __forceinline__ s16x4 vtr(lds_cptr p) { return __builtin_bit_cast(s16x4, __builtin_amdgcn_ds_read_tr16_b64_v4i16((__attribute__((address_space(3))) v4i16_t*)p)); }
#define ATT_WAIT_BAR() asm volatile("s_waitcnt vmcnt(0) lgkmcnt(0)\n\ts_barrier" ::: "memory")
constexpr int SLOT = 32768;
constexpr int WSF_OFF = LDSCTL_OFF + 2048;
constexpr int XCH_OFF = 0;

__device__ __forceinline__ void attn_unit(int b, int h, int qb, const bf16_t* Q, const bf16_t* K, const bf16_t* V, bf16_t* DO, char* shm, float B2, float lam, const float* subg TP_PARAMS) {
    TP_BEGIN(25);
    const int tid = threadIdx.x, lane = tid & 63, r32 = lane & 31, hi = lane >> 5; const int wid = __builtin_amdgcn_readfirstlane(tid >> 6);
    const int mm = wid >> 2, wq = wid & 3;
    const long rowbase = (long)b * SEQ; const int q0 = qb * 128, i0 = q0 + wq * 32;
    const float aslope = LOG2E * __builtin_amdgcn_exp2f(-2.0f * (float)(h + 1));
    const unsigned lds0 = (unsigned)(uintptr_t)shm; const lds_cptr shm3 = (lds_cptr)shm;
    float* wsf = (float*)(shm + WSF_OFF) + wid * 64;
    const bf16_t* Qw = Q + (rowbase + i0 + r32) * 512 + h * 128 + mm * 64 + hi * 8;
    bf16x8 qr[4];
#pragma unroll
    for (int ks = 0; ks < 4; ++ks) qr[ks] = *(const bf16x8*)(Qw + ks * 16);
    const int bh = b * 4 + h;
    const bf16_t* ksrc0 = K + (((size_t)bh * 2 + 0) * 32 * 8 + wid) * 512 + lane * 8;
    const bf16_t* ksrc1 = K + (((size_t)bh * 2 + 1) * 32 * 8 + wid) * 512 + lane * 8;
    const int p0i = 2 * wid, p1i = 2 * wid + 1;
    const bf16_t* vsrc0 = V + ((size_t)bh * 32 * 16 + p0i) * 512 + lane * 8;
    const bf16_t* vsrc1 = vsrc0 + 512;
    const int NTL = 2 * qb + 2;
    int ts; { const int Dk = (int)((2.0f * B2 + 30.2f) / aslope) + 1; ts = q0 - Dk; ts = ts < 0 ? 0 : (ts >> 6); }
#define ATT_DMA(t, slot) do { const unsigned _s = lds0 + (unsigned)(slot) * SLOT; \
        glds16(ksrc0 + (size_t)(t) * 4096, (unsigned)__builtin_amdgcn_readfirstlane(_s + wid * 1024)); glds16(ksrc1 + (size_t)(t) * 4096, (unsigned)__builtin_amdgcn_readfirstlane(_s + 8192 + wid * 1024)); \
        glds16(vsrc0 + (size_t)(t) * 8192, (unsigned)__builtin_amdgcn_readfirstlane(_s + 16384 + p0i * 1024)); glds16(vsrc1 + (size_t)(t) * 8192, (unsigned)__builtin_amdgcn_readfirstlane(_s + 16384 + p1i * 1024)); } while (0)
    ATT_DMA(ts, ts & 3); ATT_DMA(ts + 1, (ts + 1) & 3);
#if defined(ATT_PRIO_YOUNG)
    if (wid >= 4) __builtin_amdgcn_s_setprio(1);
#endif
    f32x16 o[4]; o[0] = f32x16{}; o[1] = f32x16{}; o[2] = f32x16{}; o[3] = f32x16{};
    float l_reg = 0.f;
    const int irow = i0 + r32;
    u32x4 qbias, kbias0, kbias1;
    { const float a_h = bf2f((unsigned short)f2bf(aslope)), r1 = aslope - a_h, a_m = bf2f((unsigned short)f2bf(r1)), a_l = bf2f((unsigned short)f2bf(r1 - a_m));
      const unsigned j0b = f2bf((float)r32), j1b = f2bf((float)(r32 + 32));
      qbias  = hi ? (u32x4){0u, 0u, 0u, 0u} : (u32x4){f2bf(a_h) | (f2bf(a_m) << 16), f2bf(a_l), 0u, 0u};
      kbias0 = hi ? (u32x4){0u, 0u, 0u, 0u} : (u32x4){j0b | (j0b << 16), j0b, 0u, 0u};
      kbias1 = hi ? (u32x4){0u, 0u, 0u, 0u} : (u32x4){j1b | (j1b << 16), j1b, 0u, 0u}; }
    __builtin_amdgcn_s_waitcnt(0x0F70);
    TP_END(25);
    const int vlane = ((lane >> 4) & 1) * 32 + (lane & 3) * 8 + (4 * hi + ((lane & 15) >> 2)) * 64;
    f32x16 cini; { const float c0 = aslope * (float)(64 * ts - irow) - B2; _Pragma("unroll") for (int r = 0; r < 16; ++r) cini[r] = c0; }
    const float cstep = 64.0f * aslope;
#define ATT_VRD(g) vtr(vp + ((g) >> 2) * 4096 + ((g) & 3) * 1024), vtr(vp + ((g) >> 2) * 4096 + ((g) & 3) * 1024 + 512)
#define ATT_PV(SL) do { const lds_cptr vp = shm3 + (SL) * SLOT + 16384 + vlane; \
        s16x4 vf[2][2]; \
        { const s16x4 a0[2] = {ATT_VRD(0)}, a1[2] = {ATT_VRD(1)}; vf[0][0] = a0[0]; vf[0][1] = a0[1]; vf[1][0] = a1[0]; vf[1][1] = a1[1]; } \
        __builtin_amdgcn_sched_barrier(0); \
        _Pragma("unroll") for (int g = 0; g < 16; ++g) {            \
            const s16x4 lo = vf[g & 1][0], hh = vf[g & 1][1]; \
            const bf16x8 vfr = (bf16x8){lo[0], lo[1], lo[2], lo[3], hh[0], hh[1], hh[2], hh[3]}; \
            o[g >> 2] = __builtin_amdgcn_mfma_f32_32x32x16_bf16(__builtin_bit_cast(bf16x8, pw[g & 3]), vfr, o[g >> 2], 0, 0, 0); \
            if (g + 2 < 16) { const s16x4 a3[2] = {ATT_VRD(g + 2)}; vf[g & 1][0] = a3[0]; vf[g & 1][1] = a3[1]; } \
            __builtin_amdgcn_sched_barrier(0); } \
        } while (0)
#define ATT_TILE(MASKED) do { \
        TP_BEGIN(21); \
        if (t + 1 < NTL) asm volatile("s_waitcnt vmcnt(4) lgkmcnt(0)\n\ts_barrier" ::: "memory"); else ATT_WAIT_BAR(); \
        TP_END(21); TP_BEGIN(22); \
        if (t + 2 < NTL) ATT_DMA(t + 2, (t + 2) & 3); \
        TP_END(22); TP_BEGIN(23); \
        const int j0 = 64 * t; \
        if (!(MASKED) || j0 <= i0 + 31) { \
            const char* kb = shm + (t & 3) * SLOT + mm * 8192 + hi * 1024 + r32 * 16; \
            bf16x8 kf[2]; kf[0] = *(const bf16x8*)(kb); kf[1] = *(const bf16x8*)(kb + 512);     \
            __builtin_amdgcn_sched_barrier(0); \
            f32x16 p0 = __builtin_amdgcn_mfma_f32_32x32x16_bf16(__builtin_bit_cast(bf16x8, kbias0), __builtin_bit_cast(bf16x8, qbias), cini, 0, 0, 0); \
            f32x16 p1 = __builtin_amdgcn_mfma_f32_32x32x16_bf16(__builtin_bit_cast(bf16x8, kbias1), __builtin_bit_cast(bf16x8, qbias), cini, 0, 0, 0); \
            __builtin_amdgcn_sched_barrier(0); \
            _Pragma("unroll") for (int f = 0; f < 8; ++f) { \
                if (f & 1) p1 = __builtin_amdgcn_mfma_f32_32x32x16_bf16(kf[1], qr[f >> 1], p1, 0, 0, 0); else p0 = __builtin_amdgcn_mfma_f32_32x32x16_bf16(kf[0], qr[f >> 1], p0, 0, 0, 0); \
                if (f + 2 < 8) kf[f & 1] = *(const bf16x8*)(kb + ((f + 2) >> 1) * 2048 + (f & 1) * 512); \
                __builtin_amdgcn_sched_barrier(0); } \
            if (MASKED) { const int jb = j0 + 4 * hi; \
                _Pragma("unroll") for (int r = 0; r < 16; ++r) { const int j = jb + (r & 3) + 8 * (r >> 2); if (j > irow) p0[r] = -1.0e30f; if (j + 32 > irow) p1[r] = -1.0e30f; } } \
            float sacc = 0.f; \
            _Pragma("unroll") for (int r = 0; r < 16; ++r) { p0[r] = __builtin_amdgcn_exp2f(p0[r]); p1[r] = __builtin_amdgcn_exp2f(p1[r]); sacc += p0[r] + p1[r]; } \
            l_reg += sacc; \
            u32x4 pw[4]; \
            pw[0] = (u32x4){cvt_pk_bf16(p0[0], p0[1]), cvt_pk_bf16(p0[2], p0[3]), cvt_pk_bf16(p0[4], p0[5]), cvt_pk_bf16(p0[6], p0[7])}; \
            pw[1] = (u32x4){cvt_pk_bf16(p0[8], p0[9]), cvt_pk_bf16(p0[10], p0[11]), cvt_pk_bf16(p0[12], p0[13]), cvt_pk_bf16(p0[14], p0[15])}; \
            pw[2] = (u32x4){cvt_pk_bf16(p1[0], p1[1]), cvt_pk_bf16(p1[2], p1[3]), cvt_pk_bf16(p1[4], p1[5]), cvt_pk_bf16(p1[6], p1[7])}; \
            pw[3] = (u32x4){cvt_pk_bf16(p1[8], p1[9]), cvt_pk_bf16(p1[10], p1[11]), cvt_pk_bf16(p1[12], p1[13]), cvt_pk_bf16(p1[14], p1[15])}; \
            TP_END(23); TP_BEGIN(24); \
            ATT_PV(t & 3); \
            TP_END(24); TP_BEGIN(23); \
        } TP_END(23); \
        _Pragma("unroll") for (int r = 0; r < 16; ++r) cini[r] += cstep; } while (0)
    int t = ts;
    for (; t < NTL - 2; ++t) ATT_TILE(false);
    for (; t < NTL; ++t) ATT_TILE(true);
#undef ATT_PV
#undef ATT_VRD
    TP_BEGIN(26);
#undef ATT_TILE
    { auto rr = __builtin_amdgcn_permlane32_swap(__float_as_uint(l_reg), __float_as_uint(l_reg), false, false); l_reg = __uint_as_float(rr[0]) + __uint_as_float(rr[1]); }
    if (hi == 0) wsf[r32] = l_reg;
    asm volatile("s_waitcnt lgkmcnt(0)" ::: "memory");
    const float fac = (mm == 0) ? 1.0f : lam;
#pragma unroll
    for (int r = 0; r < 16; ++r) { const float rl = fac * __builtin_amdgcn_rcpf(wsf[crow(r, hi)]);
#pragma unroll
        for (int d0 = 0; d0 < 4; ++d0) o[d0][r] *= rl; }
    TP_BEGIN(27);
    ATT_WAIT_BAR();
    TP_END(27); TP_BEGIN(28);
    float* xs = (float*)(shm + XCH_OFF) + (size_t)(wq * 2 + mm) * 16 * 128;
    const float* xr = (const float*)(shm + XCH_OFF) + (size_t)(wq * 2 + (mm ^ 1)) * 16 * 128;
    const int rs0 = mm ? 0 : 8, rk0 = mm ? 8 : 0;
#pragma unroll
    for (int rr = 0; rr < 8; ++rr)
#pragma unroll
        for (int d0 = 0; d0 < 4; ++d0) { const int r = rr + 8; const float vs = mm ? o[d0][rr] : o[d0][r];
            xs[(crow(rr, hi)) * 128 + 32 * d0 + r32] = vs; }
    ATT_WAIT_BAR();
    bf16_t* stg = (bf16_t*)(shm + 65536);
    { float gsub[4];
#pragma unroll
      for (int d0 = 0; d0 < 4; ++d0) gsub[d0] = subg[32 * d0 + r32] * 0.8f;
#pragma unroll
      for (int rr = 0; rr < 8; ++rr) {
          float ov[4], ss = 0.f;
#pragma unroll
          for (int d0 = 0; d0 < 4; ++d0) { const float other = xr[crow(rr, hi) * 128 + 32 * d0 + r32]; const float mine = mm ? o[d0][rr + 8] : o[d0][rr];
              ov[d0] = mm ? (other - mine) : (mine - other); ss += ov[d0] * ov[d0]; }
          ss += __shfl_xor(ss, 1); ss += __shfl_xor(ss, 2); ss += __shfl_xor(ss, 4); ss += __shfl_xor(ss, 8); ss += __shfl_xor(ss, 16);
          const float rinv = __builtin_amdgcn_rsqf(ss * (1.0f / 128.0f) + EPS);
          bf16_t* srow = stg + (wq * 32 + rk0 * 2 + crow(rr, hi)) * 128 + r32;
#pragma unroll
          for (int d0 = 0; d0 < 4; ++d0) srow[32 * d0] = (bf16_t)f2bf(ov[d0] * rinv * gsub[d0]);
      } }
    (void)rs0;
    ATT_WAIT_BAR();
    { const int row = tid >> 2, q4 = tid & 3;
      const bf16_t* sp = stg + row * 128 + q4 * 32; bf16_t* gp = DO + (size_t)(rowbase + q0 + row) * 1024 + 512 + h * 128 + q4 * 32;
      u32x4 v[4];
#pragma unroll
      for (int i = 0; i < 4; ++i) v[i] = *(const u32x4*)(sp + i * 8);
#pragma unroll
      for (int i = 0; i < 4; ++i) *(u32x4*)(gp + i * 8) = v[i]; }
    asm volatile("s_waitcnt lgkmcnt(0)" ::: "memory");
    TP_END(28);
    TP_END(26);
#undef ATT_DMA
}
}

struct Args { const float* in[23]; float* out; unsigned char* ws; };

__device__ __forceinline__ float wave_sum(float v) {
#pragma unroll
    for (int o = 1; o < 64; o <<= 1) v += __shfl_xor(v, o);
    return v;
}
__device__ __forceinline__ float wave_max(float v) {
#pragma unroll
    for (int o = 1; o < 64; o <<= 1) v = fmaxf(v, __shfl_xor(v, o));
    return v;
}

template <class DstF>
__device__ __forceinline__ void transpose_item(const float* W, int N, int k0, int n0, LAS float* scr, int lane, const float* ksc, DstF dst) {
    const int kk = lane >> 3, n4 = (lane & 7) * 4;
    f32x4 v[8];
#pragma unroll
    for (int j = 0; j < 8; ++j) v[j] = *(const f32x4*)(W + (size_t)(k0 + kk + 8 * j) * N + n0 + n4);
#pragma unroll
    for (int j = 0; j < 8; ++j) { LAS float* d = scr + (kk + 8 * j) * 33 + n4; d[0] = v[j][0]; d[1] = v[j][1]; d[2] = v[j][2]; d[3] = v[j][3]; }
    LDS_WAIT(); asm volatile("" ::: "memory");
    const int c = lane & 7;
    f32x4 s0 = {1.f, 1.f, 1.f, 1.f}, s1 = s0;
    if (ksc) { s0 = *(const f32x4*)(ksc + k0 + 8 * c); s1 = *(const f32x4*)(ksc + k0 + 8 * c + 4); }
#pragma unroll
    for (int j = 0; j < 4; ++j) { const int n = (lane >> 3) + 8 * j; const LAS float* s = scr + (8 * c) * 33 + n;
        u32x4 o; o.x = pk2(s[0 * 33] * s0[0], s[1 * 33] * s0[1]); o.y = pk2(s[2 * 33] * s0[2], s[3 * 33] * s0[3]); o.z = pk2(s[4 * 33] * s1[0], s[5 * 33] * s1[1]); o.w = pk2(s[6 * 33] * s1[2], s[7 * 33] * s1[3]);
        *(GAS u32x4*)(dst(n0 + n) + k0 + 8 * c) = o; }
    LDS_WAIT(); asm volatile("" ::: "memory");
}

template <class DstF>
__device__ __forceinline__ void transpose_item_f8(const float* W, int N, int k0, int n0, LAS float* scr, int lane, const float* ksc, float mult, DstF dst8) {
    const int kk = lane >> 3, n4 = (lane & 7) * 4;
    f32x4 v[8];
#pragma unroll
    for (int j = 0; j < 8; ++j) v[j] = *(const f32x4*)(W + (size_t)(k0 + kk + 8 * j) * N + n0 + n4);
#pragma unroll
    for (int j = 0; j < 8; ++j) { LAS float* d = scr + (kk + 8 * j) * 33 + n4; d[0] = v[j][0]; d[1] = v[j][1]; d[2] = v[j][2]; d[3] = v[j][3]; }
    LDS_WAIT(); asm volatile("" ::: "memory");
    const int c = lane & 7;
    f32x4 s0 = {mult, mult, mult, mult}, s1 = s0;
    if (ksc) { s0 = s0 * *(const f32x4*)(ksc + k0 + 8 * c); s1 = s1 * *(const f32x4*)(ksc + k0 + 8 * c + 4); }
#pragma unroll
    for (int j = 0; j < 4; ++j) { const int n = (lane >> 3) + 8 * j; const LAS float* s = scr + (8 * c) * 33 + n;
        u32x2 o; o.x = pk4_f8(s[0 * 33] * s0[0], s[1 * 33] * s0[1], s[2 * 33] * s0[2], s[3 * 33] * s0[3]); o.y = pk4_f8(s[4 * 33] * s1[0], s[5 * 33] * s1[1], s[6 * 33] * s1[2], s[7 * 33] * s1[3]);
        *(GAS u32x2*)(dst8(n0 + n) + k0 + 8 * c) = o; }
    LDS_WAIT(); asm volatile("" ::: "memory");
}

#define PH_BEGIN() unsigned char* ws = args.ws; asm volatile("" : "+s"(ws)); int tid = threadIdx.x; asm volatile("" : "+v"(tid)); \
    const int lane = tid & 63, wave = __builtin_amdgcn_readfirstlane(tid >> 6); const int G = gridDim.x, bx = blockIdx.x; \
    const int vcu = (G % 8 == 0) ? (bx % 8) * (G / 8) + bx / 8 : bx; const int gw = vcu * NWAVES + wave, NGW = G * NWAVES; \
    gu32* ctl = (gu32*)(ws + WS_CTL); (void)lane; (void)wave; (void)gw; (void)NGW; (void)ctl; (void)vcu
#define WSP(T, off) ((T*)(ws + (off)))

#ifndef DEPHASE3
#define DEPHASE3 0
#endif
#ifndef DEPHASE4
#define DEPHASE4 0
#endif
#ifndef DEPHASE8
#define DEPHASE8 0
#endif
__device__ __forceinline__ void dephase(int vcu, unsigned ticks) {
    if ((vcu & 1) && ticks) { const unsigned long long t0 = __builtin_amdgcn_s_memrealtime(); while (__builtin_amdgcn_s_memrealtime() - t0 < ticks) __builtin_amdgcn_s_sleep(16); }
}
__global__ void __launch_bounds__(NWAVES * 64, 2) hybrid_fwd(Args args) {
    extern __shared__ __attribute__((aligned(16))) unsigned char lds[];
    LAS unsigned char* L = (LAS unsigned char*)lds;
    volatile LAS unsigned* MISC = (volatile LAS unsigned*)(L + MISC_OFF);
    for (int u = threadIdx.x; u < (LDS_BYTES - LDSCTL_OFF) / 4; u += NWAVES * 64) ((LAS unsigned*)(L + LDSCTL_OFF))[u] = 0u;
    __syncthreads();
    XcdBarrier bar = xcd_barrier_post((unsigned*)((gu32*)(args.ws + WS_CTL) + CW_BAR), MISC + 8);
    TP_DECL();

    TP_BEGIN(10);
    if (PHASE_MASK & 1) REPS(1) {
        PH_BEGIN();
        bf16_t* WinT = WSP(bf16_t, WS_WIN); bf16_t* WmT = WSP(bf16_t, WS_WM); bf16_t* WoT = WSP(bf16_t, WS_WO); unsigned char* Wgu8 = WSP(unsigned char, WS_WGU); bf16_t* WdT = WSP(bf16_t, WS_WD);
        bf16_t* WrH = WSP(bf16_t, WS_WRH); bf16_t* WrL = WSP(bf16_t, WS_WRL); bf16_t* Hb = WSP(bf16_t, WS_H);
        LAS float* scr = (LAS float*)(L + wave * 16384);
        constexpr int I_IN = 16 * 128, I_AU = 8 * 32, I_OUT = 16 * 32, I_G = 32 * 256, I_U = 32 * 256, I_D = 32 * 256;
        constexpr int NITEMS = I_IN + I_AU + I_OUT + I_G + I_U + I_D;
        TP_BEGIN(30);
        for (int it = gw; it < NITEMS; it += NGW) {
            int r = it;
            if (r < I_IN) { const int kb = r / 128, nb = r % 128;
                transpose_item(args.in[2], 4096, kb * 64, nb * 32, scr, lane, nullptr, [&](int n) -> bf16_t* {
                    int v = n; if (n >= 512 && n < 1536) { const int l = n & 255; v = (n & ~255) + 128 * ((l >> 5) & 1) + 32 * (l >> 6) + (l & 31); }
                    else if (n >= 2048) { const int c = (n - 2048) & 1023; v = 2048 + 256 * (c >> 7) + (c & 127) + ((n >= 3072) ? 128 : 0); }
                    return WinT + (size_t)v * 1024; });
                continue; } r -= I_IN;
            if (r < I_AU) { const int kb = r / 32, nb = r % 32;
                transpose_item(args.in[13], 1024, kb * 64, nb * 32, scr, lane, nullptr, [&](int n) -> bf16_t* { return WmT + (size_t)n * 1024 + 512; }); continue; } r -= I_AU;
            if (r < I_OUT) { const int kb = r / 32, nb = r % 32;
                transpose_item(args.in[14], 1024, kb * 64, nb * 32, scr, lane, nullptr, [&](int n) -> bf16_t* { return WoT + (size_t)n * 1024; }); continue; } r -= I_OUT;
            if (r < I_G) { const int e = r / 256, q = r % 256, kb = q / 16, nb = q % 16;
                transpose_item_f8(args.in[20] + (size_t)e * 1024 * 512, 512, kb * 64, nb * 32, scr, lane, args.in[15], F8_WSCALE, [&](int n) -> unsigned char* { return Wgu8 + (size_t)e * 1024 * 1024 + (size_t)(256 * (n >> 7) + (n & 127)) * 1024; }); continue; } r -= I_G;
            if (r < I_U) { const int e = r / 256, q = r % 256, kb = q / 16, nb = q % 16;
                transpose_item_f8(args.in[21] + (size_t)e * 1024 * 512, 512, kb * 64, nb * 32, scr, lane, args.in[15], F8_WSCALE, [&](int n) -> unsigned char* { return Wgu8 + (size_t)e * 1024 * 1024 + (size_t)(256 * (n >> 7) + 128 + (n & 127)) * 1024; }); continue; } r -= I_U;
            { const int e = r / 256, q = r % 256, kb = q / 32, nb = q % 32;
                transpose_item(args.in[22] + (size_t)e * 512 * 1024, 1024, kb * 64, nb * 32, scr, lane, nullptr, [&](int n) -> bf16_t* { return WdT + ((size_t)e * 1024 + n) * 512; }); }
        }
        TP_END(30); TP_BEGIN(31);
        for (int it = gw; it < 2048; it += NGW) {
            const int kq = it >> 4, nb = it & 15, n = 64 * nb + lane, k = 4 * kq, g = k >> 7, kl = k & 127;
            const float* pw = args.in[3] + (size_t)(g * 128 + kl) * 128; const float* sc = args.in[4] + g * 128; const float* wu = args.in[5] + (size_t)(g * 128) * 1024 + n;
            float a0 = 0.f, a1 = 0.f, a2 = 0.f, a3 = 0.f;
            for (int c0 = 0; c0 < 128; c0 += 16) { float wv[16];
#pragma unroll
                for (int c = 0; c < 16; ++c) wv[c] = wu[(size_t)(c0 + c) * 1024];
#pragma unroll
                for (int c = 0; c < 16; ++c) { const float w2 = wv[c] * sc[c0 + c]; a0 += pw[c0 + c] * w2; a1 += pw[128 + c0 + c] * w2; a2 += pw[256 + c0 + c] * w2; a3 += pw[384 + c0 + c] * w2; } }
            u32x2 o; o.x = pk2(a0, a1); o.y = pk2(a2, a3);
            *(u32x2*)(WmT + (size_t)n * 1024 + k) = o;
        }
        TP_END(31); TP_BEGIN(32);
        for (int it = gw * 64 + lane; it < 48 * 1024; it += NGW * 64) {
            const int n = it >> 10, k = it & 1023; float w = 0.f;
            if (n < 4) w = args.in[16][k * 4 + n]; else if (n < 36) w = args.in[18][k * 32 + (n - 4)];
            w *= args.in[15][k];
            const unsigned hb = f2bf(w); const float lo = w - __builtin_bit_cast(float, hb << 16);
            WrH[it] = (bf16_t)hb; WrL[it] = (bf16_t)f2bf(lo);
        }
        TP_END(32); TP_BEGIN(33);
        { const float* x = args.in[0]; const GAS f32x4* g4 = (const GAS f32x4*)args.in[1] + lane; f32x4 gg[4];
#pragma unroll
          for (int j = 0; j < 4; ++j) gg[j] = g4[64 * j];
          for (int m = gw * 2; m < NTOK; m += NGW * 2) {
            const GAS f32x4* xr = (const GAS f32x4*)(x + (size_t)m * DM) + lane;
            f32x4 v[8]; float s0 = 0.f, s1 = 0.f;
#pragma unroll
            for (int j = 0; j < 8; ++j) v[j] = xr[64 * j];
#pragma unroll
            for (int j = 0; j < 4; ++j) { s0 += (v[j].x * v[j].x + v[j].y * v[j].y) + (v[j].z * v[j].z + v[j].w * v[j].w); s1 += (v[4 + j].x * v[4 + j].x + v[4 + j].y * v[4 + j].y) + (v[4 + j].z * v[4 + j].z + v[4 + j].w * v[4 + j].w); }
            const float r0 = __builtin_amdgcn_rsqf(wave_sum(s0) * (1.f / DM) + EPS), r1 = __builtin_amdgcn_rsqf(wave_sum(s1) * (1.f / DM) + EPS);
            GAS unsigned long long* o8 = (GAS unsigned long long*)(Hb + (size_t)m * DM) + lane;
#pragma unroll
            for (int j = 0; j < 8; ++j) { const f32x4 y = v[j] * (j < 4 ? r0 : r1) * gg[j & 3]; o8[64 * j] = (unsigned long long)pk2(y.x, y.y) | ((unsigned long long)pk2(y.z, y.w) << 32); }
          } }
        TP_END(33);
    }
    xcd_barrier(bar);
    TP_END(10);

    TP_BEGIN(11);
    if (PHASE_MASK & 2) REPS(2) {
        PH_BEGIN();
        gm::StaticOrder S; S.init(WSP(bf16_t, WS_H), WSP(bf16_t, WS_WIN), 1024, 1024, NTOK, 4096, G, bx);
        gm::EpiProj E{WSP(bf16_t, WS_U), WSP(bf16_t, WS_Q), WSP(bf16_t, WS_K), WSP(bf16_t, WS_V), WSP(bf16_t, WS_GP), WSP(bf16_t, WS_GA), args.in[6], args.in[7]};
        gm::gemm_phase<1, gm::EpiProj, gm::StaticOrder, gm::NT, false, false>(L, S, E, 1024, 1024 TP_ARGS);
    }
    xcd_barrier(bar);
    TP_END(11);

    TP_BEGIN(12);
    if (PHASE_MASK & 4) REPS(4) {
        PH_BEGIN();
        bf16_t* Ub = WSP(bf16_t, WS_U); bf16_t* DOb = WSP(bf16_t, WS_DO);
        float lam, B2;
        { const float a1 = args.in[8][lane] * args.in[9][lane], a2 = args.in[10][lane] * args.in[11][lane];
          lam = __expf(wave_sum(a1)) - __expf(wave_sum(a2)) + 0.2f;
          const float mq = wave_max(fabsf(args.in[6][lane])), mk = wave_max(fabsf(args.in[7][lane]));
          B2 = 8.0f * mq * mk * LOG2E * 1.02f + 0.5f; }
        TP_BEGIN(20);
        { LAS int* tick = (LAS int*)(L + LDSCTL_OFF + 512);
          const int bq = vcu >> 3; unsigned* qh = (unsigned*)(ctl + CW_ATTQ) + bq * 16;
          if (tid == 0) tick[0] = (int)atomicAdd(qh, 1u);
          __syncthreads();
          int idx = tick[0];
          while (idx < 64) {
              __syncthreads();
              if (tid == 0) tick[0] = (int)atomicAdd(qh, 1u);
              int h, qb; if (idx < 32) { h = 3 - (idx & 1); qb = 15 - (idx >> 1); } else if (idx < 48) { h = 1; qb = 47 - idx; } else { h = 0; qb = 63 - idx; }
              att::attn_unit(bq, h, qb, WSP(bf16_t, WS_Q), WSP(bf16_t, WS_K), WSP(bf16_t, WS_V), DOb, (char*)lds, B2, lam, args.in[12] TP_ARGS);
              __syncthreads();
              idx = tick[0];
          } }
        TP_END(20);
        { const int w = 2 << (lane >> 4);
          const bf16_t* Ul = Ub + lane * 8;
          for (int blk = gw; blk < NTOK / 8; blk += NGW) {
            const int tok0 = blk * 8, t0 = tok0 & (SEQ - 1);
            u32x4 hist[15], curv[8], oldv[8];
#pragma unroll
            for (int s = 1; s <= 15; ++s) { const int ok = (s < w) && (t0 - s >= 0); hist[s - 1] = *(const u32x4*)(Ul + (size_t)(ok ? tok0 - s : tok0) * 512); if (!ok) hist[s - 1] = (u32x4){0u, 0u, 0u, 0u}; }
#pragma unroll
            for (int tt = 0; tt < 8; ++tt) { curv[tt] = *(const u32x4*)(Ul + (size_t)(tok0 + tt) * 512);
                const int ok = (t0 + tt - w + 1 >= 0); oldv[tt] = *(const u32x4*)(Ul + (size_t)(ok ? tok0 + tt - w + 1 : tok0) * 512); if (!ok) oldv[tt] = (u32x4){0u, 0u, 0u, 0u}; }
            float S[8];
#pragma unroll
            for (int c = 0; c < 8; ++c) S[c] = 0.f;
#pragma unroll
            for (int s = 0; s < 15; ++s) { const u32x4 v = hist[s];
                S[0] += bflo(v.x); S[1] += bfhi(v.x); S[2] += bflo(v.y); S[3] += bfhi(v.y); S[4] += bflo(v.z); S[5] += bfhi(v.z); S[6] += bflo(v.w); S[7] += bfhi(v.w); }
#pragma unroll
            for (int tt = 0; tt < 8; ++tt) { const u32x4 v = curv[tt], q = oldv[tt]; const int t = t0 + tt;
                const float c0 = bflo(v.x), c1 = bfhi(v.x), c2 = bflo(v.y), c3 = bfhi(v.y), c4 = bflo(v.z), c5 = bfhi(v.z), c6 = bflo(v.w), c7 = bfhi(v.w);
                S[0] += c0; S[1] += c1; S[2] += c2; S[3] += c3; S[4] += c4; S[5] += c5; S[6] += c6; S[7] += c7;
                const float inv = 1.0f / (float)((t + 1 < w) ? t + 1 : w);
                u32x4 o; o.x = pk2(S[0] * inv - c0, S[1] * inv - c1); o.y = pk2(S[2] * inv - c2, S[3] * inv - c3); o.z = pk2(S[4] * inv - c4, S[5] * inv - c5); o.w = pk2(S[6] * inv - c6, S[7] * inv - c7);
                *(u32x4*)(DOb + (size_t)(tok0 + tt) * 1024 + lane * 8) = o;
                S[0] -= bflo(q.x); S[1] -= bfhi(q.x); S[2] -= bflo(q.y); S[3] -= bfhi(q.y); S[4] -= bflo(q.z); S[5] -= bfhi(q.z); S[6] -= bflo(q.w); S[7] -= bfhi(q.w); }
          } }
    }
    xcd_barrier(bar);
    TP_END(12);

    TP_BEGIN(13);
    if (PHASE_MASK & 8) REPS(8) {
        PH_BEGIN();
        gm::StaticOrder S; S.init(WSP(bf16_t, WS_DO), WSP(bf16_t, WS_WM), 1024, 1024, NTOK, 1024, G, bx);
        gm::EpiMerge E{WSP(bf16_t, WS_GP), WSP(bf16_t, WS_GA), WSP(bf16_t, WS_MERGED)};
        dephase(vcu, DEPHASE3);
        gm::gemm_phase<3, gm::EpiMerge, gm::StaticOrder, gm::NT, false, true>(L, S, E, 1024, 1024 TP_ARGS);
    }
    xcd_barrier(bar);
    TP_END(13);

    TP_BEGIN(14);
    if (PHASE_MASK & 16) REPS(16) {
        PH_BEGIN();
        gm::StaticOrder S; S.init(WSP(bf16_t, WS_MERGED), WSP(bf16_t, WS_WO), 1024, 1024, NTOK, 1024, G, bx);
        gm::EpiRes E{args.in[0], WSP(bf16_t, WS_X1), WSP(unsigned char, WS_X1F8)};
        dephase(vcu, DEPHASE4);
        gm::gemm_phase<4, gm::EpiRes, gm::StaticOrder, gm::NT, false, false>(L, S, E, 1024, 1024 TP_ARGS);
    }
    xcd_barrier(bar);
    TP_END(14);

    TP_BEGIN(15);
    if (PHASE_MASK & 32) {
        PH_BEGIN();
        float* rstd2 = WSP(float, WS_RSTD); int* tcls = WSP(int, WS_TCLS); float* twlo = WSP(float, WS_TWLO); float* twhi = WSP(float, WS_TWHI);
        int* stok = WSP(int, WS_STOK); float* swlo = WSP(float, WS_SWLO); float* swhi = WSP(float, WS_SWHI); float* srstd = WSP(float, WS_SRSTD);
        const bf16_t* X1 = WSP(bf16_t, WS_X1); const bf16_t* WrH = WSP(bf16_t, WS_WRH); const bf16_t* WrL = WSP(bf16_t, WS_WRL);
        for (int i = gw * 64 + lane; i < MAXT * 256; i += NGW * 64) { stok[i] = -1; swlo[i] = 0.f; swhi[i] = 0.f; srstd[i] = 0.f; }
        constexpr int TROW = 1040, LG_OFF = 96 * TROW;
        const int row = lane & 15, kg = lane >> 4;
        const int tok0 = gw * 32;
        f32x4 acc[2][3];
#pragma unroll
        for (int rg = 0; rg < 2; ++rg)
#pragma unroll
            for (int nf = 0; nf < 3; ++nf) acc[rg][nf] = (f32x4){0.f, 0.f, 0.f, 0.f};
        float ss[2] = {0.f, 0.f};
        for (int blk0 = 0; blk0 < NTOK; blk0 += NGW * 32) {
          const int tb = blk0 + tok0; const bool live = tb < NTOK;
          for (int half = 0; half < 2; ++half) {
            __syncthreads();
            for (int i = tid; i < 96 * 64; i += NWAVES * 64) { const int r = i >> 6, c = i & 63;
                const bf16_t* src = (r < 48 ? WrH + (size_t)r * 1024 : WrL + (size_t)(r - 48) * 1024) + half * 512 + c * 8;
                *(LAS u32x4*)(L + r * TROW + c * 16) = *(const u32x4*)src; }
            __syncthreads();
            if (live) {
                const bf16_t* xa = X1 + (size_t)(tb + row) * 1024 + half * 512 + kg * 16;
#pragma unroll 4
                for (int sp = 0; sp < 8; ++sp) {
                    u32x4 A[2][2];
#pragma unroll
                    for (int rg = 0; rg < 2; ++rg) { A[rg][0] = *(const u32x4*)(xa + (size_t)rg * 16 * 1024 + sp * 64); A[rg][1] = *(const u32x4*)(xa + (size_t)rg * 16 * 1024 + sp * 64 + 8); }
#pragma unroll
                    for (int rg = 0; rg < 2; ++rg)
#pragma unroll
                        for (int hh = 0; hh < 2; ++hh) { const u32x4 v = A[rg][hh];
                            const float f0 = bflo(v.x), f1 = bfhi(v.x), f2 = bflo(v.y), f3 = bfhi(v.y), f4 = bflo(v.z), f5 = bfhi(v.z), f6 = bflo(v.w), f7 = bfhi(v.w);
                            ss[rg] += (f0 * f0 + f1 * f1) + (f2 * f2 + f3 * f3) + (f4 * f4 + f5 * f5) + (f6 * f6 + f7 * f7); }
#pragma unroll
                    for (int hh = 0; hh < 2; ++hh)
#pragma unroll
                        for (int nf = 0; nf < 3; ++nf) {
                            const bf16x8 Bh = *(const LAS bf16x8*)(L + (nf * 16 + row) * TROW + (sp * 64 + kg * 16 + hh * 8) * 2);
                            const bf16x8 Bl = *(const LAS bf16x8*)(L + (48 + nf * 16 + row) * TROW + (sp * 64 + kg * 16 + hh * 8) * 2);
#pragma unroll
                            for (int rg = 0; rg < 2; ++rg) { const bf16x8 Af = __builtin_bit_cast(bf16x8, A[rg][hh]);
                                acc[rg][nf] = __builtin_amdgcn_mfma_f32_16x16x32_bf16(Af, Bh, acc[rg][nf], 0, 0, 0);
                                acc[rg][nf] = __builtin_amdgcn_mfma_f32_16x16x32_bf16(Af, Bl, acc[rg][nf], 0, 0, 0); }
                        }
                }
            }
          }
          if (live) {
            LAS float* lg = (LAS float*)(L + LG_OFF + wave * 3072);
#pragma unroll
            for (int rg = 0; rg < 2; ++rg) {
                float s2 = ss[rg]; s2 += __shfl_xor(s2, 16); s2 += __shfl_xor(s2, 32);
                const float rstd = __builtin_amdgcn_rsqf(s2 * (1.0f / 1024.0f) + EPS);
#pragma unroll
                for (int nf = 0; nf < 3; ++nf)
#pragma unroll
                    for (int r = 0; r < 4; ++r) lg[(4 * kg + r) * 48 + 16 * nf + row] = acc[rg][nf][r];
                LDS_WAIT(); asm volatile("" ::: "memory");
                if (lane < 16) {
                    const int tok = tb + rg * 16 + lane;
                    const LAS float* my = lg + lane * 48;
                    float gl[4]; int g = 0;
#pragma unroll
                    for (int j = 0; j < 4; ++j) gl[j] = rstd * my[j] + args.in[17][j];
                    float gmx = gl[0];
#pragma unroll
                    for (int j = 1; j < 4; ++j) if (gl[j] > gmx) { gmx = gl[j]; g = j; }
                    float den = 0.f;
#pragma unroll
                    for (int j = 0; j < 4; ++j) den += __expf(gl[j] - gmx);
                    const float ptop = 1.0f / den;
                    float le[8];
#pragma unroll
                    for (int e = 0; e < 8; ++e) le[e] = rstd * my[4 + g * 8 + e] + args.in[19][g * 8 + e];
                    int e1 = 0; float v1 = le[0];
#pragma unroll
                    for (int e = 1; e < 8; ++e) if (le[e] > v1) { v1 = le[e]; e1 = e; }
                    int e2 = -1; float v2 = -3.0e38f;
#pragma unroll
                    for (int e = 0; e < 8; ++e) if (e != e1 && le[e] > v2) { v2 = le[e]; e2 = e; }
                    const float rr = __expf(v2 - v1), w1 = ptop / (1.0f + rr), w2 = ptop * rr / (1.0f + rr);
                    const int lo = e1 < e2 ? e1 : e2, hi2 = e1 < e2 ? e2 : e1;
                    const float wlo = e1 < e2 ? w1 : w2, whi = e1 < e2 ? w2 : w1;
                    const int cls = g * 28 + lo * 8 - (lo * (lo + 1)) / 2 + (hi2 - lo - 1);
                    tcls[tok] = cls; twlo[tok] = wlo; twhi[tok] = whi; rstd2[tok] = rstd;
                    atomicAdd((unsigned*)(ctl + CW_CNT) + cls * 16, 1u);
                }
                LDS_WAIT(); asm volatile("" ::: "memory");
                ss[rg] = 0.f;
#pragma unroll
                for (int nf = 0; nf < 3; ++nf) acc[rg][nf] = (f32x4){0.f, 0.f, 0.f, 0.f};
            }
          }
        }
    }
    xcd_barrier(bar);
    TP_END(15);

    TP_BEGIN(16);
    if (PHASE_MASK & 64) {
        PH_BEGIN();
        float* rstd2 = WSP(float, WS_RSTD); int* tcls = WSP(int, WS_TCLS); float* twlo = WSP(float, WS_TWLO); float* twhi = WSP(float, WS_TWHI);
        int* stok = WSP(int, WS_STOK); float* swlo = WSP(float, WS_SWLO); float* swhi = WSP(float, WS_SWHI); float* srstd = WSP(float, WS_SRSTD);
        int* tilecls = WSP(int, WS_TILECLS);
        LAS int* fstart = (LAS int*)(L);
        LAS int* hidx = (LAS int*)(L + 512);
        LAS int* nfull = (LAS int*)(L + 1024);
        LAS int* cntl = (LAS int*)(L + 1536);
        LAS int* tot = (LAS int*)(L + 2048);
        if (tid < NCLS) cntl[tid] = (int)__hip_atomic_load((unsigned*)(ctl + CW_CNT) + tid * 16, RLX_AGENT);
        __syncthreads();
        if (tid == 0) { int f = 0, h = 0;
            for (int c = 0; c < NCLS; ++c) { const int n = cntl[c], nt = (n + 255) >> 8, lr = n - 256 * (nt - 1); const int hf = (nt > 0 && lr <= 128) ? 1 : 0; nfull[c] = nt - hf; fstart[c] = f; f += nt - hf; hidx[c] = hf ? h : -1; h += hf; }
            for (int c = 0; c < NCLS; ++c) if (hidx[c] >= 0) hidx[c] += f;
            tot[0] = f; tot[1] = f + h; }
        __syncthreads();
        if (bx == 0) {
            if (tid < NCLS) { const int t0 = fstart[tid], nf = nfull[tid]; for (int t = 0; t < nf; ++t) tilecls[t0 + t] = tid; if (hidx[tid] >= 0) tilecls[hidx[tid]] = tid; }
            if (tid == 0) { __hip_atomic_store((unsigned*)(ctl + CW_NTILES), (unsigned)tot[1], RLX_AGENT); __hip_atomic_store((unsigned*)(ctl + CW_NTILES) + 1, (unsigned)tot[0], RLX_AGENT); }
        }
        for (int tok = bx * 512 + tid; tok < NTOK; tok += G * 512) {
            const int c = tcls[tok];
            const unsigned pos = atomicAdd((unsigned*)(ctl + CW_CUR) + c * 16, 1u);
            const int j = (int)(pos >> 8); const int tile = (j < nfull[c]) ? fstart[c] + j : hidx[c];
            const int slot = tile * 256 + (int)(pos & 255u);
            stok[slot] = tok; swlo[slot] = twlo[tok]; swhi[slot] = twhi[tok]; srstd[slot] = rstd2[tok];
        }
    }
    xcd_barrier(bar);
    TP_END(16);

    TP_BEGIN(17);
    if (PHASE_MASK & 128) REPS(128) {
        PH_BEGIN();
        LAS int* utab = (LAS int*)(L + UTAB_OFF); const int* tilecls = WSP(int, WS_TILECLS);
        const int ntiles = (int)__hip_atomic_load((unsigned*)(ctl + CW_NTILES), RLX_AGENT);
        const int nfullt = (int)__hip_atomic_load((unsigned*)(ctl + CW_NTILES) + 1, RLX_AGENT);
        if (tid < 16) { const int Lx = tid * G + vcu; const int tile = Lx >> 3, pn = Lx & 7; int e0 = 0, e1 = 0, tl = -1;
            if (tile < ntiles) { const int cls = tilecls[tile]; const int g = cls / 28; int rem = cls % 28, lo = 0; while (rem >= 7 - lo) { rem -= 7 - lo; ++lo; } e0 = g * 8 + lo; e1 = g * 8 + lo + 1 + rem; tl = tile; }
            utab[tid * 8 + 0] = tl; utab[tid * 8 + 1] = pn; utab[tid * 8 + 2] = e0; utab[tid * 8 + 3] = e1; utab[tid * 8 + 4] = (tile >= nfullt) ? 1 : 0; }
        __syncthreads();
        gm::MoeSched S{utab, (const char*)WSP(unsigned char, WS_X1F8), (const char*)WSP(unsigned char, WS_WGU), WSP(int, WS_STOK), 1};
        gm::EpiMoe1 E{WSP(float, WS_SRSTD), WSP(float, WS_SWLO), WSP(float, WS_SWHI), WSP(bf16_t, WS_HDN)};
        gm::gemm_phase<7, gm::EpiMoe1, gm::MoeSched, 8, true, false, true, 8>(L, S, E, 512, 512 TP_ARGS);
    }
    xcd_barrier(bar);
    TP_END(17);
    TP_BEGIN(18);
    if (PHASE_MASK & 256) {
        PH_BEGIN();
        LAS int* utab = (LAS int*)(L + UTAB_OFF); const int* tilecls = WSP(int, WS_TILECLS);
        const int ntiles = (int)__hip_atomic_load((unsigned*)(ctl + CW_NTILES), RLX_AGENT);
        const int nfullt = (int)__hip_atomic_load((unsigned*)(ctl + CW_NTILES) + 1, RLX_AGENT);
        if (tid < 16) { const int Lx = tid * G + vcu; const int tile = Lx >> 2, pn = Lx & 3; int e0 = 0, e1 = 0, tl = -1;
            if (tile < ntiles) { const int cls = tilecls[tile]; const int g = cls / 28; int rem = cls % 28, lo = 0; while (rem >= 7 - lo) { rem -= 7 - lo; ++lo; } e0 = g * 8 + lo; e1 = g * 8 + lo + 1 + rem; tl = tile; }
            utab[tid * 8 + 0] = tl; utab[tid * 8 + 1] = pn; utab[tid * 8 + 2] = e0; utab[tid * 8 + 3] = e1; utab[tid * 8 + 4] = (tile >= nfullt) ? 1 : 0; }
        __syncthreads();
        gm::MoeSched S{utab, (const char*)WSP(bf16_t, WS_HDN), (const char*)WSP(bf16_t, WS_WD), WSP(int, WS_STOK), 2};
        gm::EpiMoe2 E{WSP(int, WS_STOK), WSP(bf16_t, WS_X1), args.out};
        dephase(vcu, DEPHASE8);
        gm::gemm_phase<8, gm::EpiMoe2, gm::MoeSched, 8, false, false>(L, S, E, 1024, 512 TP_ARGS);
    }
    TP_END(18);
    TP_FINISH();
}

extern "C" void kernel_launch(void* const* d_in, const int* in_sizes, int n_in, void* d_out, int out_size, void* d_ws, size_t ws_size, hipStream_t stream) {
    static int grid = 0;
    if (grid == 0) {
        if (n_in != 23 || out_size != NTOK * DM || ws_size < WS_END) { fprintf(stderr, "kernel_launch: unexpected shapes (n_in %d, out %d, ws %zu)\n", n_in, out_size, ws_size); grid = -1; return; }
        int dev = 0, cus = 0;
        if (hipGetDevice(&dev) != hipSuccess || hipDeviceGetAttribute(&cus, hipDeviceAttributeMultiprocessorCount, dev) != hipSuccess) { grid = -1; return; }
        if (hipFuncSetAttribute((const void*)hybrid_fwd, hipFuncAttributeMaxDynamicSharedMemorySize, LDS_BYTES) != hipSuccess) { fprintf(stderr, "kernel_launch: hipFuncSetAttribute failed\n"); grid = -1; return; }
        int per_cu = 0;
        if (hipOccupancyMaxActiveBlocksPerMultiprocessor(&per_cu, (const void*)hybrid_fwd, NWAVES * 64, LDS_BYTES) != hipSuccess || per_cu < 1) fprintf(stderr, "kernel_launch: occupancy query says %d\n", per_cu);
        (void)hipGetLastError();
        grid = cus;
        if (grid != 256) fprintf(stderr, "kernel_launch: %d CUs (built for 256)\n", grid);
    }
    if (grid < 0) return;
    if (hipMemsetAsync((char*)d_ws + WS_CTL, 0, CTL_ZERO_BYTES, stream) != hipSuccess) return;
    Args a{};
    for (int i = 0; i < 23; ++i) a.in[i] = (const float*)d_in[i];
    a.out = (float*)d_out; a.ws = (unsigned char*)d_ws;
    hipLaunchKernelGGL(hybrid_fwd, dim3(grid), dim3(NWAVES * 64), LDS_BYTES, stream, a);
}
```

```cpp
#include <hip/hip_runtime.h>
#include <hip/hip_bf16.h>
#include <cstdio>
#include <cstdint>

#define LAS __attribute__((address_space(3)))
#define GAS __attribute__((address_space(1)))
typedef unsigned short bf16_t;
typedef short bf16x8 __attribute__((ext_vector_type(8)));
typedef short s16x4 __attribute__((ext_vector_type(4)));
typedef float f32x2 __attribute__((ext_vector_type(2)));
typedef float f32x4 __attribute__((ext_vector_type(4)));
typedef float f32x16 __attribute__((ext_vector_type(16)));
typedef unsigned u32x4 __attribute__((ext_vector_type(4)));
typedef unsigned u32x2 __attribute__((ext_vector_type(2)));
typedef GAS unsigned gu32;
typedef int i32x4 __attribute__((ext_vector_type(4)));
typedef int i32x8 __attribute__((ext_vector_type(8)));
#define RLX_AGENT __ATOMIC_RELAXED, __HIP_MEMORY_SCOPE_AGENT
#define LDS_WAIT() asm volatile("s_waitcnt lgkmcnt(0)" ::: "memory")
#define VM_WAIT() asm volatile("s_waitcnt vmcnt(0)" ::: "memory")

#ifndef PHASE_MASK
#define PHASE_MASK 0x1ff
#endif
#ifndef DUP_MASK
#define DUP_MASK 0
#endif
#ifdef TPROBE
#ifndef TP_AMP
#define TP_AMP 4
#endif
#ifndef TP_WAVE
#define TP_WAVE 0
#endif
__device__ __forceinline__ unsigned long long tp_now() { unsigned long long t; __builtin_amdgcn_sched_barrier(0); asm volatile("s_memrealtime %0\n\ts_waitcnt lgkmcnt(0)" : "=s"(t) :: "memory"); __builtin_amdgcn_sched_barrier(0); return t; }
#define TP_DECL() unsigned long long tp_t0 = 0, tp_acc = 0; (void)tp_t0
#define TP_PARAMS , unsigned long long& tp_t0, unsigned long long& tp_acc
#define TP_ARGS , tp_t0, tp_acc
#define TP_BEGIN(k) do { if ((k) == TPROBE) tp_t0 = tp_now(); } while (0)
#define TP_END(k) do { if ((k) == TPROBE) tp_acc += tp_now() - tp_t0; } while (0)
#define TP_FINISH() do { if (blockIdx.x == 0 && threadIdx.x == TP_WAVE * 64) { const unsigned long long s0 = tp_now(); while (tp_now() - s0 < tp_acc * TP_AMP) __builtin_amdgcn_s_sleep(8); } } while (0)
#else
#define TP_DECL()
#define TP_PARAMS
#define TP_ARGS
#define TP_BEGIN(k)
#define TP_END(k)
#define TP_FINISH()
#endif
#define REPS(bit) for (int rep_ = 0; rep_ < ((DUP_MASK & (bit)) ? 2 : 1); ++rep_)

constexpr int NTOK = 65536, DM = 1024, SEQ = 2048;
constexpr float LOG2E = 1.4426950408889634f;
constexpr float EPS = 1e-6f;
constexpr int NCLS = 112, MAXT = 368;
constexpr int NWAVES = 8;

constexpr size_t MiB = 1u << 20;
constexpr size_t WS_CTL = 0, CTL_ZERO_BYTES = 1 * MiB;
constexpr size_t WS_RSTD = 1 * MiB, WS_TCLS = WS_RSTD + 256 * 1024, WS_TWLO = WS_TCLS + 256 * 1024, WS_TWHI = WS_TWLO + 256 * 1024;
constexpr size_t WS_STOK = 2 * MiB, WS_SWLO = WS_STOK + 512 * 1024, WS_SWHI = WS_SWLO + 512 * 1024, WS_SRSTD = WS_SWHI + 512 * 1024;
constexpr size_t WS_TILECLS = 4 * MiB;
constexpr size_t WS_WRH = 5 * MiB, WS_WRL = WS_WRH + 128 * 1024;
constexpr size_t WS_WIN = 16 * MiB, WS_WM = 24 * MiB, WS_WO = 26 * MiB;
constexpr size_t WS_WGU = 32 * MiB, WS_WD = 96 * MiB;
constexpr size_t WS_H = 128 * MiB;
constexpr size_t WS_U = 256 * MiB, WS_Q = 320 * MiB, WS_K = 384 * MiB, WS_V = 448 * MiB;
constexpr size_t WS_GP = 512 * MiB, WS_GA = 640 * MiB;
constexpr size_t WS_DO = 768 * MiB;
constexpr size_t WS_END = 896 * MiB;
constexpr size_t WS_MERGED = WS_H, WS_X1 = WS_U, WS_HDN = WS_GP, WS_X1F8 = WS_K;
constexpr int CW_TMO = 0, CW_NTILES = 16, CW_BAR = 4096, CW_CNT = 8192, CW_CUR = 10240, CW_ATTQ = 12288;

constexpr int RING_BYTES = 131072;
constexpr int LDSCTL_OFF = RING_BYTES, MISC_OFF = LDSCTL_OFF + 320, UTAB_OFF = LDSCTL_OFF + 1024;
constexpr int JUNK_OFF = LDSCTL_OFF + 8192;
constexpr int LDS_BYTES = 147456;

__device__ __forceinline__ unsigned f2bf(float f) { unsigned u = __builtin_bit_cast(unsigned, f); return (u + 0x7fffu + ((u >> 16) & 1u)) >> 16; }
__device__ __forceinline__ unsigned pk2(float lo, float hi) { return f2bf(lo) | (f2bf(hi) << 16); }
__device__ __forceinline__ float bf2f(unsigned short b) { return __builtin_bit_cast(float, (unsigned)b << 16); }
__device__ __forceinline__ float bflo(unsigned w) { return __builtin_bit_cast(float, w << 16); }
__device__ __forceinline__ float bfhi(unsigned w) { return __builtin_bit_cast(float, w & 0xffff0000u); }
__device__ __forceinline__ unsigned cvt_pk_bf16(float lo, float hi) { unsigned r; asm("v_cvt_pk_bf16_f32 %0, %1, %2" : "=v"(r) : "v"(lo), "v"(hi)); return r; }

__device__ __forceinline__ unsigned pk4_f8(float a, float b, float c, float d) { int w = 0; w = __builtin_amdgcn_cvt_pk_fp8_f32(a, b, w, false); w = __builtin_amdgcn_cvt_pk_fp8_f32(c, d, w, true); return (unsigned)w; }
constexpr float F8_WSCALE = 32.0f, F8_HSCALE = 16.0f;

#define XB_TMO      128
#define XB_XCNT(j)  (256  + 64 * (j))
#define XB_XSUB(j)  (1280 + 64 * (j))
#define XB_XGEN(j)  (2304 + 64 * (j))
#define XB_TOP      3328
#define XB_TOPGEN   3392
#define XCD_BAR_WORDS 3456
#define XB_SPIN_CAP (1u << 18)
__device__ __forceinline__ unsigned xb_ld(unsigned* p)              { return __hip_atomic_load(p, __ATOMIC_RELAXED, __HIP_MEMORY_SCOPE_AGENT); }
__device__ __forceinline__ unsigned xb_add(unsigned* p, unsigned v) { return __hip_atomic_fetch_add(p, v, __ATOMIC_RELAXED, __HIP_MEMORY_SCOPE_AGENT); }
__device__ __forceinline__ unsigned xb_xcc_id() { return (unsigned)__builtin_amdgcn_s_getreg((3 << 11) | 20) & 0xFu; }
#define XB_SPIN(cond, bar) do { unsigned _sp = 0; while (cond) { __builtin_amdgcn_s_sleep(1); \
    if ((++_sp & 255u) == 0u) { if (xb_ld(&(bar)[XB_TMO])) break; if (_sp > XB_SPIN_CAP) { atomicAdd(&(bar)[XB_TMO], 1u); break; } } } } while (0)
struct XcdBarrier { unsigned* bar; unsigned x; volatile LAS unsigned* st; };
__device__ __forceinline__ XcdBarrier xcd_barrier_post(unsigned* bar, volatile LAS unsigned* st) {
    XcdBarrier b; b.bar = bar; b.x = xb_xcc_id(); b.st = st;
    if (threadIdx.x == 0) (void)xb_add(&bar[XB_XCNT(b.x)], 1u);
    return b;
}
__device__ __forceinline__ void xcd_barrier_complete(unsigned* bar, unsigned x, unsigned& nloc, unsigned& nx) {
    const unsigned G = gridDim.x * gridDim.y * gridDim.z;
    unsigned sum, cnt, mine, sp = 0u;
    for (;;) {
        sum = 0u; cnt = 0u; mine = 0u;
#pragma unroll
        for (unsigned j = 0; j < 16; ++j) { const unsigned c = xb_ld(&bar[XB_XCNT(j)]); sum += c; cnt += (c > 0u) ? 1u : 0u; mine = (j == x) ? c : mine; }
        if (sum == G) break;
        __builtin_amdgcn_s_sleep(1);
        if ((++sp & 255u) == 0u) { if (xb_ld(&bar[XB_TMO])) break; if (sp > XB_SPIN_CAP) { atomicAdd(&bar[XB_TMO], 1u); break; } }
    }
    nloc = mine > 0u ? mine : 1u; nx = cnt > 0u ? cnt : 1u;
}
__device__ __forceinline__ void xcd_barrier(const XcdBarrier& b) {
    asm volatile("s_waitcnt vmcnt(0)" ::: "memory");
    __syncthreads();
    if (threadIdx.x == 0) {
        unsigned* bar = b.bar;
        __builtin_amdgcn_s_waitcnt(0);
        unsigned nloc = b.st[0], nx = b.st[1];
        if (nloc == 0u) { xcd_barrier_complete(bar, b.x, nloc, nx); b.st[0] = nloc; b.st[1] = nx; }
        const unsigned old = xb_add(&bar[XB_XSUB(b.x)], 1u);
        const unsigned gen = old / nloc;
        if (old + 1u == (gen + 1u) * nloc) {
            __builtin_amdgcn_fence(__ATOMIC_RELEASE, "agent");
            asm volatile("s_waitcnt vmcnt(0)" ::: "memory");
            const unsigned og = xb_add(&bar[XB_TOP], 1u);
            const unsigned tg = og / nx;
            if (og + 1u == (tg + 1u) * nx) xb_add(&bar[XB_TOPGEN], 1u);
            else XB_SPIN(xb_ld(&bar[XB_TOPGEN]) == tg, bar);
            __builtin_amdgcn_fence(__ATOMIC_ACQUIRE, "agent");
            xb_add(&bar[XB_XGEN(b.x)], 1u);
            asm volatile("s_waitcnt vmcnt(0)" ::: "memory");
        } else {
            XB_SPIN(xb_ld(&bar[XB_XGEN(b.x)]) == gen, bar);
            __builtin_amdgcn_fence(__ATOMIC_ACQUIRE, "agent");
            asm volatile("s_waitcnt vmcnt(0)" ::: "memory");
        }
    }
    __syncthreads();
}

namespace gm {
constexpr int BM = 256, BK = 64, HALF = 128, HTB = HALF * BK * 2, NXCD = 8, WGM = 8, NT = 16;
__host__ __device__ __forceinline__ int lds_byte(int r, int c) { const int st = (r >> 4) * 2 + (c >> 5), rr = r & 15, cc = c & 31, ob = rr * 64 + cc * 2; return st * 1024 + (ob ^ (((ob >> 9) & 1) << 5)); }
__host__ __device__ __forceinline__ void stage_rc(int b, int& R, int& C) { const int st = b / 1024, sb = b % 1024, swz = sb ^ (((sb >> 9) & 1) << 5); R = (st >> 1) * 16 + swz / 64; C = (st & 1) * 32 + (swz % 64) / 2; }
__host__ __device__ __forceinline__ int perm32(int rho) { const int n = rho >> 4, i = rho & 15; return 8 * (i >> 2) + 4 * n + (i & 3); }

struct Unit { const char* a; const char* b0; const char* b1; int pm, pn, e0, e1, half; };

struct StaticOrder {
    const char* A; const char* Bt; int lda, ldb; int nM, nN, nwg, G, c;
    __device__ void init(const void* A_, const void* Bt_, int lda_, int ldb_, int M, int N, int G_, int c_) { A = (const char*)A_; Bt = (const char*)Bt_; lda = lda_; ldb = ldb_; nM = M / BM; nN = N / BM; nwg = nM * nN; G = G_; c = c_; }
    __device__ __forceinline__ bool next(int i, Unit& u) const {
        const long L = (long)i * G + c; if (L >= nwg) return false;
        int wgid = (int)L; { const int q = nwg / NXCD, r = nwg % NXCD, xcd = wgid % NXCD, off = wgid / NXCD; wgid = (xcd < r ? xcd * (q + 1) : r * (q + 1) + (xcd - r) * q) + off; }
        const int nig = WGM * nN, gid = wgid / nig, fm = gid * WGM, gsz = (nM - fm) < WGM ? (nM - fm) : WGM;
        u.pm = fm + ((wgid % nig) % gsz); u.pn = (wgid % nig) / gsz; u.e0 = 0; u.e1 = 0; u.half = 0;
        u.a = A + (size_t)u.pm * BM * lda * 2; u.b0 = Bt + (size_t)u.pn * BM * ldb * 2; u.b1 = u.b0;
        return true;
    }
    __device__ __forceinline__ void offs(const Unit&, const int (&)[2], const int (&)[2], unsigned (&)[2][2]) const {}
};

template <int PH, class Epi, class Sched, int KS, bool GATHER, bool MID, bool F8 = false, int NTT = 16>
__device__ __forceinline__ void gemm_phase(LAS unsigned char* lds, const Sched& S, const Epi& E, const int lda, const int ldb TP_PARAMS) {
    int tid = threadIdx.x; asm volatile("" : "+v"(tid));
    const int wid = __builtin_amdgcn_readfirstlane(tid >> 6), lane = tid & 63, wr = wid >> 2, wc = wid & 3, fr = lane & 15, fq = lane >> 4;
    int Rr[2], Cc[2]; unsigned offA[2][2], offAn[2][2], voffB[2];
#pragma unroll
    for (int i = 0; i < 2; ++i) { int R, C; stage_rc(tid * 16 + i * 8192, R, C); Rr[i] = R; Cc[i] = C; const int Rb = Epi::PERM ? ((R & ~31) + perm32(R & 31)) : R;
        voffB[i] = (unsigned)(Rb * ldb + C) * 2u;
        offA[0][i] = (unsigned)(R * lda + C) * 2u; offA[1][i] = (unsigned)((R + HALF) * lda + C) * 2u; offAn[0][i] = offA[0][i]; offAn[1][i] = offA[1][i]; }
    const size_t kstep = (size_t)(BK * 2);
    const size_t hstepB = (size_t)HALF * ldb * 2;
    const unsigned ldsw = (unsigned)wid * 1024u;
    const int aoff = lds_byte(wr * 64 + fr, fq * 8), boff = lds_byte(wc * 32 + fr, fq * 8);
#define G_SA(b, h) (((b) * 2 + (h)) * HTB)
#define G_SB(b, h) ((4 + (b) * 2 + (h)) * HTB)
#define G_STAGE_A(bufoff, gbase, OFF, h) do { _Pragma("unroll") for (int _i = 0; _i < 2; ++_i) \
        __builtin_amdgcn_global_load_lds((const unsigned*)((const char*)(gbase) + (OFF)[h][_i]), (LAS unsigned*)(lds + (bufoff) + ldsw + _i * 8192), 16, 0, 0); } while (0)
#define G_STAGE_B(bufoff, gbase) do { _Pragma("unroll") for (int _i = 0; _i < 2; ++_i) \
        __builtin_amdgcn_global_load_lds((const unsigned*)((const char*)(gbase) + voffB[_i]), (LAS unsigned*)(lds + (bufoff) + ldsw + _i * 8192), 16, 0, 0); } while (0)
#define G_LD16(off) (*(const LAS bf16x8*)(lds + (off)))
#define G_CAT2(x, y) __builtin_shufflevector(__builtin_bit_cast(i32x4, x), __builtin_bit_cast(i32x4, y), 0, 1, 2, 3, 4, 5, 6, 7)
#define G_LDA(dst, b, h) do { _Pragma("unroll") for (int m = 0; m < 4; ++m) { if constexpr (F8) { dst##8[m] = G_CAT2(G_LD16(G_SA(b, h) + aoff + m * 2048), G_LD16(G_SA(b, h) + aoff + m * 2048 + 1024)); } \
        else { _Pragma("unroll") for (int k = 0; k < 2; ++k) dst[m][k] = G_LD16(G_SA(b, h) + aoff + m * 2048 + k * 1024); } } } while (0)
#define G_LDB(dst, b, h) do { _Pragma("unroll") for (int n = 0; n < 2; ++n) { if constexpr (F8) { dst##8[n] = G_CAT2(G_LD16(G_SB(b, h) + boff + n * 2048), G_LD16(G_SB(b, h) + boff + n * 2048 + 1024)); } \
        else { _Pragma("unroll") for (int k = 0; k < 2; ++k) dst[n][k] = G_LD16(G_SB(b, h) + boff + n * 2048 + k * 1024); } } } while (0)
#define G_MMA(ai, bj, At, Bt) do { __builtin_amdgcn_s_setprio(1); \
        if constexpr (F8) { _Pragma("unroll") for (int m = 0; m < 4; ++m) _Pragma("unroll") for (int n = 0; n < 2; ++n) \
            acc[ai][bj][m][n] = __builtin_amdgcn_mfma_scale_f32_16x16x128_f8f6f4(Bt##8[n], At##8[m], acc[ai][bj][m][n], 0, 0, 0, 0x7F7F7F7F, 0, 0x7F7F7F7F); } \
        else { _Pragma("unroll") for (int m = 0; m < 4; ++m) _Pragma("unroll") for (int n = 0; n < 2; ++n) _Pragma("unroll") for (int k = 0; k < 2; ++k) \
            acc[ai][bj][m][n] = __builtin_amdgcn_mfma_f32_16x16x32_bf16(Bt[n][k], At[m][k], acc[ai][bj][m][n], 0, 0, 0); } \
        __builtin_amdgcn_s_setprio(0); } while (0)
#define G_WAIT_V(n) asm volatile("s_waitcnt vmcnt(" #n ")" ::: "memory")
#define G_WAIT_L(n) asm volatile("s_waitcnt lgkmcnt(" #n ")" ::: "memory")
#define G_BAR __builtin_amdgcn_s_barrier()
#define G_SCHED __builtin_amdgcn_sched_barrier(0)
#define G_BP(u, t) ((t) < KS ? (u).b0 + (size_t)(t) * kstep : (u).b1 + (size_t)((t) - KS) * kstep)
    Unit cur, nxt; int ui = 0;
    if (!S.next(0, cur)) return;
    if constexpr (GATHER) S.offs(cur, Rr, Cc, offA);
    f32x4 acc[2][2][4][2];
#pragma unroll
    for (int a = 0; a < 2; ++a)
#pragma unroll
        for (int b = 0; b < 2; ++b)
#pragma unroll
            for (int m = 0; m < 4; ++m)
#pragma unroll
                for (int n = 0; n < 2; ++n) acc[a][b][m][n] = (f32x4){0.f, 0.f, 0.f, 0.f};
    bf16x8 At[4][2], B0[2][2], B1[2][2]; i32x8 At8[4], B08[2], B18[2];
    {
        const char* cA = cur.a; const char* cB = cur.b0; const char* cB1 = G_BP(cur, 1);
        G_STAGE_B(G_SB(0, 0), cB); G_STAGE_B(G_SB(0, 1), cB + hstepB); G_STAGE_A(G_SA(0, 0), cA, offA, 0); G_STAGE_A(G_SA(0, 1), cA, offA, 1);
        if (wr == 1) G_BAR;
        G_WAIT_V(2); G_BAR;
        G_STAGE_B(G_SB(1, 0), cB1); G_STAGE_A(G_SA(1, 0), cA + kstep, offA, 0); G_STAGE_B(G_SB(1, 1), cB1 + hstepB);
        G_WAIT_V(6); G_BAR;
    }
    for (;;) {
        const bool has_next = S.next(ui + 1, nxt);
#if defined(EPI_PREFETCH)
        E.prefetch(cur, wr, wc, lane, (LAS unsigned*)(lds + JUNK_OFF + wid * 256));
#endif
        TP_BEGIN(100 + PH * 10);
#pragma nounroll
        for (int t = 0; t < NTT; t += 2) {
            const bool last = (t == NTT - 2);
            if constexpr (MID) { if (t == NTT / 2) { TP_BEGIN(102 + PH * 10); E.mid(acc, cur, wr, wc, fr, fq); TP_END(102 + PH * 10); } }
            if constexpr (GATHER) { if (t == NTT - 4 && has_next) S.offs(nxt, Rr, Cc, offAn); }
            const char* a1 = cur.a + (size_t)(t + 1) * kstep;
            const bool sw = last && has_next;
            const int t2 = last ? 0 : t + 2;
            const char* ua = sw ? nxt.a : cur.a; const char* ub0 = sw ? nxt.b0 : cur.b0; const char* ub1 = sw ? nxt.b1 : cur.b1;
            const char* a2 = ua + (size_t)t2 * kstep; const char* a3 = a2 + kstep;
            const char* b2 = (t2 < KS) ? ub0 + (size_t)t2 * kstep : ub1 + (size_t)(t2 - KS) * kstep;
            const char* b3 = (t2 + 1 < KS) ? ub0 + (size_t)(t2 + 1) * kstep : ub1 + (size_t)(t2 + 1 - KS) * kstep;
            G_LDB(B0, 0, 0); G_LDB(B1, 0, 1); G_SCHED; G_LDA(At, 0, 0); G_STAGE_A(G_SA(1, 1), a1, offA, 1);
            G_WAIT_V(8); G_WAIT_L(0); G_BAR; G_MMA(0, 0, At, B0); G_MMA(0, 1, At, B1); G_BAR; G_SCHED;
            if constexpr (GATHER) { if (sw) {
#pragma unroll
                for (int h = 0; h < 2; ++h)
#pragma unroll
                    for (int i = 0; i < 2; ++i) offA[h][i] = offAn[h][i]; } }
            G_LDA(At, 0, 1); G_STAGE_B(G_SB(0, 0), b2); G_STAGE_B(G_SB(0, 1), b2 + hstepB); G_STAGE_A(G_SA(0, 0), a2, offA, 0);
            G_WAIT_V(8); G_WAIT_L(0); G_BAR; if (F8 || !cur.half) { G_MMA(1, 0, At, B0); G_MMA(1, 1, At, B1); } G_BAR; G_SCHED;
            G_LDB(B0, 1, 0); G_LDB(B1, 1, 1); G_SCHED; G_LDA(At, 1, 0); G_STAGE_A(G_SA(0, 1), a2, offA, 1);
            G_WAIT_V(8); G_WAIT_L(0); G_BAR; G_MMA(0, 0, At, B0); G_MMA(0, 1, At, B1); G_BAR; G_SCHED;
            G_LDA(At, 1, 1); G_STAGE_B(G_SB(1, 0), b3); G_STAGE_B(G_SB(1, 1), b3 + hstepB); G_STAGE_A(G_SA(1, 0), a3, offA, 0);
            G_WAIT_V(8); G_WAIT_L(0); G_BAR; if (F8 || !cur.half) { G_MMA(1, 0, At, B0); G_MMA(1, 1, At, B1); } G_BAR; G_SCHED;
        }
        TP_END(100 + PH * 10); TP_BEGIN(101 + PH * 10);
        if (wr == 0) G_BAR;
        E(acc, cur, wr, wc, fr, fq);
        TP_END(101 + PH * 10);
        if (!has_next) break;
#pragma unroll
        for (int a = 0; a < 2; ++a)
#pragma unroll
            for (int b = 0; b < 2; ++b)
#pragma unroll
                for (int m = 0; m < 4; ++m)
#pragma unroll
                    for (int n = 0; n < 2; ++n) acc[a][b][m][n] = (f32x4){0.f, 0.f, 0.f, 0.f};
        cur = nxt; ++ui;
        if (wr == 1) G_BAR;
    }
    G_WAIT_V(0);
    G_BAR;
#undef G_SA
#undef G_SB
#undef G_STAGE_A
#undef G_STAGE_B
#undef G_LDA
#undef G_LDB
#undef G_MMA
#undef G_CAT2
#undef G_LD16
#undef G_WAIT_V
#undef G_WAIT_L
#undef G_BAR
#undef G_SCHED
#undef G_BP
}

__device__ __forceinline__ void st8(bf16_t* p, f32x4 v0, f32x4 v1) { u32x4 w; w.x = cvt_pk_bf16(v0[0], v0[1]); w.y = cvt_pk_bf16(v0[2], v0[3]); w.z = cvt_pk_bf16(v1[0], v1[1]); w.w = cvt_pk_bf16(v1[2], v1[3]); *(u32x4*)p = w; }
__device__ __forceinline__ float sigm(float z) { return __builtin_amdgcn_rcpf(1.0f + __builtin_amdgcn_exp2f(-z * LOG2E)); }

__device__ __forceinline__ void touch(const void* p, LAS unsigned* junk) { __builtin_amdgcn_global_load_lds((const unsigned*)p, junk, 4, 0, 0); }

struct EpiProj {
    static constexpr bool PERM = true;
    __device__ __forceinline__ void prefetch(const Unit&, int, int, int, LAS unsigned*) const {}
    bf16_t *U, *Q, *K, *V, *GP, *GA; const float *gq, *gk;
    __device__ __forceinline__ void mid(f32x4 (&)[2][2][4][2], const Unit&, int, int, int, int) const {}
    __device__ __forceinline__ void operator()(const f32x4 (&acc)[2][2][4][2], const Unit& u, int wr, int wc, int fr, int fq) const {
        const int pn = u.pn; const int row0 = u.pm * BM + wr * 64 + fr;
        if (pn < 2) {
            const int col0 = (pn & 1) * 256 + wc * 32 + 8 * fq;
#pragma unroll
            for (int ai = 0; ai < 2; ++ai)
#pragma unroll
                for (int m = 0; m < 4; ++m) { bf16_t* rowp = U + (size_t)(row0 + ai * HALF + m * 16) * 512 + col0;
#pragma unroll
                    for (int bj = 0; bj < 2; ++bj) st8(rowp + bj * HALF, acc[ai][bj][m][0], acc[ai][bj][m][1]); }
        } else if (pn == 6 || pn == 7) {
#pragma unroll
            for (int ai = 0; ai < 2; ++ai)
#pragma unroll
                for (int m = 0; m < 4; ++m) { const int row = row0 + ai * HALF + m * 16, b = row >> 11, t = row & 2047;
#pragma unroll
                    for (int bj = 0; bj < 2; ++bj) { const int bh = b * 4 + 2 * (pn - 6) + bj;
                        st8(V + ((((size_t)bh * 32 + (t >> 6)) * 16 + (wc * 4 + ((t >> 4) & 3))) * 16 + (t & 15)) * 32 + 8 * fq, acc[ai][bj][m][0], acc[ai][bj][m][1]); } }
        } else if (pn < 6) {
            const bool isq = pn < 4; bf16_t* base = isq ? Q : K; const float* g = isq ? gq : gk; const float sc = isq ? (0.125f * LOG2E) : 1.0f;
            f32x4 gv[2][2];
#pragma unroll
            for (int bj = 0; bj < 2; ++bj) { gv[bj][0] = *(const f32x4*)(g + 32 * bj + 8 * fq); gv[bj][1] = *(const f32x4*)(g + 32 * bj + 8 * fq + 4); }
            const int col0 = (pn & 1) * 256 + 64 * wc + 8 * fq;
#pragma unroll
            for (int ai = 0; ai < 2; ++ai)
#pragma unroll
                for (int m = 0; m < 4; ++m) {
                    float ss = 0.f;
#pragma unroll
                    for (int bj = 0; bj < 2; ++bj)
#pragma unroll
                        for (int n = 0; n < 2; ++n) { const f32x4 x = acc[ai][bj][m][n]; ss += (x[0] * x[0] + x[1] * x[1]) + (x[2] * x[2] + x[3] * x[3]); }
                    ss += __shfl_xor(ss, 16); ss += __shfl_xor(ss, 32);
                    const float rinv = __builtin_amdgcn_rsqf(ss * (1.0f / 64.0f) + EPS) * sc;
                    const int row = row0 + ai * HALF + m * 16;
                    if (isq) { bf16_t* rowp = base + (size_t)row * 512 + col0;
#pragma unroll
                        for (int bj = 0; bj < 2; ++bj) st8(rowp + 32 * bj, acc[ai][bj][m][0] * rinv * gv[bj][0], acc[ai][bj][m][1] * rinv * gv[bj][1]);
                    } else {
                        const int b = row >> 11, t = row & 2047, sh = (pn - 4) * 4 + wc, bh = b * 4 + (sh >> 1), mm = sh & 1;
#pragma unroll
                        for (int bj = 0; bj < 2; ++bj) st8(base + (((((size_t)bh * 2 + mm) * 32 + (t >> 6)) * 8 + (4 * bj + fq)) * 64 + (t & 63)) * 8, acc[ai][bj][m][0] * rinv * gv[bj][0], acc[ai][bj][m][1] * rinv * gv[bj][1]);
                    }
                }
        } else {
            const int col0 = (pn - 8) * 128 + wc * 32 + 8 * fq;
#pragma unroll
            for (int ai = 0; ai < 2; ++ai)
#pragma unroll
                for (int m = 0; m < 4; ++m) { const size_t off = (size_t)(row0 + ai * HALF + m * 16) * 1024 + col0;
                    f32x4 r0, r1, a0, a1;
#pragma unroll
                    for (int i = 0; i < 4; ++i) {
                        const float ea0 = __builtin_amdgcn_exp2f(-acc[ai][1][m][0][i] * LOG2E), ea1 = __builtin_amdgcn_exp2f(-acc[ai][1][m][1][i] * LOG2E);
                        a0[i] = __builtin_amdgcn_rcpf(1.0f + ea0); a1[i] = __builtin_amdgcn_rcpf(1.0f + ea1);
                        r0[i] = sigm(acc[ai][0][m][0][i]) * (1.0f + ea0); r1[i] = sigm(acc[ai][0][m][1][i]) * (1.0f + ea1); }
                    st8(GP + off, r0, r1); st8(GA + off, a0, a1); }
        }
    }
};

struct EpiMerge {
    static constexpr bool PERM = true;
    const bf16_t *GP, *GA; bf16_t* O;
    __device__ __forceinline__ void prefetch(const Unit& u, int wr, int wc, int lane, LAS unsigned* junk) const {
#pragma unroll
        for (int q = 0; q < 4; ++q) { const int idx = q * 64 + lane, ri = idx >> 1, bj = idx & 1; const int row = u.pm * BM + 128 * (ri >> 6) + 64 * wr + (ri & 63);
            const size_t off = (size_t)row * 1024 + u.pn * BM + wc * 32 + bj * HALF; touch(GP + off, junk); touch(GA + off, junk); }
    }
    __device__ __forceinline__ void mid(f32x4 (&acc)[2][2][4][2], const Unit& u, int wr, int wc, int fr, int fq) const {
        int row0 = u.pm * BM + wr * 64 + fr; const int col0 = u.pn * BM + wc * 32 + 8 * fq;
        asm volatile("" : "+v"(row0));
#pragma unroll
        for (int ai = 0; ai < 2; ++ai) {
            u32x4 pv[4][2];
#pragma unroll
            for (int m = 0; m < 4; ++m) { const size_t off = (size_t)(row0 + ai * HALF + m * 16) * 1024 + col0;
#pragma unroll
                for (int bj = 0; bj < 2; ++bj) pv[m][bj] = *(const u32x4*)(GP + off + bj * HALF); }
#pragma unroll
            for (int m = 0; m < 4; ++m)
#pragma unroll
                for (int bj = 0; bj < 2; ++bj) { const u32x4 p = pv[m][bj];
                    const f32x4 r0 = {bflo(p.x), bfhi(p.x), bflo(p.y), bfhi(p.y)}, r1 = {bflo(p.z), bfhi(p.z), bflo(p.w), bfhi(p.w)};
                    acc[ai][bj][m][0] *= r0; acc[ai][bj][m][1] *= r1; }
            asm volatile("" ::: "memory");
        }
    }
    __device__ __forceinline__ void operator()(const f32x4 (&acc)[2][2][4][2], const Unit& u, int wr, int wc, int fr, int fq) const {
        const int row0 = u.pm * BM + wr * 64 + fr, col0 = u.pn * BM + wc * 32 + 8 * fq;
#pragma unroll
        for (int ai = 0; ai < 2; ++ai) {
            u32x4 av[4][2];
#pragma unroll
            for (int m = 0; m < 4; ++m)
#pragma unroll
                for (int bj = 0; bj < 2; ++bj) av[m][bj] = *(const u32x4*)(GA + (size_t)(row0 + ai * HALF + m * 16) * 1024 + col0 + bj * HALF);
#pragma unroll
            for (int m = 0; m < 4; ++m)
#pragma unroll
                for (int bj = 0; bj < 2; ++bj) { const u32x4 a = av[m][bj];
                    const f32x4 g0 = {bflo(a.x), bfhi(a.x), bflo(a.y), bfhi(a.y)}, g1 = {bflo(a.z), bfhi(a.z), bflo(a.w), bfhi(a.w)};
                    st8(O + (size_t)(row0 + ai * HALF + m * 16) * 1024 + col0 + bj * HALF, acc[ai][bj][m][0] * g0, acc[ai][bj][m][1] * g1); }
            asm volatile("" ::: "memory");
        }
    }
};

struct EpiRes {
    static constexpr bool PERM = true;
    const float* X; bf16_t* O;
    __device__ __forceinline__ void prefetch(const Unit& u, int wr, int wc, int lane, LAS unsigned* junk) const {
#pragma unroll
        for (int q = 0; q < 4; ++q) { const int idx = q * 64 + lane, ri = idx >> 1, bj = idx & 1; const int row = u.pm * BM + 128 * (ri >> 6) + 64 * wr + (ri & 63);
            touch(X + (size_t)row * 1024 + u.pn * BM + wc * 32 + bj * HALF, junk); }
    }
    __device__ __forceinline__ void mid(f32x4 (&)[2][2][4][2], const Unit&, int, int, int, int) const {}
    __device__ __forceinline__ void operator()(const f32x4 (&acc)[2][2][4][2], const Unit& u, int wr, int wc, int fr, int fq) const {
        const int row0 = u.pm * BM + wr * 64 + fr, col0 = u.pn * BM + wc * 32 + 8 * fq;
#pragma unroll
        for (int ai = 0; ai < 2; ++ai) {
            f32x4 xv[4][2][2];
#pragma unroll
            for (int m = 0; m < 4; ++m)
#pragma unroll
                for (int bj = 0; bj < 2; ++bj) { const float* xp = X + (size_t)(row0 + ai * HALF + m * 16) * 1024 + col0 + bj * HALF; xv[m][bj][0] = *(const f32x4*)xp; xv[m][bj][1] = *(const f32x4*)(xp + 4); }
#pragma unroll
            for (int m = 0; m < 4; ++m)
#pragma unroll
                for (int bj = 0; bj < 2; ++bj) st8(O + (size_t)(row0 + ai * HALF + m * 16) * 1024 + col0 + bj * HALF, xv[m][bj][0] + acc[ai][bj][m][0], xv[m][bj][1] + acc[ai][bj][m][1]);
            asm volatile("" ::: "memory");
        }
    }
};

struct EpiMoe1 {
    static constexpr bool PERM = true;
    __device__ __forceinline__ void prefetch(const Unit&, int, int, int, LAS unsigned*) const {}
    const float *SR, *SWLO, *SWHI; bf16_t* HDN;
    __device__ __forceinline__ void mid(f32x4 (&)[2][2][4][2], const Unit&, int, int, int, int) const {}
    __device__ __forceinline__ void operator()(const f32x4 (&acc)[2][2][4][2], const Unit& u, int wr, int wc, int fr, int fq) const {
        const int slot0 = u.pm * BM + wr * 64 + fr; const float* SW = (u.pn < 4) ? SWLO : SWHI;
        const int col0 = (u.pn >> 2) * 512 + (u.pn & 3) * 128 + wc * 32 + 8 * fq;
        float rsv[2][4], wv[2][4];
#pragma unroll
        for (int ai = 0; ai < 2; ++ai)
#pragma unroll
            for (int m = 0; m < 4; ++m) { rsv[ai][m] = SR[slot0 + ai * HALF + m * 16]; wv[ai][m] = SW[slot0 + ai * HALF + m * 16]; }
#pragma unroll
        for (int ai = 0; ai < 2; ++ai) { if (ai == 1 && u.half) break;
#pragma unroll
            for (int m = 0; m < 4; ++m) { const int slot = slot0 + ai * HALF + m * 16; const float rs = rsv[ai][m] * (1.0f / F8_WSCALE), w = wv[ai][m];
                f32x4 h0, h1;
#pragma unroll
                for (int i = 0; i < 4; ++i) { const float g0 = acc[ai][0][m][0][i] * rs, u0 = acc[ai][1][m][0][i] * rs, g1 = acc[ai][0][m][1][i] * rs, u1 = acc[ai][1][m][1][i] * rs;
                    h0[i] = g0 * sigm(g0) * u0 * w; h1[i] = g1 * sigm(g1) * u1 * w; }
                st8(HDN + (size_t)slot * 1024 + col0, h0, h1); } }
    }
};

struct EpiMoe2 {
    static constexpr bool PERM = true;
    const int* STOK; const bf16_t* X1; float* O;
    __device__ __forceinline__ void prefetch(const Unit& u, int wr, int wc, int lane, LAS unsigned* junk) const {
#pragma unroll
        for (int q = 0; q < 4; ++q) { const int idx = q * 64 + lane, ri = idx >> 1, bj = idx & 1; int tok = STOK[u.pm * BM + 128 * (ri >> 6) + 64 * wr + (ri & 63)]; tok = tok < 0 ? 0 : tok;
            touch(X1 + (size_t)tok * 1024 + u.pn * BM + wc * 32 + bj * HALF, junk); }
    }
    __device__ __forceinline__ void mid(f32x4 (&)[2][2][4][2], const Unit&, int, int, int, int) const {}
    __device__ __forceinline__ void operator()(const f32x4 (&acc)[2][2][4][2], const Unit& u, int wr, int wc, int fr, int fq) const {
        int fr_ = fr, fq_ = fq; asm volatile("" : "+v"(fr_), "+v"(fq_));
        const int slot0 = u.pm * BM + wr * 64 + fr_, col0 = u.pn * BM + wc * 32 + 8 * fq_;
        int tk[2][4];
#pragma unroll
        for (int ai = 0; ai < 2; ++ai)
#pragma unroll
            for (int m = 0; m < 4; ++m) tk[ai][m] = STOK[slot0 + ai * HALF + m * 16];
#pragma unroll
        for (int ai = 0; ai < 2; ++ai) { if (ai == 1 && u.half) break;
#pragma unroll
            for (int mp = 0; mp < 2; ++mp) {
                u32x4 xv[2][2];
#pragma unroll
                for (int mi = 0; mi < 2; ++mi) { const int m = mp * 2 + mi; const int tok = tk[ai][m] < 0 ? 0 : tk[ai][m];
#pragma unroll
                    for (int bj = 0; bj < 2; ++bj) xv[mi][bj] = *(const u32x4*)(X1 + (size_t)tok * 1024 + col0 + bj * HALF); }
#pragma unroll
                for (int mi = 0; mi < 2; ++mi) { const int m = mp * 2 + mi; const int tok = tk[ai][m];
                    if (tok >= 0) { const size_t off = (size_t)tok * 1024 + col0;
#pragma unroll
                        for (int bj = 0; bj < 2; ++bj) { const u32x4 x = xv[mi][bj];
                            const f32x4 x0 = {bflo(x.x), bfhi(x.x), bflo(x.y), bfhi(x.y)}, x1 = {bflo(x.z), bfhi(x.z), bflo(x.w), bfhi(x.w)};
                            constexpr float SC = 1.0f;
                            *(f32x4*)(O + off + bj * HALF) = x0 + acc[ai][bj][m][0] * SC; *(f32x4*)(O + off + bj * HALF + 4) = x1 + acc[ai][bj][m][1] * SC; } } }
                asm volatile("" ::: "memory");
            }
        }
    }
};

struct MoeSched {
    const LAS int* tab; const char* A; const char* B; const int* STOK; int mode;
    __device__ __forceinline__ bool next(int i, Unit& u) const {
        if (i >= 16) return false;
        const int tile = __builtin_amdgcn_readfirstlane(tab[i * 8 + 0]); if (tile < 0) return false;
        const int pn = __builtin_amdgcn_readfirstlane(tab[i * 8 + 1]), e0 = __builtin_amdgcn_readfirstlane(tab[i * 8 + 2]), e1 = __builtin_amdgcn_readfirstlane(tab[i * 8 + 3]);
        u.pm = tile; u.pn = pn; u.e0 = e0; u.e1 = e1; u.half = __builtin_amdgcn_readfirstlane(tab[i * 8 + 4]);
        if (mode == 1) { const int e = (pn < 4) ? e0 : e1; u.a = A; u.b0 = B + ((size_t)e * 1024 * 1024 + (size_t)(pn & 3) * 256 * 1024); u.b1 = u.b0; }
        else { u.a = A + (size_t)tile * 256 * 1024 * 2; u.b0 = B + ((size_t)e0 * 1024 + (size_t)pn * 256) * 512 * 2; u.b1 = B + ((size_t)e1 * 1024 + (size_t)pn * 256) * 512 * 2; }
        return true;
    }
    __device__ __forceinline__ void offs(const Unit& u, const int (&Rr)[2], const int (&Cc)[2], unsigned (&off)[2][2]) const {
#pragma unroll
        for (int h = 0; h < 2; ++h)
#pragma unroll
            for (int i = 0; i < 2; ++i) { int tok = STOK[u.pm * 256 + h * 128 + Rr[i]]; tok = tok < 0 ? 0 : tok; off[h][i] = (unsigned)tok * 1024u + (unsigned)Cc[i] * 2u; }
    }
};
}

namespace att {
__device__ __forceinline__ int crow(int r, int hi) { return (r & 3) + 8 * (r >> 2) + 4 * hi; }
__device__ __forceinline__ void glds16(const void* gsrc, unsigned lds_dst) { unsigned keep;
    asm volatile("s_mov_b32 %0, m0\n\ts_mov_b32 m0, %2\n\ts_nop 0\n\tglobal_load_lds_dwordx4 %1, off\n\ts_mov_b32 m0, %0" : "=&s"(keep) : "v"(gsrc), "s"(lds_dst) : "memory"); }
typedef __attribute__((address_space(3))) const char* lds_cptr;
typedef short v4i16_t __attribute__((ext_vector_type(4)));
__device__ __forceinline__ s16x4 vtr(lds_cptr p) { return __builtin_bit_cast(s16x4, __builtin_amdgcn_ds_read_tr16_b64_v4i16((__attribute__((address_space(3))) v4i16_t*)p)); }
#define ATT_WAIT_BAR() asm volatile("s_waitcnt vmcnt(0) lgkmcnt(0)\n\ts_barrier" ::: "memory")
constexpr int SLOT = 32768;
constexpr int WSF_OFF = LDSCTL_OFF + 2048;
constexpr int XCH_OFF = 0;

__device__ __forceinline__ void attn_unit(int b, int h, int qb, const bf16_t* Q, const bf16_t* K, const bf16_t* V, bf16_t* DO, char* shm, float B2, float lam, const float* subg TP_PARAMS) {
    TP_BEGIN(25);
    const int tid = threadIdx.x, lane = tid & 63, r32 = lane & 31, hi = lane >> 5; const int wid = __builtin_amdgcn_readfirstlane(tid >> 6);
    const int mm = wid >> 2, wq = wid & 3;
    const long rowbase = (long)b * SEQ; const int q0 = qb * 128, i0 = q0 + wq * 32;
    const float aslope = LOG2E * __builtin_amdgcn_exp2f(-2.0f * (float)(h + 1));
    const unsigned lds0 = (unsigned)(uintptr_t)shm; const lds_cptr shm3 = (lds_cptr)shm;
    float* wsf = (float*)(shm + WSF_OFF) + wid * 64;
    const bf16_t* Qw = Q + (rowbase + i0 + r32) * 512 + h * 128 + mm * 64 + hi * 8;
    bf16x8 qr[4];
#pragma unroll
    for (int ks = 0; ks < 4; ++ks) qr[ks] = *(const bf16x8*)(Qw + ks * 16);
    const int bh = b * 4 + h;
    const bf16_t* ksrc0 = K + (((size_t)bh * 2 + 0) * 32 * 8 + wid) * 512 + lane * 8;
    const bf16_t* ksrc1 = K + (((size_t)bh * 2 + 1) * 32 * 8 + wid) * 512 + lane * 8;
    const int p0i = 2 * wid, p1i = 2 * wid + 1;
    const bf16_t* vsrc0 = V + ((size_t)bh * 32 * 16 + p0i) * 512 + lane * 8;
    const bf16_t* vsrc1 = vsrc0 + 512;
    const int NTL = 2 * qb + 2;
    int ts; { const int Dk = (int)((2.0f * B2 + 30.2f) / aslope) + 1; ts = q0 - Dk; ts = ts < 0 ? 0 : (ts >> 6); }
#define ATT_DMA(t, slot) do { const unsigned _s = lds0 + (unsigned)(slot) * SLOT; \
        glds16(ksrc0 + (size_t)(t) * 4096, (unsigned)__builtin_amdgcn_readfirstlane(_s + wid * 1024)); glds16(ksrc1 + (size_t)(t) * 4096, (unsigned)__builtin_amdgcn_readfirstlane(_s + 8192 + wid * 1024)); \
        glds16(vsrc0 + (size_t)(t) * 8192, (unsigned)__builtin_amdgcn_readfirstlane(_s + 16384 + p0i * 1024)); glds16(vsrc1 + (size_t)(t) * 8192, (unsigned)__builtin_amdgcn_readfirstlane(_s + 16384 + p1i * 1024)); } while (0)
    ATT_DMA(ts, ts & 3); ATT_DMA(ts + 1, (ts + 1) & 3);
#if defined(ATT_PRIO_YOUNG)
    if (wid >= 4) __builtin_amdgcn_s_setprio(1);
#endif
    f32x16 o[4]; o[0] = f32x16{}; o[1] = f32x16{}; o[2] = f32x16{}; o[3] = f32x16{};
    float l_reg = 0.f;
    const int irow = i0 + r32;
    u32x4 qbias, kbias0, kbias1;
    { const float a_h = bf2f((unsigned short)f2bf(aslope)), r1 = aslope - a_h, a_m = bf2f((unsigned short)f2bf(r1)), a_l = bf2f((unsigned short)f2bf(r1 - a_m));
      const unsigned j0b = f2bf((float)r32), j1b = f2bf((float)(r32 + 32));
      qbias  = hi ? (u32x4){0u, 0u, 0u, 0u} : (u32x4){f2bf(a_h) | (f2bf(a_m) << 16), f2bf(a_l), 0u, 0u};
      kbias0 = hi ? (u32x4){0u, 0u, 0u, 0u} : (u32x4){j0b | (j0b << 16), j0b, 0u, 0u};
      kbias1 = hi ? (u32x4){0u, 0u, 0u, 0u} : (u32x4){j1b | (j1b << 16), j1b, 0u, 0u}; }
    __builtin_amdgcn_s_waitcnt(0x0F70);
    TP_END(25);
    const int vlane = ((lane >> 4) & 1) * 32 + (lane & 3) * 8 + (4 * hi + ((lane & 15) >> 2)) * 64;
    f32x16 cini; { const float c0 = aslope * (float)(64 * ts - irow) - B2; _Pragma("unroll") for (int r = 0; r < 16; ++r) cini[r] = c0; }
    const float cstep = 64.0f * aslope;
#define ATT_VRD(g) vtr(vp + ((g) >> 2) * 4096 + ((g) & 3) * 1024), vtr(vp + ((g) >> 2) * 4096 + ((g) & 3) * 1024 + 512)
#define ATT_PV(SL) do { const lds_cptr vp = shm3 + (SL) * SLOT + 16384 + vlane; \
        s16x4 vf[2][2]; \
        { const s16x4 a0[2] = {ATT_VRD(0)}, a1[2] = {ATT_VRD(1)}; vf[0][0] = a0[0]; vf[0][1] = a0[1]; vf[1][0] = a1[0]; vf[1][1] = a1[1]; } \
        __builtin_amdgcn_sched_barrier(0); \
        _Pragma("unroll") for (int g = 0; g < 16; ++g) {            \
            const s16x4 lo = vf[g & 1][0], hh = vf[g & 1][1]; \
            const bf16x8 vfr = (bf16x8){lo[0], lo[1], lo[2], lo[3], hh[0], hh[1], hh[2], hh[3]}; \
            o[g >> 2] = __builtin_amdgcn_mfma_f32_32x32x16_bf16(__builtin_bit_cast(bf16x8, pw[g & 3]), vfr, o[g >> 2], 0, 0, 0); \
            if (g + 2 < 16) { const s16x4 a3[2] = {ATT_VRD(g + 2)}; vf[g & 1][0] = a3[0]; vf[g & 1][1] = a3[1]; } \
            __builtin_amdgcn_sched_barrier(0); } \
        } while (0)
#define ATT_TILE(MASKED) do { \
        TP_BEGIN(21); \
        if (t + 1 < NTL) asm volatile("s_waitcnt vmcnt(4) lgkmcnt(0)\n\ts_barrier" ::: "memory"); else ATT_WAIT_BAR(); \
        TP_END(21); TP_BEGIN(22); \
        if (t + 2 < NTL) ATT_DMA(t + 2, (t + 2) & 3); \
        TP_END(22); TP_BEGIN(23); \
        const int j0 = 64 * t; \
        if (!(MASKED) || j0 <= i0 + 31) { \
            const char* kb = shm + (t & 3) * SLOT + mm * 8192 + hi * 1024 + r32 * 16; \
            bf16x8 kf[2]; kf[0] = *(const bf16x8*)(kb); kf[1] = *(const bf16x8*)(kb + 512);     \
            __builtin_amdgcn_sched_barrier(0); \
            f32x16 p0 = __builtin_amdgcn_mfma_f32_32x32x16_bf16(__builtin_bit_cast(bf16x8, kbias0), __builtin_bit_cast(bf16x8, qbias), cini, 0, 0, 0); \
            f32x16 p1 = __builtin_amdgcn_mfma_f32_32x32x16_bf16(__builtin_bit_cast(bf16x8, kbias1), __builtin_bit_cast(bf16x8, qbias), cini, 0, 0, 0); \
            __builtin_amdgcn_sched_barrier(0); \
            _Pragma("unroll") for (int f = 0; f < 8; ++f) { \
                if (f & 1) p1 = __builtin_amdgcn_mfma_f32_32x32x16_bf16(kf[1], qr[f >> 1], p1, 0, 0, 0); else p0 = __builtin_amdgcn_mfma_f32_32x32x16_bf16(kf[0], qr[f >> 1], p0, 0, 0, 0); \
                if (f + 2 < 8) kf[f & 1] = *(const bf16x8*)(kb + ((f + 2) >> 1) * 2048 + (f & 1) * 512); \
                __builtin_amdgcn_sched_barrier(0); } \
            if (MASKED) { const int jb = j0 + 4 * hi; \
                _Pragma("unroll") for (int r = 0; r < 16; ++r) { const int j = jb + (r & 3) + 8 * (r >> 2); if (j > irow) p0[r] = -1.0e30f; if (j + 32 > irow) p1[r] = -1.0e30f; } } \
            float sacc = 0.f; \
            _Pragma("unroll") for (int r = 0; r < 16; ++r) { p0[r] = __builtin_amdgcn_exp2f(p0[r]); p1[r] = __builtin_amdgcn_exp2f(p1[r]); sacc += p0[r] + p1[r]; } \
            l_reg += sacc; \
            u32x4 pw[4]; \
            pw[0] = (u32x4){cvt_pk_bf16(p0[0], p0[1]), cvt_pk_bf16(p0[2], p0[3]), cvt_pk_bf16(p0[4], p0[5]), cvt_pk_bf16(p0[6], p0[7])}; \
            pw[1] = (u32x4){cvt_pk_bf16(p0[8], p0[9]), cvt_pk_bf16(p0[10], p0[11]), cvt_pk_bf16(p0[12], p0[13]), cvt_pk_bf16(p0[14], p0[15])}; \
            pw[2] = (u32x4){cvt_pk_bf16(p1[0], p1[1]), cvt_pk_bf16(p1[2], p1[3]), cvt_pk_bf16(p1[4], p1[5]), cvt_pk_bf16(p1[6], p1[7])}; \
            pw[3] = (u32x4){cvt_pk_bf16(p1[8], p1[9]), cvt_pk_bf16(p1[10], p1[11]), cvt_pk_bf16(p1[12], p1[13]), cvt_pk_bf16(p1[14], p1[15])}; \
            TP_END(23); TP_BEGIN(24); \
            ATT_PV(t & 3); \
            TP_END(24); TP_BEGIN(23); \
        } TP_END(23); \
        _Pragma("unroll") for (int r = 0; r < 16; ++r) cini[r] += cstep; } while (0)
    int t = ts;
    for (; t < NTL - 2; ++t) ATT_TILE(false);
    for (; t < NTL; ++t) ATT_TILE(true);
#undef ATT_PV
#undef ATT_VRD
    TP_BEGIN(26);
#undef ATT_TILE
    { auto rr = __builtin_amdgcn_permlane32_swap(__float_as_uint(l_reg), __float_as_uint(l_reg), false, false); l_reg = __uint_as_float(rr[0]) + __uint_as_float(rr[1]); }
    if (hi == 0) wsf[r32] = l_reg;
    asm volatile("s_waitcnt lgkmcnt(0)" ::: "memory");
    const float fac = (mm == 0) ? 1.0f : lam;
#pragma unroll
    for (int r = 0; r < 16; ++r) { const float rl = fac * __builtin_amdgcn_rcpf(wsf[crow(r, hi)]);
#pragma unroll
        for (int d0 = 0; d0 < 4; ++d0) o[d0][r] *= rl; }
    TP_BEGIN(27);
    ATT_WAIT_BAR();
    TP_END(27); TP_BEGIN(28);
    float* xs = (float*)(shm + XCH_OFF) + (size_t)(wq * 2 + mm) * 16 * 128;
    const float* xr = (const float*)(shm + XCH_OFF) + (size_t)(wq * 2 + (mm ^ 1)) * 16 * 128;
    const int rs0 = mm ? 0 : 8, rk0 = mm ? 8 : 0;
#pragma unroll
    for (int rr = 0; rr < 8; ++rr)
#pragma unroll
        for (int d0 = 0; d0 < 4; ++d0) { const int r = rr + 8; const float vs = mm ? o[d0][rr] : o[d0][r];
            xs[(crow(rr, hi)) * 128 + 32 * d0 + r32] = vs; }
    ATT_WAIT_BAR();
    bf16_t* stg = (bf16_t*)(shm + 65536);
    { float gsub[4];
#pragma unroll
      for (int d0 = 0; d0 < 4; ++d0) gsub[d0] = subg[32 * d0 + r32] * 0.8f;
#pragma unroll
      for (int rr = 0; rr < 8; ++rr) {
          float ov[4], ss = 0.f;
#pragma unroll
          for (int d0 = 0; d0 < 4; ++d0) { const float other = xr[crow(rr, hi) * 128 + 32 * d0 + r32]; const float mine = mm ? o[d0][rr + 8] : o[d0][rr];
              ov[d0] = mm ? (other - mine) : (mine - other); ss += ov[d0] * ov[d0]; }
          ss += __shfl_xor(ss, 1); ss += __shfl_xor(ss, 2); ss += __shfl_xor(ss, 4); ss += __shfl_xor(ss, 8); ss += __shfl_xor(ss, 16);
          const float rinv = __builtin_amdgcn_rsqf(ss * (1.0f / 128.0f) + EPS);
          bf16_t* srow = stg + (wq * 32 + rk0 * 2 + crow(rr, hi)) * 128 + r32;
#pragma unroll
          for (int d0 = 0; d0 < 4; ++d0) srow[32 * d0] = (bf16_t)f2bf(ov[d0] * rinv * gsub[d0]);
      } }
    (void)rs0;
    ATT_WAIT_BAR();
    { const int row = tid >> 2, q4 = tid & 3;
      const bf16_t* sp = stg + row * 128 + q4 * 32; bf16_t* gp = DO + (size_t)(rowbase + q0 + row) * 1024 + 512 + h * 128 + q4 * 32;
      u32x4 v[4];
#pragma unroll
      for (int i = 0; i < 4; ++i) v[i] = *(const u32x4*)(sp + i * 8);
#pragma unroll
      for (int i = 0; i < 4; ++i) *(u32x4*)(gp + i * 8) = v[i]; }
    asm volatile("s_waitcnt lgkmcnt(0)" ::: "memory");
    TP_END(28);
    TP_END(26);
#undef ATT_DMA
}
}

struct Args { const float* in[23]; float* out; unsigned char* ws; };

__device__ __forceinline__ float wave_sum(float v) {
#pragma unroll
    for (int o = 1; o < 64; o <<= 1) v += __shfl_xor(v, o);
    return v;
}
__device__ __forceinline__ float wave_max(float v) {
#pragma unroll
    for (int o = 1; o < 64; o <<= 1) v = fmaxf(v, __shfl_xor(v, o));
    return v;
}

template <class DstF>
__device__ __forceinline__ void transpose_item(const float* W, int N, int k0, int n0, LAS float* scr, int lane, const float* ksc, DstF dst) {
    const int kk = lane >> 3, n4 = (lane & 7) * 4;
    f32x4 v[8];
#pragma unroll
    for (int j = 0; j < 8; ++j) v[j] = *(const f32x4*)(W + (size_t)(k0 + kk + 8 * j) * N + n0 + n4);
#pragma unroll
    for (int j = 0; j < 8; ++j) { LAS float* d = scr + (kk + 8 * j) * 33 + n4; d[0] = v[j][0]; d[1] = v[j][1]; d[2] = v[j][2]; d[3] = v[j][3]; }
    LDS_WAIT(); asm volatile("" ::: "memory");
    const int c = lane & 7;
    f32x4 s0 = {1.f, 1.f, 1.f, 1.f}, s1 = s0;
    if (ksc) { s0 = *(const f32x4*)(ksc + k0 + 8 * c); s1 = *(const f32x4*)(ksc + k0 + 8 * c + 4); }
#pragma unroll
    for (int j = 0; j < 4; ++j) { const int n = (lane >> 3) + 8 * j; const LAS float* s = scr + (8 * c) * 33 + n;
        u32x4 o; o.x = pk2(s[0 * 33] * s0[0], s[1 * 33] * s0[1]); o.y = pk2(s[2 * 33] * s0[2], s[3 * 33] * s0[3]); o.z = pk2(s[4 * 33] * s1[0], s[5 * 33] * s1[1]); o.w = pk2(s[6 * 33] * s1[2], s[7 * 33] * s1[3]);
        *(GAS u32x4*)(dst(n0 + n) + k0 + 8 * c) = o; }
    LDS_WAIT(); asm volatile("" ::: "memory");
}

template <class DstF>
__device__ __forceinline__ void transpose_item_f8(const float* W, int N, int k0, int n0, LAS float* scr, int lane, const float* ksc, float mult, DstF dst8) {
    const int kk = lane >> 3, n4 = (lane & 7) * 4;
    f32x4 v[8];
#pragma unroll
    for (int j = 0; j < 8; ++j) v[j] = *(const f32x4*)(W + (size_t)(k0 + kk + 8 * j) * N + n0 + n4);
#pragma unroll
    for (int j = 0; j < 8; ++j) { LAS float* d = scr + (kk + 8 * j) * 33 + n4; d[0] = v[j][0]; d[1] = v[j][1]; d[2] = v[j][2]; d[3] = v[j][3]; }
    LDS_WAIT(); asm volatile("" ::: "memory");
    const int c = lane & 7;
    f32x4 s0 = {mult, mult, mult, mult}, s1 = s0;
    if (ksc) { s0 = s0 * *(const f32x4*)(ksc + k0 + 8 * c); s1 = s1 * *(const f32x4*)(ksc + k0 + 8 * c + 4); }
#pragma unroll
    for (int j = 0; j < 4; ++j) { const int n = (lane >> 3) + 8 * j; const LAS float* s = scr + (8 * c) * 33 + n;
        u32x2 o; o.x = pk4_f8(s[0 * 33] * s0[0], s[1 * 33] * s0[1], s[2 * 33] * s0[2], s[3 * 33] * s0[3]); o.y = pk4_f8(s[4 * 33] * s1[0], s[5 * 33] * s1[1], s[6 * 33] * s1[2], s[7 * 33] * s1[3]);
        *(GAS u32x2*)(dst8(n0 + n) + k0 + 8 * c) = o; }
    LDS_WAIT(); asm volatile("" ::: "memory");
}

#define PH_BEGIN() unsigned char* ws = args.ws; asm volatile("" : "+s"(ws)); int tid = threadIdx.x; asm volatile("" : "+v"(tid)); \
    const int lane = tid & 63, wave = __builtin_amdgcn_readfirstlane(tid >> 6); const int G = gridDim.x, bx = blockIdx.x; \
    const int vcu = (G % 8 == 0) ? (bx % 8) * (G / 8) + bx / 8 : bx; const int gw = vcu * NWAVES + wave, NGW = G * NWAVES; \
    gu32* ctl = (gu32*)(ws + WS_CTL); (void)lane; (void)wave; (void)gw; (void)NGW; (void)ctl; (void)vcu
#define WSP(T, off) ((T*)(ws + (off)))

#ifndef DEPHASE3
#define DEPHASE3 0
#endif
#ifndef DEPHASE4
#define DEPHASE4 0
#endif
#ifndef DEPHASE8
#define DEPHASE8 0
#endif
__device__ __forceinline__ void dephase(int vcu, unsigned ticks) {
    if ((vcu & 1) && ticks) { const unsigned long long t0 = __builtin_amdgcn_s_memrealtime(); while (__builtin_amdgcn_s_memrealtime() - t0 < ticks) __builtin_amdgcn_s_sleep(16); }
}
__global__ void __launch_bounds__(NWAVES * 64, 2) hybrid_fwd(Args args) {
    extern __shared__ __attribute__((aligned(16))) unsigned char lds[];
    LAS unsigned char* L = (LAS unsigned char*)lds;
    volatile LAS unsigned* MISC = (volatile LAS unsigned*)(L + MISC_OFF);
    for (int u = threadIdx.x; u < (LDS_BYTES - LDSCTL_OFF) / 4; u += NWAVES * 64) ((LAS unsigned*)(L + LDSCTL_OFF))[u] = 0u;
    __syncthreads();
    XcdBarrier bar = xcd_barrier_post((unsigned*)((gu32*)(args.ws + WS_CTL) + CW_BAR), MISC + 8);
    TP_DECL();

    TP_BEGIN(10);
    if (PHASE_MASK & 1) REPS(1) {
        PH_BEGIN();
        bf16_t* WinT = WSP(bf16_t, WS_WIN); bf16_t* WmT = WSP(bf16_t, WS_WM); bf16_t* WoT = WSP(bf16_t, WS_WO); unsigned char* Wgu8 = WSP(unsigned char, WS_WGU); bf16_t* WdT = WSP(bf16_t, WS_WD);
        bf16_t* WrH = WSP(bf16_t, WS_WRH); bf16_t* WrL = WSP(bf16_t, WS_WRL); bf16_t* Hb = WSP(bf16_t, WS_H);
        LAS float* scr = (LAS float*)(L + wave * 16384);
        constexpr int I_IN = 16 * 128, I_AU = 8 * 32, I_OUT = 16 * 32, I_G = 32 * 256, I_U = 32 * 256, I_D = 32 * 256;
        constexpr int NITEMS = I_IN + I_AU + I_OUT + I_G + I_U + I_D;
        TP_BEGIN(30);
        for (int it = gw; it < NITEMS; it += NGW) {
            int r = it;
            if (r < I_IN) { const int kb = r / 128, nb = r % 128;
                transpose_item(args.in[2], 4096, kb * 64, nb * 32, scr, lane, nullptr, [&](int n) -> bf16_t* {
                    int v = n; if (n >= 512 && n < 1536) { const int l = n & 255; v = (n & ~255) + 128 * ((l >> 5) & 1) + 32 * (l >> 6) + (l & 31); }
                    else if (n >= 2048) { const int c = (n - 2048) & 1023; v = 2048 + 256 * (c >> 7) + (c & 127) + ((n >= 3072) ? 128 : 0); }
                    return WinT + (size_t)v * 1024; });
                continue; } r -= I_IN;
            if (r < I_AU) { const int kb = r / 32, nb = r % 32;
                transpose_item(args.in[13], 1024, kb * 64, nb * 32, scr, lane, nullptr, [&](int n) -> bf16_t* { return WmT + (size_t)n * 1024 + 512; }); continue; } r -= I_AU;
            if (r < I_OUT) { const int kb = r / 32, nb = r % 32;
                transpose_item(args.in[14], 1024, kb * 64, nb * 32, scr, lane, nullptr, [&](int n) -> bf16_t* { return WoT + (size_t)n * 1024; }); continue; } r -= I_OUT;
            if (r < I_G) { const int e = r / 256, q = r % 256, kb = q / 16, nb = q % 16;
                transpose_item_f8(args.in[20] + (size_t)e * 1024 * 512, 512, kb * 64, nb * 32, scr, lane, args.in[15], F8_WSCALE, [&](int n) -> unsigned char* { return Wgu8 + (size_t)e * 1024 * 1024 + (size_t)(256 * (n >> 7) + (n & 127)) * 1024; }); continue; } r -= I_G;
            if (r < I_U) { const int e = r / 256, q = r % 256, kb = q / 16, nb = q % 16;
                transpose_item_f8(args.in[21] + (size_t)e * 1024 * 512, 512, kb * 64, nb * 32, scr, lane, args.in[15], F8_WSCALE, [&](int n) -> unsigned char* { return Wgu8 + (size_t)e * 1024 * 1024 + (size_t)(256 * (n >> 7) + 128 + (n & 127)) * 1024; }); continue; } r -= I_U;
            { const int e = r / 256, q = r % 256, kb = q / 32, nb = q % 32;
                transpose_item(args.in[22] + (size_t)e * 512 * 1024, 1024, kb * 64, nb * 32, scr, lane, nullptr, [&](int n) -> bf16_t* { return WdT + ((size_t)e * 1024 + n) * 512; }); }
        }
        TP_END(30); TP_BEGIN(31);
        for (int it = gw; it < 2048; it += NGW) {
            const int kq = it >> 4, nb = it & 15, n = 64 * nb + lane, k = 4 * kq, g = k >> 7, kl = k & 127;
            const float* pw = args.in[3] + (size_t)(g * 128 + kl) * 128; const float* sc = args.in[4] + g * 128; const float* wu = args.in[5] + (size_t)(g * 128) * 1024 + n;
            float a0 = 0.f, a1 = 0.f, a2 = 0.f, a3 = 0.f;
            for (int c0 = 0; c0 < 128; c0 += 16) { float wv[16];
#pragma unroll
                for (int c = 0; c < 16; ++c) wv[c] = wu[(size_t)(c0 + c) * 1024];
#pragma unroll
                for (int c = 0; c < 16; ++c) { const float w2 = wv[c] * sc[c0 + c]; a0 += pw[c0 + c] * w2; a1 += pw[128 + c0 + c] * w2; a2 += pw[256 + c0 + c] * w2; a3 += pw[384 + c0 + c] * w2; } }
            u32x2 o; o.x = pk2(a0, a1); o.y = pk2(a2, a3);
            *(u32x2*)(WmT + (size_t)n * 1024 + k) = o;
        }
        TP_END(31); TP_BEGIN(32);
        for (int it = gw * 64 + lane; it < 48 * 1024; it += NGW * 64) {
            const int n = it >> 10, k = it & 1023; float w = 0.f;
            if (n < 4) w = args.in[16][k * 4 + n]; else if (n < 36) w = args.in[18][k * 32 + (n - 4)];
            w *= args.in[15][k];
            const unsigned hb = f2bf(w); const float lo = w - __builtin_bit_cast(float, hb << 16);
            WrH[it] = (bf16_t)hb; WrL[it] = (bf16_t)f2bf(lo);
        }
        TP_END(32); TP_BEGIN(33);
        { const float* x = args.in[0]; const GAS f32x4* g4 = (const GAS f32x4*)args.in[1] + lane; f32x4 gg[4];
#pragma unroll
          for (int j = 0; j < 4; ++j) gg[j] = g4[64 * j];
          for (int m = gw * 2; m < NTOK; m += NGW * 2) {
            const GAS f32x4* xr = (const GAS f32x4*)(x + (size_t)m * DM) + lane;
            f32x4 v[8]; float s0 = 0.f, s1 = 0.f;
#pragma unroll
            for (int j = 0; j < 8; ++j) v[j] = xr[64 * j];
#pragma unroll
            for (int j = 0; j < 4; ++j) { s0 += (v[j].x * v[j].x + v[j].y * v[j].y) + (v[j].z * v[j].z + v[j].w * v[j].w); s1 += (v[4 + j].x * v[4 + j].x + v[4 + j].y * v[4 + j].y) + (v[4 + j].z * v[4 + j].z + v[4 + j].w * v[4 + j].w); }
            const float r0 = __builtin_amdgcn_rsqf(wave_sum(s0) * (1.f / DM) + EPS), r1 = __builtin_amdgcn_rsqf(wave_sum(s1) * (1.f / DM) + EPS);
            GAS unsigned long long* o8 = (GAS unsigned long long*)(Hb + (size_t)m * DM) + lane;
#pragma unroll
            for (int j = 0; j < 8; ++j) { const f32x4 y = v[j] * (j < 4 ? r0 : r1) * gg[j & 3]; o8[64 * j] = (unsigned long long)pk2(y.x, y.y) | ((unsigned long long)pk2(y.z, y.w) << 32); }
          } }
        TP_END(33);
    }
    xcd_barrier(bar);
    TP_END(10);

    TP_BEGIN(11);
    if (PHASE_MASK & 2) REPS(2) {
        PH_BEGIN();
        gm::StaticOrder S; S.init(WSP(bf16_t, WS_H), WSP(bf16_t, WS_WIN), 1024, 1024, NTOK, 4096, G, bx);
        gm::EpiProj E{WSP(bf16_t, WS_U), WSP(bf16_t, WS_Q), WSP(bf16_t, WS_K), WSP(bf16_t, WS_V), WSP(bf16_t, WS_GP), WSP(bf16_t, WS_GA), args.in[6], args.in[7]};
        gm::gemm_phase<1, gm::EpiProj, gm::StaticOrder, gm::NT, false, false>(L, S, E, 1024, 1024 TP_ARGS);
    }
    xcd_barrier(bar);
    TP_END(11);

    TP_BEGIN(12);
    if (PHASE_MASK & 4) REPS(4) {
        PH_BEGIN();
        bf16_t* Ub = WSP(bf16_t, WS_U); bf16_t* DOb = WSP(bf16_t, WS_DO);
        float lam, B2;
        { const float a1 = args.in[8][lane] * args.in[9][lane], a2 = args.in[10][lane] * args.in[11][lane];
          lam = __expf(wave_sum(a1)) - __expf(wave_sum(a2)) + 0.2f;
          const float mq = wave_max(fabsf(args.in[6][lane])), mk = wave_max(fabsf(args.in[7][lane]));
          B2 = 8.0f * mq * mk * LOG2E * 1.02f + 0.5f; }
        TP_BEGIN(20);
        { LAS int* tick = (LAS int*)(L + LDSCTL_OFF + 512);
          const int bq = vcu >> 3; unsigned* qh = (unsigned*)(ctl + CW_ATTQ) + bq * 16;
          if (tid == 0) tick[0] = (int)atomicAdd(qh, 1u);
          __syncthreads();
          int idx = tick[0];
          while (idx < 64) {
              __syncthreads();
              if (tid == 0) tick[0] = (int)atomicAdd(qh, 1u);
              int h, qb; if (idx < 32) { h = 3 - (idx & 1); qb = 15 - (idx >> 1); } else if (idx < 48) { h = 1; qb = 47 - idx; } else { h = 0; qb = 63 - idx; }
              att::attn_unit(bq, h, qb, WSP(bf16_t, WS_Q), WSP(bf16_t, WS_K), WSP(bf16_t, WS_V), DOb, (char*)lds, B2, lam, args.in[12] TP_ARGS);
              __syncthreads();
              idx = tick[0];
          } }
        TP_END(20);
        { const int w = 2 << (lane >> 4);
          const bf16_t* Ul = Ub + lane * 8;
          for (int blk = gw; blk < NTOK / 8; blk += NGW) {
            const int tok0 = blk * 8, t0 = tok0 & (SEQ - 1);
            u32x4 hist[15], curv[8], oldv[8];
#pragma unroll
            for (int s = 1; s <= 15; ++s) { const int ok = (s < w) && (t0 - s >= 0); hist[s - 1] = *(const u32x4*)(Ul + (size_t)(ok ? tok0 - s : tok0) * 512); if (!ok) hist[s - 1] = (u32x4){0u, 0u, 0u, 0u}; }
#pragma unroll
            for (int tt = 0; tt < 8; ++tt) { curv[tt] = *(const u32x4*)(Ul + (size_t)(tok0 + tt) * 512);
                const int ok = (t0 + tt - w + 1 >= 0); oldv[tt] = *(const u32x4*)(Ul + (size_t)(ok ? tok0 + tt - w + 1 : tok0) * 512); if (!ok) oldv[tt] = (u32x4){0u, 0u, 0u, 0u}; }
            float S[8];
#pragma unroll
            for (int c = 0; c < 8; ++c) S[c] = 0.f;
#pragma unroll
            for (int s = 0; s < 15; ++s) { const u32x4 v = hist[s];
                S[0] += bflo(v.x); S[1] += bfhi(v.x); S[2] += bflo(v.y); S[3] += bfhi(v.y); S[4] += bflo(v.z); S[5] += bfhi(v.z); S[6] += bflo(v.w); S[7] += bfhi(v.w); }
#pragma unroll
            for (int tt = 0; tt < 8; ++tt) { const u32x4 v = curv[tt], q = oldv[tt]; const int t = t0 + tt;
                const float c0 = bflo(v.x), c1 = bfhi(v.x), c2 = bflo(v.y), c3 = bfhi(v.y), c4 = bflo(v.z), c5 = bfhi(v.z), c6 = bflo(v.w), c7 = bfhi(v.w);
                S[0] += c0; S[1] += c1; S[2] += c2; S[3] += c3; S[4] += c4; S[5] += c5; S[6] += c6; S[7] += c7;
                const float inv = 1.0f / (float)((t + 1 < w) ? t + 1 : w);
                u32x4 o; o.x = pk2(S[0] * inv - c0, S[1] * inv - c1); o.y = pk2(S[2] * inv - c2, S[3] * inv - c3); o.z = pk2(S[4] * inv - c4, S[5] * inv - c5); o.w = pk2(S[6] * inv - c6, S[7] * inv - c7);
                *(u32x4*)(DOb + (size_t)(tok0 + tt) * 1024 + lane * 8) = o;
                S[0] -= bflo(q.x); S[1] -= bfhi(q.x); S[2] -= bflo(q.y); S[3] -= bfhi(q.y); S[4] -= bflo(q.z); S[5] -= bfhi(q.z); S[6] -= bflo(q.w); S[7] -= bfhi(q.w); }
          } }
    }
    xcd_barrier(bar);
    TP_END(12);

    TP_BEGIN(13);
    if (PHASE_MASK & 8) REPS(8) {
        PH_BEGIN();
        gm::StaticOrder S; S.init(WSP(bf16_t, WS_DO), WSP(bf16_t, WS_WM), 1024, 1024, NTOK, 1024, G, bx);
        gm::EpiMerge E{WSP(bf16_t, WS_GP), WSP(bf16_t, WS_GA), WSP(bf16_t, WS_MERGED)};
        dephase(vcu, DEPHASE3);
        gm::gemm_phase<3, gm::EpiMerge, gm::StaticOrder, gm::NT, false, true>(L, S, E, 1024, 1024 TP_ARGS);
    }
    xcd_barrier(bar);
    TP_END(13);

    TP_BEGIN(14);
    if (PHASE_MASK & 16) REPS(16) {
        PH_BEGIN();
        gm::StaticOrder S; S.init(WSP(bf16_t, WS_MERGED), WSP(bf16_t, WS_WO), 1024, 1024, NTOK, 1024, G, bx);
        gm::EpiRes E{args.in[0], WSP(bf16_t, WS_X1)};
        dephase(vcu, DEPHASE4);
        gm::gemm_phase<4, gm::EpiRes, gm::StaticOrder, gm::NT, false, false>(L, S, E, 1024, 1024 TP_ARGS);
    }
    xcd_barrier(bar);
    TP_END(14);

    TP_BEGIN(15);
    if (PHASE_MASK & 32) {
        PH_BEGIN();
        float* rstd2 = WSP(float, WS_RSTD); int* tcls = WSP(int, WS_TCLS); float* twlo = WSP(float, WS_TWLO); float* twhi = WSP(float, WS_TWHI);
        int* stok = WSP(int, WS_STOK); float* swlo = WSP(float, WS_SWLO); float* swhi = WSP(float, WS_SWHI); float* srstd = WSP(float, WS_SRSTD);
        const bf16_t* X1 = WSP(bf16_t, WS_X1); const bf16_t* WrH = WSP(bf16_t, WS_WRH); const bf16_t* WrL = WSP(bf16_t, WS_WRL); unsigned char* X1F = WSP(unsigned char, WS_X1F8);
        for (int i = gw * 64 + lane; i < MAXT * 256; i += NGW * 64) { stok[i] = -1; swlo[i] = 0.f; swhi[i] = 0.f; srstd[i] = 0.f; }
        constexpr int TROW = 1040, LG_OFF = 96 * TROW;
        const int row = lane & 15, kg = lane >> 4;
        const int tok0 = gw * 32;
        f32x4 acc[2][3];
#pragma unroll
        for (int rg = 0; rg < 2; ++rg)
#pragma unroll
            for (int nf = 0; nf < 3; ++nf) acc[rg][nf] = (f32x4){0.f, 0.f, 0.f, 0.f};
        float ss[2] = {0.f, 0.f};
        for (int blk0 = 0; blk0 < NTOK; blk0 += NGW * 32) {
          const int tb = blk0 + tok0; const bool live = tb < NTOK;
          for (int half = 0; half < 2; ++half) {
            __syncthreads();
            for (int i = tid; i < 96 * 64; i += NWAVES * 64) { const int r = i >> 6, c = i & 63;
                const bf16_t* src = (r < 48 ? WrH + (size_t)r * 1024 : WrL + (size_t)(r - 48) * 1024) + half * 512 + c * 8;
                *(LAS u32x4*)(L + r * TROW + c * 16) = *(const u32x4*)src; }
            __syncthreads();
            if (live) {
                const bf16_t* xa = X1 + (size_t)(tb + row) * 1024 + half * 512 + kg * 16;
#pragma unroll 4
                for (int sp = 0; sp < 8; ++sp) {
                    u32x4 A[2][2];
#pragma unroll
                    for (int rg = 0; rg < 2; ++rg) { A[rg][0] = *(const u32x4*)(xa + (size_t)rg * 16 * 1024 + sp * 64); A[rg][1] = *(const u32x4*)(xa + (size_t)rg * 16 * 1024 + sp * 64 + 8); }
#pragma unroll
                    for (int rg = 0; rg < 2; ++rg) {
                        const u32x4 a0 = A[rg][0], a1 = A[rg][1]; u32x4 w;
                        w.x = pk4_f8(bflo(a0.x), bfhi(a0.x), bflo(a0.y), bfhi(a0.y)); w.y = pk4_f8(bflo(a0.z), bfhi(a0.z), bflo(a0.w), bfhi(a0.w));
                        w.z = pk4_f8(bflo(a1.x), bfhi(a1.x), bflo(a1.y), bfhi(a1.y)); w.w = pk4_f8(bflo(a1.z), bfhi(a1.z), bflo(a1.w), bfhi(a1.w));
                        *(u32x4*)(X1F + (size_t)(tb + rg * 16 + row) * 1024 + half * 512 + sp * 64 + kg * 16) = w; }
#pragma unroll
                    for (int rg = 0; rg < 2; ++rg)
#pragma unroll
                        for (int hh = 0; hh < 2; ++hh) { const u32x4 v = A[rg][hh];
                            const float f0 = bflo(v.x), f1 = bfhi(v.x), f2 = bflo(v.y), f3 = bfhi(v.y), f4 = bflo(v.z), f5 = bfhi(v.z), f6 = bflo(v.w), f7 = bfhi(v.w);
                            ss[rg] += (f0 * f0 + f1 * f1) + (f2 * f2 + f3 * f3) + (f4 * f4 + f5 * f5) + (f6 * f6 + f7 * f7); }
#pragma unroll
                    for (int hh = 0; hh < 2; ++hh)
#pragma unroll
                        for (int nf = 0; nf < 3; ++nf) {
                            const bf16x8 Bh = *(const LAS bf16x8*)(L + (nf * 16 + row) * TROW + (sp * 64 + kg * 16 + hh * 8) * 2);
                            const bf16x8 Bl = *(const LAS bf16x8*)(L + (48 + nf * 16 + row) * TROW + (sp * 64 + kg * 16 + hh * 8) * 2);
#pragma unroll
                            for (int rg = 0; rg < 2; ++rg) { const bf16x8 Af = __builtin_bit_cast(bf16x8, A[rg][hh]);
                                acc[rg][nf] = __builtin_amdgcn_mfma_f32_16x16x32_bf16(Af, Bh, acc[rg][nf], 0, 0, 0);
                                acc[rg][nf] = __builtin_amdgcn_mfma_f32_16x16x32_bf16(Af, Bl, acc[rg][nf], 0, 0, 0); }
                        }
                }
            }
          }
          if (live) {
            LAS float* lg = (LAS float*)(L + LG_OFF + wave * 3072);
#pragma unroll
            for (int rg = 0; rg < 2; ++rg) {
                float s2 = ss[rg]; s2 += __shfl_xor(s2, 16); s2 += __shfl_xor(s2, 32);
                const float rstd = __builtin_amdgcn_rsqf(s2 * (1.0f / 1024.0f) + EPS);
#pragma unroll
                for (int nf = 0; nf < 3; ++nf)
#pragma unroll
                    for (int r = 0; r < 4; ++r) lg[(4 * kg + r) * 48 + 16 * nf + row] = acc[rg][nf][r];
                LDS_WAIT(); asm volatile("" ::: "memory");
                if (lane < 16) {
                    const int tok = tb + rg * 16 + lane;
                    const LAS float* my = lg + lane * 48;
                    float gl[4]; int g = 0;
#pragma unroll
                    for (int j = 0; j < 4; ++j) gl[j] = rstd * my[j] + args.in[17][j];
                    float gmx = gl[0];
#pragma unroll
                    for (int j = 1; j < 4; ++j) if (gl[j] > gmx) { gmx = gl[j]; g = j; }
                    float den = 0.f;
#pragma unroll
                    for (int j = 0; j < 4; ++j) den += __expf(gl[j] - gmx);
                    const float ptop = 1.0f / den;
                    float le[8];
#pragma unroll
                    for (int e = 0; e < 8; ++e) le[e] = rstd * my[4 + g * 8 + e] + args.in[19][g * 8 + e];
                    int e1 = 0; float v1 = le[0];
#pragma unroll
                    for (int e = 1; e < 8; ++e) if (le[e] > v1) { v1 = le[e]; e1 = e; }
                    int e2 = -1; float v2 = -3.0e38f;
#pragma unroll
                    for (int e = 0; e < 8; ++e) if (e != e1 && le[e] > v2) { v2 = le[e]; e2 = e; }
                    const float rr = __expf(v2 - v1), w1 = ptop / (1.0f + rr), w2 = ptop * rr / (1.0f + rr);
                    const int lo = e1 < e2 ? e1 : e2, hi2 = e1 < e2 ? e2 : e1;
                    const float wlo = e1 < e2 ? w1 : w2, whi = e1 < e2 ? w2 : w1;
                    const int cls = g * 28 + lo * 8 - (lo * (lo + 1)) / 2 + (hi2 - lo - 1);
                    const unsigned pos = atomicAdd((unsigned*)(ctl + CW_CNT) + cls * 16, 1u);
                    tcls[tok] = cls | ((int)pos << 8); twlo[tok] = wlo; twhi[tok] = whi; rstd2[tok] = rstd;
                }
                LDS_WAIT(); asm volatile("" ::: "memory");
                ss[rg] = 0.f;
#pragma unroll
                for (int nf = 0; nf < 3; ++nf) acc[rg][nf] = (f32x4){0.f, 0.f, 0.f, 0.f};
            }
          }
        }
    }
    xcd_barrier(bar);
    TP_END(15);

    TP_BEGIN(16);
    if (PHASE_MASK & 64) {
        PH_BEGIN();
        float* rstd2 = WSP(float, WS_RSTD); int* tcls = WSP(int, WS_TCLS); float* twlo = WSP(float, WS_TWLO); float* twhi = WSP(float, WS_TWHI);
        int* stok = WSP(int, WS_STOK); float* swlo = WSP(float, WS_SWLO); float* swhi = WSP(float, WS_SWHI); float* srstd = WSP(float, WS_SRSTD);
        int* tilecls = WSP(int, WS_TILECLS);
        LAS int* fstart = (LAS int*)(L);
        LAS int* hidx = (LAS int*)(L + 512);
        LAS int* nfull = (LAS int*)(L + 1024);
        LAS int* cntl = (LAS int*)(L + 1536);
        LAS int* tot = (LAS int*)(L + 2048);
        if (tid < NCLS) cntl[tid] = (int)__hip_atomic_load((unsigned*)(ctl + CW_CNT) + tid * 16, RLX_AGENT);
        __syncthreads();
        if (tid == 0) { int f = 0, h = 0;
            for (int c = 0; c < NCLS; ++c) { const int n = cntl[c], nt = (n + 255) >> 8, lr = n - 256 * (nt - 1); const int hf = (nt > 0 && lr <= 128) ? 1 : 0; nfull[c] = nt - hf; fstart[c] = f; f += nt - hf; hidx[c] = hf ? h : -1; h += hf; }
            for (int c = 0; c < NCLS; ++c) if (hidx[c] >= 0) hidx[c] += f;
            tot[0] = f; tot[1] = f + h; }
        __syncthreads();
        if (bx == 0) {
            if (tid < NCLS) { const int t0 = fstart[tid], nf = nfull[tid]; for (int t = 0; t < nf; ++t) tilecls[t0 + t] = tid; if (hidx[tid] >= 0) tilecls[hidx[tid]] = tid; }
            if (tid == 0) { __hip_atomic_store((unsigned*)(ctl + CW_NTILES), (unsigned)tot[1], RLX_AGENT); __hip_atomic_store((unsigned*)(ctl + CW_NTILES) + 1, (unsigned)tot[0], RLX_AGENT); }
        }
        for (int tok = bx * 512 + tid; tok < NTOK; tok += G * 512) {
            const int cp = tcls[tok]; const int c = cp & 255; const unsigned pos = (unsigned)cp >> 8;
            const int j = (int)(pos >> 8); const int tile = (j < nfull[c]) ? fstart[c] + j : hidx[c];
            const int slot = tile * 256 + (int)(pos & 255u);
            stok[slot] = tok; swlo[slot] = twlo[tok]; swhi[slot] = twhi[tok]; srstd[slot] = rstd2[tok];
        }
    }
    xcd_barrier(bar);
    TP_END(16);

    TP_BEGIN(17);
    if (PHASE_MASK & 128) REPS(128) {
        PH_BEGIN();
        LAS int* utab = (LAS int*)(L + UTAB_OFF); const int* tilecls = WSP(int, WS_TILECLS);
        const int ntiles = (int)__hip_atomic_load((unsigned*)(ctl + CW_NTILES), RLX_AGENT);
        const int nfullt = (int)__hip_atomic_load((unsigned*)(ctl + CW_NTILES) + 1, RLX_AGENT);
        if (tid < 16) { const int Lx = tid * G + vcu; const int tile = Lx >> 3, pn = Lx & 7; int e0 = 0, e1 = 0, tl = -1;
            if (tile < ntiles) { const int cls = tilecls[tile]; const int g = cls / 28; int rem = cls % 28, lo = 0; while (rem >= 7 - lo) { rem -= 7 - lo; ++lo; } e0 = g * 8 + lo; e1 = g * 8 + lo + 1 + rem; tl = tile; }
            utab[tid * 8 + 0] = tl; utab[tid * 8 + 1] = pn; utab[tid * 8 + 2] = e0; utab[tid * 8 + 3] = e1; utab[tid * 8 + 4] = (tile >= nfullt) ? 1 : 0; }
        __syncthreads();
        gm::MoeSched S{utab, (const char*)WSP(unsigned char, WS_X1F8), (const char*)WSP(unsigned char, WS_WGU), WSP(int, WS_STOK), 1};
        gm::EpiMoe1 E{WSP(float, WS_SRSTD), WSP(float, WS_SWLO), WSP(float, WS_SWHI), WSP(bf16_t, WS_HDN)};
        gm::gemm_phase<7, gm::EpiMoe1, gm::MoeSched, 8, true, false, true, 8>(L, S, E, 512, 512 TP_ARGS);
    }
    xcd_barrier(bar);
    TP_END(17);
    TP_BEGIN(18);
    if (PHASE_MASK & 256) {
        PH_BEGIN();
        LAS int* utab = (LAS int*)(L + UTAB_OFF); const int* tilecls = WSP(int, WS_TILECLS);
        const int ntiles = (int)__hip_atomic_load((unsigned*)(ctl + CW_NTILES), RLX_AGENT);
        const int nfullt = (int)__hip_atomic_load((unsigned*)(ctl + CW_NTILES) + 1, RLX_AGENT);
        if (tid < 16) { const int Lx = tid * G + vcu; const int tile = Lx >> 2, pn = Lx & 3; int e0 = 0, e1 = 0, tl = -1;
            if (tile < ntiles) { const int cls = tilecls[tile]; const int g = cls / 28; int rem = cls % 28, lo = 0; while (rem >= 7 - lo) { rem -= 7 - lo; ++lo; } e0 = g * 8 + lo; e1 = g * 8 + lo + 1 + rem; tl = tile; }
            utab[tid * 8 + 0] = tl; utab[tid * 8 + 1] = pn; utab[tid * 8 + 2] = e0; utab[tid * 8 + 3] = e1; utab[tid * 8 + 4] = (tile >= nfullt) ? 1 : 0; }
        __syncthreads();
        gm::MoeSched S{utab, (const char*)WSP(bf16_t, WS_HDN), (const char*)WSP(bf16_t, WS_WD), WSP(int, WS_STOK), 2};
        gm::EpiMoe2 E{WSP(int, WS_STOK), WSP(bf16_t, WS_X1), args.out};
        dephase(vcu, DEPHASE8);
        gm::gemm_phase<8, gm::EpiMoe2, gm::MoeSched, 8, false, false>(L, S, E, 1024, 512 TP_ARGS);
    }
    TP_END(18);
    TP_FINISH();
}

extern "C" void kernel_launch(void* const* d_in, const int* in_sizes, int n_in, void* d_out, int out_size, void* d_ws, size_t ws_size, hipStream_t stream) {
    static int grid = 0;
    if (grid == 0) {
        if (n_in != 23 || out_size != NTOK * DM || ws_size < WS_END) { fprintf(stderr, "kernel_launch: unexpected shapes (n_in %d, out %d, ws %zu)\n", n_in, out_size, ws_size); grid = -1; return; }
        int dev = 0, cus = 0;
        if (hipGetDevice(&dev) != hipSuccess || hipDeviceGetAttribute(&cus, hipDeviceAttributeMultiprocessorCount, dev) != hipSuccess) { grid = -1; return; }
        if (hipFuncSetAttribute((const void*)hybrid_fwd, hipFuncAttributeMaxDynamicSharedMemorySize, LDS_BYTES) != hipSuccess) { fprintf(stderr, "kernel_launch: hipFuncSetAttribute failed\n"); grid = -1; return; }
        int per_cu = 0;
        if (hipOccupancyMaxActiveBlocksPerMultiprocessor(&per_cu, (const void*)hybrid_fwd, NWAVES * 64, LDS_BYTES) != hipSuccess || per_cu < 1) fprintf(stderr, "kernel_launch: occupancy query says %d\n", per_cu);
        (void)hipGetLastError();
        grid = cus;
        if (grid != 256) fprintf(stderr, "kernel_launch: %d CUs (built for 256)\n", grid);
    }
    if (grid < 0) return;
    if (hipMemsetAsync((char*)d_ws + WS_CTL, 0, CTL_ZERO_BYTES, stream) != hipSuccess) return;
    Args a{};
    for (int i = 0; i < 23; ++i) a.in[i] = (const float*)d_in[i];
    a.out = (float*)d_out; a.ws = (unsigned char*)d_ws;
    hipLaunchKernelGGL(hybrid_fwd, dim3(grid), dim3(NWAVES * 64), LDS_BYTES, stream, a);
}
```

```cpp
#include <hip/hip_runtime.h>
#include <hip/hip_bf16.h>
#include <cstdio>
#include <cstdint>

#define LAS __attribute__((address_space(3)))
#define GAS __attribute__((address_space(1)))
typedef unsigned short bf16_t;
typedef short bf16x8 __attribute__((ext_vector_type(8)));
typedef short s16x4 __attribute__((ext_vector_type(4)));
typedef float f32x2 __attribute__((ext_vector_type(2)));
typedef float f32x4 __attribute__((ext_vector_type(4)));
typedef float f32x16 __attribute__((ext_vector_type(16)));
typedef unsigned u32x4 __attribute__((ext_vector_type(4)));
typedef unsigned u32x2 __attribute__((ext_vector_type(2)));
typedef GAS unsigned gu32;
typedef int i32x4 __attribute__((ext_vector_type(4)));
typedef int i32x8 __attribute__((ext_vector_type(8)));
#define RLX_AGENT __ATOMIC_RELAXED, __HIP_MEMORY_SCOPE_AGENT
#define LDS_WAIT() asm volatile("s_waitcnt lgkmcnt(0)" ::: "memory")
#define VM_WAIT() asm volatile("s_waitcnt vmcnt(0)" ::: "memory")

#ifndef PHASE_MASK
#define PHASE_MASK 0x1ff
#endif
#ifndef DUP_MASK
#define DUP_MASK 0
#endif
#ifdef TPROBE
#ifndef TP_AMP
#define TP_AMP 4
#endif
#ifndef TP_WAVE
#define TP_WAVE 0
#endif
__device__ __forceinline__ unsigned long long tp_now() { unsigned long long t; __builtin_amdgcn_sched_barrier(0); asm volatile("s_memrealtime %0\n\ts_waitcnt lgkmcnt(0)" : "=s"(t) :: "memory"); __builtin_amdgcn_sched_barrier(0); return t; }
#define TP_DECL() unsigned long long tp_t0 = 0, tp_acc = 0; (void)tp_t0
#define TP_PARAMS , unsigned long long& tp_t0, unsigned long long& tp_acc
#define TP_ARGS , tp_t0, tp_acc
#define TP_BEGIN(k) do { if ((k) == TPROBE) tp_t0 = tp_now(); } while (0)
#define TP_END(k) do { if ((k) == TPROBE) tp_acc += tp_now() - tp_t0; } while (0)
#define TP_FINISH() do { if (blockIdx.x == 0 && threadIdx.x == TP_WAVE * 64) { const unsigned long long s0 = tp_now(); while (tp_now() - s0 < tp_acc * TP_AMP) __builtin_amdgcn_s_sleep(8); } } while (0)
#else
#define TP_DECL()
#define TP_PARAMS
#define TP_ARGS
#define TP_BEGIN(k)
#define TP_END(k)
#define TP_FINISH()
#endif
#define REPS(bit) for (int rep_ = 0; rep_ < ((DUP_MASK & (bit)) ? 2 : 1); ++rep_)

constexpr int NTOK = 65536, DM = 1024, SEQ = 2048;
constexpr float LOG2E = 1.4426950408889634f;
constexpr float EPS = 1e-6f;
constexpr int NCLS = 112, MAXT = 368;
constexpr int NWAVES = 8;

constexpr size_t MiB = 1u << 20;
constexpr size_t WS_CTL = 0, CTL_ZERO_BYTES = 64 * 1024;
constexpr size_t WS_RSTD = 1 * MiB, WS_TCLS = WS_RSTD + 256 * 1024, WS_TWLO = WS_TCLS + 256 * 1024, WS_TWHI = WS_TWLO + 256 * 1024;
constexpr size_t WS_STOK = 2 * MiB, WS_SWLO = WS_STOK + 512 * 1024, WS_SWHI = WS_SWLO + 512 * 1024, WS_SRSTD = WS_SWHI + 512 * 1024;
constexpr size_t WS_TILECLS = 4 * MiB;
constexpr size_t WS_WRH = 5 * MiB, WS_WRL = WS_WRH + 128 * 1024;
constexpr size_t WS_WIN = 16 * MiB, WS_WM = 24 * MiB, WS_WO = 26 * MiB;
constexpr size_t WS_WGU = 32 * MiB, WS_WD = 96 * MiB;
constexpr size_t WS_H = 128 * MiB;
constexpr size_t WS_U = 256 * MiB, WS_Q = 320 * MiB, WS_K = 384 * MiB, WS_V = 448 * MiB;
constexpr size_t WS_GP = 512 * MiB, WS_GA = 640 * MiB;
constexpr size_t WS_DO = 768 * MiB;
constexpr size_t WS_END = 896 * MiB;
constexpr size_t WS_MERGED = WS_H, WS_X1 = WS_U, WS_HDN = WS_GP, WS_X1F8 = WS_K;
constexpr int CW_TMO = 0, CW_NTILES = 16, CW_BAR = 4096, CW_CNT = 8192, CW_CUR = 10240, CW_ATTQ = 12288;
static_assert((CW_ATTQ + 32 * 16) * 4 <= (int)CTL_ZERO_BYTES && (CW_BAR + 3456) <= CW_CNT, "control words inside the per-call memset");

constexpr int RING_BYTES = 131072;
constexpr int LDSCTL_OFF = RING_BYTES, MISC_OFF = LDSCTL_OFF + 320, UTAB_OFF = LDSCTL_OFF + 1024;
constexpr int JUNK_OFF = LDSCTL_OFF + 8192;
constexpr int LDS_BYTES = 147456;

__device__ __forceinline__ unsigned f2bf(float f) { unsigned u = __builtin_bit_cast(unsigned, f); return (u + 0x7fffu + ((u >> 16) & 1u)) >> 16; }
__device__ __forceinline__ unsigned pk2(float lo, float hi) { return f2bf(lo) | (f2bf(hi) << 16); }
__device__ __forceinline__ float bf2f(unsigned short b) { return __builtin_bit_cast(float, (unsigned)b << 16); }
__device__ __forceinline__ float bflo(unsigned w) { return __builtin_bit_cast(float, w << 16); }
__device__ __forceinline__ float bfhi(unsigned w) { return __builtin_bit_cast(float, w & 0xffff0000u); }
__device__ __forceinline__ unsigned cvt_pk_bf16(float lo, float hi) { unsigned r; asm("v_cvt_pk_bf16_f32 %0, %1, %2" : "=v"(r) : "v"(lo), "v"(hi)); return r; }

__device__ __forceinline__ unsigned pk4_f8(float a, float b, float c, float d) { int w = 0; w = __builtin_amdgcn_cvt_pk_fp8_f32(a, b, w, false); w = __builtin_amdgcn_cvt_pk_fp8_f32(c, d, w, true); return (unsigned)w; }
constexpr float F8_WSCALE = 32.0f, F8_HSCALE = 16.0f;

#define XB_TMO      128
#define XB_XCNT(j)  (256  + 64 * (j))
#define XB_XSUB(j)  (1280 + 64 * (j))
#define XB_XGEN(j)  (2304 + 64 * (j))
#define XB_TOP      3328
#define XB_TOPGEN   3392
#define XCD_BAR_WORDS 3456
#define XB_SPIN_CAP (1u << 18)
__device__ __forceinline__ unsigned xb_ld(unsigned* p)              { return __hip_atomic_load(p, __ATOMIC_RELAXED, __HIP_MEMORY_SCOPE_AGENT); }
__device__ __forceinline__ unsigned xb_add(unsigned* p, unsigned v) { return __hip_atomic_fetch_add(p, v, __ATOMIC_RELAXED, __HIP_MEMORY_SCOPE_AGENT); }
__device__ __forceinline__ unsigned xb_xcc_id() { return (unsigned)__builtin_amdgcn_s_getreg((3 << 11) | 20) & 0xFu; }
#define XB_SPIN(cond, bar) do { unsigned _sp = 0; while (cond) { __builtin_amdgcn_s_sleep(1); \
    if ((++_sp & 255u) == 0u) { if (xb_ld(&(bar)[XB_TMO])) break; if (_sp > XB_SPIN_CAP) { atomicAdd(&(bar)[XB_TMO], 1u); break; } } } } while (0)
struct XcdBarrier { unsigned* bar; unsigned x; volatile LAS unsigned* st; };
__device__ __forceinline__ XcdBarrier xcd_barrier_post(unsigned* bar, volatile LAS unsigned* st) {
    XcdBarrier b; b.bar = bar; b.x = xb_xcc_id(); b.st = st;
    if (threadIdx.x == 0) (void)xb_add(&bar[XB_XCNT(b.x)], 1u);
    return b;
}
__device__ __forceinline__ void xcd_barrier_complete(unsigned* bar, unsigned x, unsigned& nloc, unsigned& nx) {
    const unsigned G = gridDim.x * gridDim.y * gridDim.z;
    unsigned sum, cnt, mine, sp = 0u;
    for (;;) {
        sum = 0u; cnt = 0u; mine = 0u;
#pragma unroll
        for (unsigned j = 0; j < 16; ++j) { const unsigned c = xb_ld(&bar[XB_XCNT(j)]); sum += c; cnt += (c > 0u) ? 1u : 0u; mine = (j == x) ? c : mine; }
        if (sum == G) break;
        __builtin_amdgcn_s_sleep(1);
        if ((++sp & 255u) == 0u) { if (xb_ld(&bar[XB_TMO])) break; if (sp > XB_SPIN_CAP) { atomicAdd(&bar[XB_TMO], 1u); break; } }
    }
    nloc = mine > 0u ? mine : 1u; nx = cnt > 0u ? cnt : 1u;
}
__device__ __forceinline__ void xcd_barrier(const XcdBarrier& b) {
    asm volatile("s_waitcnt vmcnt(0)" ::: "memory");
    __syncthreads();
    if (threadIdx.x == 0) {
        unsigned* bar = b.bar;
        __builtin_amdgcn_s_waitcnt(0);
        unsigned nloc = b.st[0], nx = b.st[1];
        if (nloc == 0u) { xcd_barrier_complete(bar, b.x, nloc, nx); b.st[0] = nloc; b.st[1] = nx; }
        const unsigned old = xb_add(&bar[XB_XSUB(b.x)], 1u);
        const unsigned gen = old / nloc;
        if (old + 1u == (gen + 1u) * nloc) {
            __builtin_amdgcn_fence(__ATOMIC_RELEASE, "agent");
            asm volatile("s_waitcnt vmcnt(0)" ::: "memory");
            const unsigned og = xb_add(&bar[XB_TOP], 1u);
            const unsigned tg = og / nx;
            if (og + 1u == (tg + 1u) * nx) xb_add(&bar[XB_TOPGEN], 1u);
            else XB_SPIN(xb_ld(&bar[XB_TOPGEN]) == tg, bar);
            __builtin_amdgcn_fence(__ATOMIC_ACQUIRE, "agent");
            xb_add(&bar[XB_XGEN(b.x)], 1u);
            asm volatile("s_waitcnt vmcnt(0)" ::: "memory");
        } else {
            XB_SPIN(xb_ld(&bar[XB_XGEN(b.x)]) == gen, bar);
            __builtin_amdgcn_fence(__ATOMIC_ACQUIRE, "agent");
            asm volatile("s_waitcnt vmcnt(0)" ::: "memory");
        }
    }
    __syncthreads();
}

namespace gm {
constexpr int BM = 256, BK = 64, HALF = 128, HTB = HALF * BK * 2, NXCD = 8, WGM = 8, NT = 16;
__host__ __device__ __forceinline__ int lds_byte(int r, int c) { const int st = (r >> 4) * 2 + (c >> 5), rr = r & 15, cc = c & 31, ob = rr * 64 + cc * 2; return st * 1024 + (ob ^ (((ob >> 9) & 1) << 5)); }
__host__ __device__ __forceinline__ void stage_rc(int b, int& R, int& C) { const int st = b / 1024, sb = b % 1024, swz = sb ^ (((sb >> 9) & 1) << 5); R = (st >> 1) * 16 + swz / 64; C = (st & 1) * 32 + (swz % 64) / 2; }
__host__ __device__ __forceinline__ int perm32(int rho) { const int n = rho >> 4, i = rho & 15; return 8 * (i >> 2) + 4 * n + (i & 3); }

struct Unit { const char* a; const char* b0; const char* b1; int pm, pn, e0, e1, half; };

struct StaticOrder {
    const char* A; const char* Bt; int lda, ldb; int nM, nN, nwg, G, c;
    __device__ void init(const void* A_, const void* Bt_, int lda_, int ldb_, int M, int N, int G_, int c_) { A = (const char*)A_; Bt = (const char*)Bt_; lda = lda_; ldb = ldb_; nM = M / BM; nN = N / BM; nwg = nM * nN; G = G_; c = c_; }
    __device__ __forceinline__ bool next(int i, Unit& u) const {
        const long L = (long)i * G + c; if (L >= nwg) return false;
        int wgid = (int)L; { const int q = nwg / NXCD, r = nwg % NXCD, xcd = wgid % NXCD, off = wgid / NXCD; wgid = (xcd < r ? xcd * (q + 1) : r * (q + 1) + (xcd - r) * q) + off; }
        const int nig = WGM * nN, gid = wgid / nig, fm = gid * WGM, gsz = (nM - fm) < WGM ? (nM - fm) : WGM;
        u.pm = fm + ((wgid % nig) % gsz); u.pn = (wgid % nig) / gsz; u.e0 = 0; u.e1 = 0; u.half = 0;
        u.a = A + (size_t)u.pm * BM * lda * 2; u.b0 = Bt + (size_t)u.pn * BM * ldb * 2; u.b1 = u.b0;
        return true;
    }
    __device__ __forceinline__ void offs(const Unit&, const int (&)[2], const int (&)[2], unsigned (&)[2][2]) const {}
};

template <int PH, class Epi, class Sched, int KS, bool GATHER, bool MID, bool F8 = false, int NTT = 16>
__device__ __forceinline__ void gemm_phase(LAS unsigned char* lds, const Sched& S, const Epi& E, const int lda, const int ldb TP_PARAMS) {
    int tid = threadIdx.x; asm volatile("" : "+v"(tid));
    const int wid = __builtin_amdgcn_readfirstlane(tid >> 6), lane = tid & 63, wr = wid >> 2, wc = wid & 3, fr = lane & 15, fq = lane >> 4;
    int Rr[2], Cc[2]; unsigned offA[2][2], offAn[2][2], voffB[2];
#pragma unroll
    for (int i = 0; i < 2; ++i) { int R, C; stage_rc(tid * 16 + i * 8192, R, C); Rr[i] = R; Cc[i] = C; const int Rb = Epi::PERM ? ((R & ~31) + perm32(R & 31)) : R;
        voffB[i] = (unsigned)(Rb * ldb + C) * 2u;
        offA[0][i] = (unsigned)(R * lda + C) * 2u; offA[1][i] = (unsigned)((R + HALF) * lda + C) * 2u; offAn[0][i] = offA[0][i]; offAn[1][i] = offA[1][i]; }
    const size_t kstep = (size_t)(BK * 2);
    const size_t hstepB = (size_t)HALF * ldb * 2;
    const unsigned ldsw = (unsigned)wid * 1024u;
    const int aoff = lds_byte(wr * 64 + fr, fq * 8), boff = lds_byte(wc * 32 + fr, fq * 8);
#define G_SA(b, h) (((b) * 2 + (h)) * HTB)
#define G_SB(b, h) ((4 + (b) * 2 + (h)) * HTB)
#define G_STAGE_A(bufoff, gbase, OFF, h) do { _Pragma("unroll") for (int _i = 0; _i < 2; ++_i) \
        __builtin_amdgcn_global_load_lds((const unsigned*)((const char*)(gbase) + (OFF)[h][_i]), (LAS unsigned*)(lds + (bufoff) + ldsw + _i * 8192), 16, 0, 0); } while (0)
#define G_STAGE_B(bufoff, gbase) do { _Pragma("unroll") for (int _i = 0; _i < 2; ++_i) \
        __builtin_amdgcn_global_load_lds((const unsigned*)((const char*)(gbase) + voffB[_i]), (LAS unsigned*)(lds + (bufoff) + ldsw + _i * 8192), 16, 0, 0); } while (0)
#define G_LD16(off) (*(const LAS bf16x8*)(lds + (off)))
#define G_CAT2(x, y) __builtin_shufflevector(__builtin_bit_cast(i32x4, x), __builtin_bit_cast(i32x4, y), 0, 1, 2, 3, 4, 5, 6, 7)
#define G_LDA(dst, b, h) do { _Pragma("unroll") for (int m = 0; m < 4; ++m) { if constexpr (F8) { dst##8[m] = G_CAT2(G_LD16(G_SA(b, h) + aoff + m * 2048), G_LD16(G_SA(b, h) + aoff + m * 2048 + 1024)); } \
        else { _Pragma("unroll") for (int k = 0; k < 2; ++k) dst[m][k] = G_LD16(G_SA(b, h) + aoff + m * 2048 + k * 1024); } } } while (0)
#define G_LDB(dst, b, h) do { _Pragma("unroll") for (int n = 0; n < 2; ++n) { if constexpr (F8) { dst##8[n] = G_CAT2(G_LD16(G_SB(b, h) + boff + n * 2048), G_LD16(G_SB(b, h) + boff + n * 2048 + 1024)); } \
        else { _Pragma("unroll") for (int k = 0; k < 2; ++k) dst[n][k] = G_LD16(G_SB(b, h) + boff + n * 2048 + k * 1024); } } } while (0)
#define G_MMA(ai, bj, At, Bt) do { __builtin_amdgcn_s_setprio(1); \
        if constexpr (F8) { _Pragma("unroll") for (int m = 0; m < 4; ++m) _Pragma("unroll") for (int n = 0; n < 2; ++n) \
            acc[ai][bj][m][n] = __builtin_amdgcn_mfma_scale_f32_16x16x128_f8f6f4(Bt##8[n], At##8[m], acc[ai][bj][m][n], 0, 0, 0, 0x7F7F7F7F, 0, 0x7F7F7F7F); } \
        else { _Pragma("unroll") for (int m = 0; m < 4; ++m) _Pragma("unroll") for (int n = 0; n < 2; ++n) _Pragma("unroll") for (int k = 0; k < 2; ++k) \
            acc[ai][bj][m][n] = __builtin_amdgcn_mfma_f32_16x16x32_bf16(Bt[n][k], At[m][k], acc[ai][bj][m][n], 0, 0, 0); } \
        __builtin_amdgcn_s_setprio(0); } while (0)
#define G_WAIT_V(n) asm volatile("s_waitcnt vmcnt(" #n ")" ::: "memory")
#define G_WAIT_L(n) asm volatile("s_waitcnt lgkmcnt(" #n ")" ::: "memory")
#define G_BAR __builtin_amdgcn_s_barrier()
#define G_SCHED __builtin_amdgcn_sched_barrier(0)
#define G_BP(u, t) ((t) < KS ? (u).b0 + (size_t)(t) * kstep : (u).b1 + (size_t)((t) - KS) * kstep)
    Unit cur, nxt; int ui = 0;
    if (!S.next(0, cur)) return;
    if constexpr (GATHER) S.offs(cur, Rr, Cc, offA);
    f32x4 acc[2][2][4][2];
#pragma unroll
    for (int a = 0; a < 2; ++a)
#pragma unroll
        for (int b = 0; b < 2; ++b)
#pragma unroll
            for (int m = 0; m < 4; ++m)
#pragma unroll
                for (int n = 0; n < 2; ++n) acc[a][b][m][n] = (f32x4){0.f, 0.f, 0.f, 0.f};
    bf16x8 At[4][2], B0[2][2], B1[2][2]; i32x8 At8[4], B08[2], B18[2];
    {
        const char* cA = cur.a; const char* cB = cur.b0; const char* cB1 = G_BP(cur, 1);
        G_STAGE_B(G_SB(0, 0), cB); G_STAGE_B(G_SB(0, 1), cB + hstepB); G_STAGE_A(G_SA(0, 0), cA, offA, 0); G_STAGE_A(G_SA(0, 1), cA, offA, 1);
        if (wr == 1) G_BAR;
        G_WAIT_V(2); G_BAR;
        G_STAGE_B(G_SB(1, 0), cB1); G_STAGE_A(G_SA(1, 0), cA + kstep, offA, 0); G_STAGE_B(G_SB(1, 1), cB1 + hstepB);
        G_WAIT_V(6); G_BAR;
    }
    for (;;) {
        const bool has_next = S.next(ui + 1, nxt);
#if defined(EPI_PREFETCH)
        E.prefetch(cur, wr, wc, lane, (LAS unsigned*)(lds + JUNK_OFF + wid * 256));
#endif
        TP_BEGIN(100 + PH * 10);
#pragma nounroll
        for (int t = 0; t < NTT; t += 2) {
            const bool last = (t == NTT - 2);
            if constexpr (MID) { if (t == NTT / 2) { TP_BEGIN(102 + PH * 10); E.mid(acc, cur, wr, wc, fr, fq); TP_END(102 + PH * 10); } }
            if constexpr (GATHER) { if (t == NTT - 4 && has_next) S.offs(nxt, Rr, Cc, offAn); }
            const char* a1 = cur.a + (size_t)(t + 1) * kstep;
            const bool sw = last && has_next;
            const int t2 = last ? 0 : t + 2;
            const char* ua = sw ? nxt.a : cur.a; const char* ub0 = sw ? nxt.b0 : cur.b0; const char* ub1 = sw ? nxt.b1 : cur.b1;
            const char* a2 = ua + (size_t)t2 * kstep; const char* a3 = a2 + kstep;
            const char* b2 = (t2 < KS) ? ub0 + (size_t)t2 * kstep : ub1 + (size_t)(t2 - KS) * kstep;
            const char* b3 = (t2 + 1 < KS) ? ub0 + (size_t)(t2 + 1) * kstep : ub1 + (size_t)(t2 + 1 - KS) * kstep;
            G_LDB(B0, 0, 0); G_LDB(B1, 0, 1); G_SCHED; G_LDA(At, 0, 0); G_STAGE_A(G_SA(1, 1), a1, offA, 1);
            G_WAIT_V(8); G_WAIT_L(0); G_BAR; G_MMA(0, 0, At, B0); G_MMA(0, 1, At, B1); G_BAR; G_SCHED;
            if constexpr (GATHER) { if (sw) {
#pragma unroll
                for (int h = 0; h < 2; ++h)
#pragma unroll
                    for (int i = 0; i < 2; ++i) offA[h][i] = offAn[h][i]; } }
            G_LDA(At, 0, 1); G_STAGE_B(G_SB(0, 0), b2); G_STAGE_B(G_SB(0, 1), b2 + hstepB); G_STAGE_A(G_SA(0, 0), a2, offA, 0);
            G_WAIT_V(8); G_WAIT_L(0); G_BAR; if (F8 || !cur.half) { G_MMA(1, 0, At, B0); G_MMA(1, 1, At, B1); } G_BAR; G_SCHED;
            G_LDB(B0, 1, 0); G_LDB(B1, 1, 1); G_SCHED; G_LDA(At, 1, 0); G_STAGE_A(G_SA(0, 1), a2, offA, 1);
            G_WAIT_V(8); G_WAIT_L(0); G_BAR; G_MMA(0, 0, At, B0); G_MMA(0, 1, At, B1); G_BAR; G_SCHED;
            G_LDA(At, 1, 1); G_STAGE_B(G_SB(1, 0), b3); G_STAGE_B(G_SB(1, 1), b3 + hstepB); G_STAGE_A(G_SA(1, 0), a3, offA, 0);
            G_WAIT_V(8); G_WAIT_L(0); G_BAR; if (F8 || !cur.half) { G_MMA(1, 0, At, B0); G_MMA(1, 1, At, B1); } G_BAR; G_SCHED;
        }
        TP_END(100 + PH * 10); TP_BEGIN(101 + PH * 10);
        if (wr == 0) G_BAR;
        E(acc, cur, wr, wc, fr, fq);
        TP_END(101 + PH * 10);
        if (!has_next) break;
#pragma unroll
        for (int a = 0; a < 2; ++a)
#pragma unroll
            for (int b = 0; b < 2; ++b)
#pragma unroll
                for (int m = 0; m < 4; ++m)
#pragma unroll
                    for (int n = 0; n < 2; ++n) acc[a][b][m][n] = (f32x4){0.f, 0.f, 0.f, 0.f};
        cur = nxt; ++ui;
        if (wr == 1) G_BAR;
    }
    G_WAIT_V(0);
    G_BAR;
#undef G_SA
#undef G_SB
#undef G_STAGE_A
#undef G_STAGE_B
#undef G_LDA
#undef G_LDB
#undef G_MMA
#undef G_CAT2
#undef G_LD16
#undef G_WAIT_V
#undef G_WAIT_L
#undef G_BAR
#undef G_SCHED
#undef G_BP
}

__device__ __forceinline__ void st8(bf16_t* p, f32x4 v0, f32x4 v1) { u32x4 w; w.x = cvt_pk_bf16(v0[0], v0[1]); w.y = cvt_pk_bf16(v0[2], v0[3]); w.z = cvt_pk_bf16(v1[0], v1[1]); w.w = cvt_pk_bf16(v1[2], v1[3]); *(u32x4*)p = w; }
__device__ __forceinline__ float sigm(float z) { return __builtin_amdgcn_rcpf(1.0f + __builtin_amdgcn_exp2f(-z * LOG2E)); }

__device__ __forceinline__ void touch(const void* p, LAS unsigned* junk) { __builtin_amdgcn_global_load_lds((const unsigned*)p, junk, 4, 0, 0); }

struct EpiProj {
    static constexpr bool PERM = true;
    __device__ __forceinline__ void prefetch(const Unit&, int, int, int, LAS unsigned*) const {}
    bf16_t *U, *Q, *K, *V, *GP, *GA; const float *gq, *gk;
    __device__ __forceinline__ void mid(f32x4 (&)[2][2][4][2], const Unit&, int, int, int, int) const {}
    __device__ __forceinline__ void operator()(const f32x4 (&acc)[2][2][4][2], const Unit& u, int wr, int wc, int fr, int fq) const {
        const int pn = u.pn; const int row0 = u.pm * BM + wr * 64 + fr;
        if (pn < 2) {
            const int col0 = (pn & 1) * 256 + wc * 32 + 8 * fq;
#pragma unroll
            for (int ai = 0; ai < 2; ++ai)
#pragma unroll
                for (int m = 0; m < 4; ++m) { bf16_t* rowp = U + (size_t)(row0 + ai * HALF + m * 16) * 512 + col0;
#pragma unroll
                    for (int bj = 0; bj < 2; ++bj) st8(rowp + bj * HALF, acc[ai][bj][m][0], acc[ai][bj][m][1]); }
        } else if (pn == 6 || pn == 7) {
#pragma unroll
            for (int ai = 0; ai < 2; ++ai)
#pragma unroll
                for (int m = 0; m < 4; ++m) { const int row = row0 + ai * HALF + m * 16, b = row >> 11, t = row & 2047;
#pragma unroll
                    for (int bj = 0; bj < 2; ++bj) { const int bh = b * 4 + 2 * (pn - 6) + bj;
                        st8(V + ((((size_t)bh * 32 + (t >> 6)) * 16 + (wc * 4 + ((t >> 4) & 3))) * 16 + (t & 15)) * 32 + 8 * fq, acc[ai][bj][m][0], acc[ai][bj][m][1]); } }
        } else if (pn < 6) {
            const bool isq = pn < 4; bf16_t* base = isq ? Q : K; const float* g = isq ? gq : gk; const float sc = isq ? (0.125f * LOG2E) : 1.0f;
            f32x4 gv[2][2];
#pragma unroll
            for (int bj = 0; bj < 2; ++bj) { gv[bj][0] = *(const f32x4*)(g + 32 * bj + 8 * fq); gv[bj][1] = *(const f32x4*)(g + 32 * bj + 8 * fq + 4); }
            const int col0 = (pn & 1) * 256 + 64 * wc + 8 * fq;
#pragma unroll
            for (int ai = 0; ai < 2; ++ai)
#pragma unroll
                for (int m = 0; m < 4; ++m) {
                    float ss = 0.f;
#pragma unroll
                    for (int bj = 0; bj < 2; ++bj)
#pragma unroll
                        for (int n = 0; n < 2; ++n) { const f32x4 x = acc[ai][bj][m][n]; ss += (x[0] * x[0] + x[1] * x[1]) + (x[2] * x[2] + x[3] * x[3]); }
                    ss += __shfl_xor(ss, 16); ss += __shfl_xor(ss, 32);
                    const float rinv = __builtin_amdgcn_rsqf(ss * (1.0f / 64.0f) + EPS) * sc;
                    const int row = row0 + ai * HALF + m * 16;
                    if (isq) { bf16_t* rowp = base + (size_t)row * 512 + col0;
#pragma unroll
                        for (int bj = 0; bj < 2; ++bj) st8(rowp + 32 * bj, acc[ai][bj][m][0] * rinv * gv[bj][0], acc[ai][bj][m][1] * rinv * gv[bj][1]);
                    } else {
                        const int b = row >> 11, t = row & 2047, sh = (pn - 4) * 4 + wc, bh = b * 4 + (sh >> 1), mm = sh & 1;
#pragma unroll
                        for (int bj = 0; bj < 2; ++bj) st8(base + (((((size_t)bh * 2 + mm) * 32 + (t >> 6)) * 8 + (4 * bj + fq)) * 64 + (t & 63)) * 8, acc[ai][bj][m][0] * rinv * gv[bj][0], acc[ai][bj][m][1] * rinv * gv[bj][1]);
                    }
                }
        } else {
            const int col0 = (pn - 8) * 128 + wc * 32 + 8 * fq;
#pragma unroll
            for (int ai = 0; ai < 2; ++ai)
#pragma unroll
                for (int m = 0; m < 4; ++m) { const size_t off = (size_t)(row0 + ai * HALF + m * 16) * 1024 + col0;
                    f32x4 r0, r1, a0, a1;
#pragma unroll
                    for (int i = 0; i < 4; ++i) {
                        const float ea0 = __builtin_amdgcn_exp2f(-acc[ai][1][m][0][i] * LOG2E), ea1 = __builtin_amdgcn_exp2f(-acc[ai][1][m][1][i] * LOG2E);
                        a0[i] = __builtin_amdgcn_rcpf(1.0f + ea0); a1[i] = __builtin_amdgcn_rcpf(1.0f + ea1);
                        r0[i] = sigm(acc[ai][0][m][0][i]) * (1.0f + ea0); r1[i] = sigm(acc[ai][0][m][1][i]) * (1.0f + ea1); }
                    st8(GP + off, r0, r1); st8(GA + off, a0, a1); }
        }
    }
};

struct EpiMerge {
    static constexpr bool PERM = true;
    const bf16_t *GP, *GA; bf16_t* O;
    __device__ __forceinline__ void prefetch(const Unit& u, int wr, int wc, int lane, LAS unsigned* junk) const {
#pragma unroll
        for (int q = 0; q < 4; ++q) { const int idx = q * 64 + lane, ri = idx >> 1, bj = idx & 1; const int row = u.pm * BM + 128 * (ri >> 6) + 64 * wr + (ri & 63);
            const size_t off = (size_t)row * 1024 + u.pn * BM + wc * 32 + bj * HALF; touch(GP + off, junk); touch(GA + off, junk); }
    }
    __device__ __forceinline__ void mid(f32x4 (&acc)[2][2][4][2], const Unit& u, int wr, int wc, int fr, int fq) const {
        int row0 = u.pm * BM + wr * 64 + fr; const int col0 = u.pn * BM + wc * 32 + 8 * fq;
        asm volatile("" : "+v"(row0));
#pragma unroll
        for (int ai = 0; ai < 2; ++ai) {
            u32x4 pv[4][2];
#pragma unroll
            for (int m = 0; m < 4; ++m) { const size_t off = (size_t)(row0 + ai * HALF + m * 16) * 1024 + col0;
#pragma unroll
                for (int bj = 0; bj < 2; ++bj) pv[m][bj] = *(const u32x4*)(GP + off + bj * HALF); }
#pragma unroll
            for (int m = 0; m < 4; ++m)
#pragma unroll
                for (int bj = 0; bj < 2; ++bj) { const u32x4 p = pv[m][bj];
                    const f32x4 r0 = {bflo(p.x), bfhi(p.x), bflo(p.y), bfhi(p.y)}, r1 = {bflo(p.z), bfhi(p.z), bflo(p.w), bfhi(p.w)};
                    acc[ai][bj][m][0] *= r0; acc[ai][bj][m][1] *= r1; }
            asm volatile("" ::: "memory");
        }
    }
    __device__ __forceinline__ void operator()(const f32x4 (&acc)[2][2][4][2], const Unit& u, int wr, int wc, int fr, int fq) const {
        const int row0 = u.pm * BM + wr * 64 + fr, col0 = u.pn * BM + wc * 32 + 8 * fq;
#pragma unroll
        for (int ai = 0; ai < 2; ++ai) {
            u32x4 av[4][2];
#pragma unroll
            for (int m = 0; m < 4; ++m)
#pragma unroll
                for (int bj = 0; bj < 2; ++bj) av[m][bj] = *(const u32x4*)(GA + (size_t)(row0 + ai * HALF + m * 16) * 1024 + col0 + bj * HALF);
#pragma unroll
            for (int m = 0; m < 4; ++m)
#pragma unroll
                for (int bj = 0; bj < 2; ++bj) { const u32x4 a = av[m][bj];
                    const f32x4 g0 = {bflo(a.x), bfhi(a.x), bflo(a.y), bfhi(a.y)}, g1 = {bflo(a.z), bfhi(a.z), bflo(a.w), bfhi(a.w)};
                    st8(O + (size_t)(row0 + ai * HALF + m * 16) * 1024 + col0 + bj * HALF, acc[ai][bj][m][0] * g0, acc[ai][bj][m][1] * g1); }
            asm volatile("" ::: "memory");
        }
    }
};

struct EpiRes {
    static constexpr bool PERM = true;
    const float* X; bf16_t* O;
    __device__ __forceinline__ void prefetch(const Unit& u, int wr, int wc, int lane, LAS unsigned* junk) const {
#pragma unroll
        for (int q = 0; q < 4; ++q) { const int idx = q * 64 + lane, ri = idx >> 1, bj = idx & 1; const int row = u.pm * BM + 128 * (ri >> 6) + 64 * wr + (ri & 63);
            touch(X + (size_t)row * 1024 + u.pn * BM + wc * 32 + bj * HALF, junk); }
    }
    __device__ __forceinline__ void mid(f32x4 (&)[2][2][4][2], const Unit&, int, int, int, int) const {}
    __device__ __forceinline__ void operator()(const f32x4 (&acc)[2][2][4][2], const Unit& u, int wr, int wc, int fr, int fq) const {
        const int row0 = u.pm * BM + wr * 64 + fr, col0 = u.pn * BM + wc * 32 + 8 * fq;
#pragma unroll
        for (int ai = 0; ai < 2; ++ai) {
            f32x4 xv[4][2][2];
#pragma unroll
            for (int m = 0; m < 4; ++m)
#pragma unroll
                for (int bj = 0; bj < 2; ++bj) { const float* xp = X + (size_t)(row0 + ai * HALF + m * 16) * 1024 + col0 + bj * HALF; xv[m][bj][0] = *(const f32x4*)xp; xv[m][bj][1] = *(const f32x4*)(xp + 4); }
#pragma unroll
            for (int m = 0; m < 4; ++m)
#pragma unroll
                for (int bj = 0; bj < 2; ++bj) st8(O + (size_t)(row0 + ai * HALF + m * 16) * 1024 + col0 + bj * HALF, xv[m][bj][0] + acc[ai][bj][m][0], xv[m][bj][1] + acc[ai][bj][m][1]);
            asm volatile("" ::: "memory");
        }
    }
};

struct EpiMoe1 {
    static constexpr bool PERM = true;
    __device__ __forceinline__ void prefetch(const Unit&, int, int, int, LAS unsigned*) const {}
    const float *SR, *SWLO, *SWHI; bf16_t* HDN;
    __device__ __forceinline__ void mid(f32x4 (&)[2][2][4][2], const Unit&, int, int, int, int) const {}
    __device__ __forceinline__ void operator()(const f32x4 (&acc)[2][2][4][2], const Unit& u, int wr, int wc, int fr, int fq) const {
        const int slot0 = u.pm * BM + wr * 64 + fr; const float* SW = (u.pn < 4) ? SWLO : SWHI;
        const int col0 = (u.pn >> 2) * 512 + (u.pn & 3) * 128 + wc * 32 + 8 * fq;
        float rsv[2][4], wv[2][4];
#pragma unroll
        for (int ai = 0; ai < 2; ++ai)
#pragma unroll
            for (int m = 0; m < 4; ++m) { rsv[ai][m] = SR[slot0 + ai * HALF + m * 16]; wv[ai][m] = SW[slot0 + ai * HALF + m * 16]; }
#pragma unroll
        for (int ai = 0; ai < 2; ++ai) { if (ai == 1 && u.half) break;
#pragma unroll
            for (int m = 0; m < 4; ++m) { const int slot = slot0 + ai * HALF + m * 16; const float rs = rsv[ai][m] * (1.0f / F8_WSCALE), w = wv[ai][m];
                f32x4 h0, h1;
#pragma unroll
                for (int i = 0; i < 4; ++i) { const float g0 = acc[ai][0][m][0][i] * rs, u0 = acc[ai][1][m][0][i] * rs, g1 = acc[ai][0][m][1][i] * rs, u1 = acc[ai][1][m][1][i] * rs;
                    h0[i] = g0 * sigm(g0) * u0 * w; h1[i] = g1 * sigm(g1) * u1 * w; }
                st8(HDN + (size_t)slot * 1024 + col0, h0, h1); } }
    }
};

struct EpiMoe2 {
    static constexpr bool PERM = true;
    const int* STOK; const bf16_t* X1; float* O;
    __device__ __forceinline__ void prefetch(const Unit& u, int wr, int wc, int lane, LAS unsigned* junk) const {
#pragma unroll
        for (int q = 0; q < 4; ++q) { const int idx = q * 64 + lane, ri = idx >> 1, bj = idx & 1; int tok = STOK[u.pm * BM + 128 * (ri >> 6) + 64 * wr + (ri & 63)]; tok = tok < 0 ? 0 : tok;
            touch(X1 + (size_t)tok * 1024 + u.pn * BM + wc * 32 + bj * HALF, junk); }
    }
    __device__ __forceinline__ void mid(f32x4 (&)[2][2][4][2], const Unit&, int, int, int, int) const {}
    __device__ __forceinline__ void operator()(const f32x4 (&acc)[2][2][4][2], const Unit& u, int wr, int wc, int fr, int fq) const {
        int fr_ = fr, fq_ = fq; asm volatile("" : "+v"(fr_), "+v"(fq_));
        const int slot0 = u.pm * BM + wr * 64 + fr_, col0 = u.pn * BM + wc * 32 + 8 * fq_;
        int tk[2][4];
#pragma unroll
        for (int ai = 0; ai < 2; ++ai)
#pragma unroll
            for (int m = 0; m < 4; ++m) tk[ai][m] = STOK[slot0 + ai * HALF + m * 16];
#pragma unroll
        for (int ai = 0; ai < 2; ++ai) { if (ai == 1 && u.half) break;
#pragma unroll
            for (int mp = 0; mp < 2; ++mp) {
                u32x4 xv[2][2];
#pragma unroll
                for (int mi = 0; mi < 2; ++mi) { const int m = mp * 2 + mi; const int tok = tk[ai][m] < 0 ? 0 : tk[ai][m];
#pragma unroll
                    for (int bj = 0; bj < 2; ++bj) xv[mi][bj] = *(const u32x4*)(X1 + (size_t)tok * 1024 + col0 + bj * HALF); }
#pragma unroll
                for (int mi = 0; mi < 2; ++mi) { const int m = mp * 2 + mi; const int tok = tk[ai][m];
                    if (tok >= 0) { const size_t off = (size_t)tok * 1024 + col0;
#pragma unroll
                        for (int bj = 0; bj < 2; ++bj) { const u32x4 x = xv[mi][bj];
                            const f32x4 x0 = {bflo(x.x), bfhi(x.x), bflo(x.y), bfhi(x.y)}, x1 = {bflo(x.z), bfhi(x.z), bflo(x.w), bfhi(x.w)};
                            constexpr float SC = 1.0f;
                            *(f32x4*)(O + off + bj * HALF) = x0 + acc[ai][bj][m][0] * SC; *(f32x4*)(O + off + bj * HALF + 4) = x1 + acc[ai][bj][m][1] * SC; } } }
                asm volatile("" ::: "memory");
            }
        }
    }
};

struct MoeSched {
    const LAS int* tab; const char* A; const char* B; const int* STOK; int mode;
    __device__ __forceinline__ bool next(int i, Unit& u) const {
        if (i >= 16) return false;
        const int tile = __builtin_amdgcn_readfirstlane(tab[i * 8 + 0]); if (tile < 0) return false;
        const int pn = __builtin_amdgcn_readfirstlane(tab[i * 8 + 1]), e0 = __builtin_amdgcn_readfirstlane(tab[i * 8 + 2]), e1 = __builtin_amdgcn_readfirstlane(tab[i * 8 + 3]);
        u.pm = tile; u.pn = pn; u.e0 = e0; u.e1 = e1; u.half = __builtin_amdgcn_readfirstlane(tab[i * 8 + 4]);
        if (mode == 1) { const int e = (pn < 4) ? e0 : e1; u.a = A; u.b0 = B + ((size_t)e * 1024 * 1024 + (size_t)(pn & 3) * 256 * 1024); u.b1 = u.b0; }
        else { u.a = A + (size_t)tile * 256 * 1024 * 2; u.b0 = B + ((size_t)e0 * 1024 + (size_t)pn * 256) * 512 * 2; u.b1 = B + ((size_t)e1 * 1024 + (size_t)pn * 256) * 512 * 2; }
        return true;
    }
    __device__ __forceinline__ void offs(const Unit& u, const int (&Rr)[2], const int (&Cc)[2], unsigned (&off)[2][2]) const {
#pragma unroll
        for (int h = 0; h < 2; ++h)
#pragma unroll
            for (int i = 0; i < 2; ++i) { int tok = STOK[u.pm * 256 + h * 128 + Rr[i]]; tok = tok < 0 ? 0 : tok; off[h][i] = (unsigned)tok * 1024u + (unsigned)Cc[i] * 2u; }
    }
};
}

namespace att {
__device__ __forceinline__ int crow(int r, int hi) { return (r & 3) + 8 * (r >> 2) + 4 * hi; }
__device__ __forceinline__ void glds16(const void* gsrc, unsigned lds_dst) { unsigned keep;
    asm volatile("s_mov_b32 %0, m0\n\ts_mov_b32 m0, %2\n\ts_nop 0\n\tglobal_load_lds_dwordx4 %1, off\n\ts_mov_b32 m0, %0" : "=&s"(keep) : "v"(gsrc), "s"(lds_dst) : "memory"); }
typedef __attribute__((address_space(3))) const char* lds_cptr;
typedef short v4i16_t __attribute__((ext_vector_type(4)));
__device__ __forceinline__ s16x4 vtr(lds_cptr p) { return __builtin_bit_cast(s16x4, __builtin_amdgcn_ds_read_tr16_b64_v4i16((__attribute__((address_space(3))) v4i16_t*)p)); }
#define ATT_WAIT_BAR() asm volatile("s_waitcnt vmcnt(0) lgkmcnt(0)\n\ts_barrier" ::: "memory")
constexpr int SLOT = 32768;
constexpr int WSF_OFF = LDSCTL_OFF + 2048;
constexpr int XCH_OFF = 0;

__device__ __forceinline__ void attn_unit(int b, int h, int qb, const bf16_t* Q, const bf16_t* K, const bf16_t* V, bf16_t* DO, char* shm, float B2, float lam, const float* subg TP_PARAMS) {
    TP_BEGIN(25);
    const int tid = threadIdx.x, lane = tid & 63, r32 = lane & 31, hi = lane >> 5; const int wid = __builtin_amdgcn_readfirstlane(tid >> 6);
    const int mm = wid >> 2, wq = wid & 3;
    const long rowbase = (long)b * SEQ; const int q0 = qb * 128, i0 = q0 + wq * 32;
    const float aslope = LOG2E * __builtin_amdgcn_exp2f(-2.0f * (float)(h + 1));
    const unsigned lds0 = (unsigned)(uintptr_t)shm; const lds_cptr shm3 = (lds_cptr)shm;
    float* wsf = (float*)(shm + WSF_OFF) + wid * 64;
    const bf16_t* Qw = Q + (rowbase + i0 + r32) * 512 + h * 128 + mm * 64 + hi * 8;
    bf16x8 qr[4];
#pragma unroll
    for (int ks = 0; ks < 4; ++ks) qr[ks] = *(const bf16x8*)(Qw + ks * 16);
    const int bh = b * 4 + h;
    const bf16_t* ksrc0 = K + (((size_t)bh * 2 + 0) * 32 * 8 + wid) * 512 + lane * 8;
    const bf16_t* ksrc1 = K + (((size_t)bh * 2 + 1) * 32 * 8 + wid) * 512 + lane * 8;
    const int p0i = 2 * wid, p1i = 2 * wid + 1;
    const bf16_t* vsrc0 = V + ((size_t)bh * 32 * 16 + p0i) * 512 + lane * 8;
    const bf16_t* vsrc1 = vsrc0 + 512;
    const int NTL = 2 * qb + 2;
    int ts; { const int Dk = (int)((2.0f * B2 + 30.2f) / aslope) + 1; ts = q0 - Dk; ts = ts < 0 ? 0 : (ts >> 6); }
#define ATT_DMA(t, slot) do { const unsigned _s = lds0 + (unsigned)(slot) * SLOT; \
        glds16(ksrc0 + (size_t)(t) * 4096, (unsigned)__builtin_amdgcn_readfirstlane(_s + wid * 1024)); glds16(ksrc1 + (size_t)(t) * 4096, (unsigned)__builtin_amdgcn_readfirstlane(_s + 8192 + wid * 1024)); \
        glds16(vsrc0 + (size_t)(t) * 8192, (unsigned)__builtin_amdgcn_readfirstlane(_s + 16384 + p0i * 1024)); glds16(vsrc1 + (size_t)(t) * 8192, (unsigned)__builtin_amdgcn_readfirstlane(_s + 16384 + p1i * 1024)); } while (0)
    ATT_DMA(ts, ts & 3); ATT_DMA(ts + 1, (ts + 1) & 3);
#if defined(ATT_PRIO_YOUNG)
    if (wid >= 4) __builtin_amdgcn_s_setprio(1);
#endif
    f32x16 o[4]; o[0] = f32x16{}; o[1] = f32x16{}; o[2] = f32x16{}; o[3] = f32x16{};
    float l_reg = 0.f;
    const int irow = i0 + r32;
    u32x4 qbias, kbias0, kbias1;
    { const float a_h = bf2f((unsigned short)f2bf(aslope)), r1 = aslope - a_h, a_m = bf2f((unsigned short)f2bf(r1)), a_l = bf2f((unsigned short)f2bf(r1 - a_m));
      const unsigned j0b = f2bf((float)r32), j1b = f2bf((float)(r32 + 32));
      qbias  = hi ? (u32x4){0u, 0u, 0u, 0u} : (u32x4){f2bf(a_h) | (f2bf(a_m) << 16), f2bf(a_l), 0u, 0u};
      kbias0 = hi ? (u32x4){0u, 0u, 0u, 0u} : (u32x4){j0b | (j0b << 16), j0b, 0u, 0u};
      kbias1 = hi ? (u32x4){0u, 0u, 0u, 0u} : (u32x4){j1b | (j1b << 16), j1b, 0u, 0u}; }
    __builtin_amdgcn_s_waitcnt(0x0F70);
    TP_END(25);
    const int vlane = ((lane >> 4) & 1) * 32 + (lane & 3) * 8 + (4 * hi + ((lane & 15) >> 2)) * 64;
    f32x16 cini; { const float c0 = aslope * (float)(64 * ts - irow) - B2; _Pragma("unroll") for (int r = 0; r < 16; ++r) cini[r] = c0; }
    const float cstep = 64.0f * aslope;
#define ATT_VRD(g) vtr(vp + ((g) >> 2) * 4096 + ((g) & 3) * 1024), vtr(vp + ((g) >> 2) * 4096 + ((g) & 3) * 1024 + 512)
#define ATT_PV(SL) do { const lds_cptr vp = shm3 + (SL) * SLOT + 16384 + vlane; \
        s16x4 vf[2][2]; \
        { const s16x4 a0[2] = {ATT_VRD(0)}, a1[2] = {ATT_VRD(1)}; vf[0][0] = a0[0]; vf[0][1] = a0[1]; vf[1][0] = a1[0]; vf[1][1] = a1[1]; } \
        __builtin_amdgcn_sched_barrier(0); \
        _Pragma("unroll") for (int g = 0; g < 16; ++g) {            \
            const s16x4 lo = vf[g & 1][0], hh = vf[g & 1][1]; \
            const bf16x8 vfr = (bf16x8){lo[0], lo[1], lo[2], lo[3], hh[0], hh[1], hh[2], hh[3]}; \
            o[g >> 2] = __builtin_amdgcn_mfma_f32_32x32x16_bf16(__builtin_bit_cast(bf16x8, pw[g & 3]), vfr, o[g >> 2], 0, 0, 0); \
            if (g + 2 < 16) { const s16x4 a3[2] = {ATT_VRD(g + 2)}; vf[g & 1][0] = a3[0]; vf[g & 1][1] = a3[1]; } \
            __builtin_amdgcn_sched_barrier(0); } \
        } while (0)
#define ATT_TILE(MASKED) do { \
        TP_BEGIN(21); \
        if (t + 1 < NTL) asm volatile("s_waitcnt vmcnt(4) lgkmcnt(0)\n\ts_barrier" ::: "memory"); else ATT_WAIT_BAR(); \
        TP_END(21); TP_BEGIN(22); \
        if (t + 2 < NTL) ATT_DMA(t + 2, (t + 2) & 3); \
        TP_END(22); TP_BEGIN(23); \
        const int j0 = 64 * t; \
        if (!(MASKED) || j0 <= i0 + 31) { \
            const char* kb = shm + (t & 3) * SLOT + mm * 8192 + hi * 1024 + r32 * 16; \
            bf16x8 kf[2]; kf[0] = *(const bf16x8*)(kb); kf[1] = *(const bf16x8*)(kb + 512);     \
            __builtin_amdgcn_sched_barrier(0); \
            f32x16 p0 = __builtin_amdgcn_mfma_f32_32x32x16_bf16(__builtin_bit_cast(bf16x8, kbias0), __builtin_bit_cast(bf16x8, qbias), cini, 0, 0, 0); \
            f32x16 p1 = __builtin_amdgcn_mfma_f32_32x32x16_bf16(__builtin_bit_cast(bf16x8, kbias1), __builtin_bit_cast(bf16x8, qbias), cini, 0, 0, 0); \
            __builtin_amdgcn_sched_barrier(0); \
            _Pragma("unroll") for (int f = 0; f < 8; ++f) { \
                if (f & 1) p1 = __builtin_amdgcn_mfma_f32_32x32x16_bf16(kf[1], qr[f >> 1], p1, 0, 0, 0); else p0 = __builtin_amdgcn_mfma_f32_32x32x16_bf16(kf[0], qr[f >> 1], p0, 0, 0, 0); \
                if (f + 2 < 8) kf[f & 1] = *(const bf16x8*)(kb + ((f + 2) >> 1) * 2048 + (f & 1) * 512); \
                __builtin_amdgcn_sched_barrier(0); } \
            if (MASKED) { const int jb = j0 + 4 * hi; \
                _Pragma("unroll") for (int r = 0; r < 16; ++r) { const int j = jb + (r & 3) + 8 * (r >> 2); if (j > irow) p0[r] = -1.0e30f; if (j + 32 > irow) p1[r] = -1.0e30f; } } \
            float sacc = 0.f; \
            _Pragma("unroll") for (int r = 0; r < 16; ++r) { p0[r] = __builtin_amdgcn_exp2f(p0[r]); p1[r] = __builtin_amdgcn_exp2f(p1[r]); sacc += p0[r] + p1[r]; } \
            l_reg += sacc; \
            u32x4 pw[4]; \
            pw[0] = (u32x4){cvt_pk_bf16(p0[0], p0[1]), cvt_pk_bf16(p0[2], p0[3]), cvt_pk_bf16(p0[4], p0[5]), cvt_pk_bf16(p0[6], p0[7])}; \
            pw[1] = (u32x4){cvt_pk_bf16(p0[8], p0[9]), cvt_pk_bf16(p0[10], p0[11]), cvt_pk_bf16(p0[12], p0[13]), cvt_pk_bf16(p0[14], p0[15])}; \
            pw[2] = (u32x4){cvt_pk_bf16(p1[0], p1[1]), cvt_pk_bf16(p1[2], p1[3]), cvt_pk_bf16(p1[4], p1[5]), cvt_pk_bf16(p1[6], p1[7])}; \
            pw[3] = (u32x4){cvt_pk_bf16(p1[8], p1[9]), cvt_pk_bf16(p1[10], p1[11]), cvt_pk_bf16(p1[12], p1[13]), cvt_pk_bf16(p1[14], p1[15])}; \
            TP_END(23); TP_BEGIN(24); \
            ATT_PV(t & 3); \
            TP_END(24); TP_BEGIN(23); \
        } TP_END(23); \
        _Pragma("unroll") for (int r = 0; r < 16; ++r) cini[r] += cstep; } while (0)
    int t = ts;
    for (; t < NTL - 2; ++t) ATT_TILE(false);
    for (; t < NTL; ++t) ATT_TILE(true);
#undef ATT_PV
#undef ATT_VRD
    TP_BEGIN(26);
#undef ATT_TILE
    { auto rr = __builtin_amdgcn_permlane32_swap(__float_as_uint(l_reg), __float_as_uint(l_reg), false, false); l_reg = __uint_as_float(rr[0]) + __uint_as_float(rr[1]); }
    if (hi == 0) wsf[r32] = l_reg;
    asm volatile("s_waitcnt lgkmcnt(0)" ::: "memory");
    const float fac = (mm == 0) ? 1.0f : lam;
#pragma unroll
    for (int r = 0; r < 16; ++r) { const float rl = fac * __builtin_amdgcn_rcpf(wsf[crow(r, hi)]);
#pragma unroll
        for (int d0 = 0; d0 < 4; ++d0) o[d0][r] *= rl; }
    TP_BEGIN(27);
    ATT_WAIT_BAR();
    TP_END(27); TP_BEGIN(28);
    float* xs = (float*)(shm + XCH_OFF) + (size_t)(wq * 2 + mm) * 16 * 128;
    const float* xr = (const float*)(shm + XCH_OFF) + (size_t)(wq * 2 + (mm ^ 1)) * 16 * 128;
    const int rs0 = mm ? 0 : 8, rk0 = mm ? 8 : 0;
#pragma unroll
    for (int rr = 0; rr < 8; ++rr)
#pragma unroll
        for (int d0 = 0; d0 < 4; ++d0) { const int r = rr + 8; const float vs = mm ? o[d0][rr] : o[d0][r];
            xs[(crow(rr, hi)) * 128 + 32 * d0 + r32] = vs; }
    ATT_WAIT_BAR();
    bf16_t* stg = (bf16_t*)(shm + 65536);
    { float gsub[4];
#pragma unroll
      for (int d0 = 0; d0 < 4; ++d0) gsub[d0] = subg[32 * d0 + r32] * 0.8f;
#pragma unroll
      for (int rr = 0; rr < 8; ++rr) {
          float ov[4], ss = 0.f;
#pragma unroll
          for (int d0 = 0; d0 < 4; ++d0) { const float other = xr[crow(rr, hi) * 128 + 32 * d0 + r32]; const float mine = mm ? o[d0][rr + 8] : o[d0][rr];
              ov[d0] = mm ? (other - mine) : (mine - other); ss += ov[d0] * ov[d0]; }
          ss += __shfl_xor(ss, 1); ss += __shfl_xor(ss, 2); ss += __shfl_xor(ss, 4); ss += __shfl_xor(ss, 8); ss += __shfl_xor(ss, 16);
          const float rinv = __builtin_amdgcn_rsqf(ss * (1.0f / 128.0f) + EPS);
          bf16_t* srow = stg + (wq * 32 + rk0 * 2 + crow(rr, hi)) * 128 + r32;
#pragma unroll
          for (int d0 = 0; d0 < 4; ++d0) srow[32 * d0] = (bf16_t)f2bf(ov[d0] * rinv * gsub[d0]);
      } }
    (void)rs0;
    ATT_WAIT_BAR();
    { const int row = tid >> 2, q4 = tid & 3;
      const bf16_t* sp = stg + row * 128 + q4 * 32; bf16_t* gp = DO + (size_t)(rowbase + q0 + row) * 1024 + 512 + h * 128 + q4 * 32;
      u32x4 v[4];
#pragma unroll
      for (int i = 0; i < 4; ++i) v[i] = *(const u32x4*)(sp + i * 8);
#pragma unroll
      for (int i = 0; i < 4; ++i) *(u32x4*)(gp + i * 8) = v[i]; }
    asm volatile("s_waitcnt lgkmcnt(0)" ::: "memory");
    TP_END(28);
    TP_END(26);
#undef ATT_DMA
}
}

struct Args { const float* in[23]; float* out; unsigned char* ws; };

__device__ __forceinline__ float wave_sum(float v) {
#pragma unroll
    for (int o = 1; o < 64; o <<= 1) v += __shfl_xor(v, o);
    return v;
}
__device__ __forceinline__ float wave_max(float v) {
#pragma unroll
    for (int o = 1; o < 64; o <<= 1) v = fmaxf(v, __shfl_xor(v, o));
    return v;
}

template <class DstF>
__device__ __forceinline__ void transpose_item(const float* W, int N, int k0, int n0, LAS float* scr, int lane, const float* ksc, DstF dst) {
    const int kk = lane >> 3, n4 = (lane & 7) * 4;
    f32x4 v[8];
#pragma unroll
    for (int j = 0; j < 8; ++j) v[j] = *(const f32x4*)(W + (size_t)(k0 + kk + 8 * j) * N + n0 + n4);
#pragma unroll
    for (int j = 0; j < 8; ++j) { LAS float* d = scr + (kk + 8 * j) * 33 + n4; d[0] = v[j][0]; d[1] = v[j][1]; d[2] = v[j][2]; d[3] = v[j][3]; }
    LDS_WAIT(); asm volatile("" ::: "memory");
    const int c = lane & 7;
    f32x4 s0 = {1.f, 1.f, 1.f, 1.f}, s1 = s0;
    if (ksc) { s0 = *(const f32x4*)(ksc + k0 + 8 * c); s1 = *(const f32x4*)(ksc + k0 + 8 * c + 4); }
#pragma unroll
    for (int j = 0; j < 4; ++j) { const int n = (lane >> 3) + 8 * j; const LAS float* s = scr + (8 * c) * 33 + n;
        u32x4 o; o.x = pk2(s[0 * 33] * s0[0], s[1 * 33] * s0[1]); o.y = pk2(s[2 * 33] * s0[2], s[3 * 33] * s0[3]); o.z = pk2(s[4 * 33] * s1[0], s[5 * 33] * s1[1]); o.w = pk2(s[6 * 33] * s1[2], s[7 * 33] * s1[3]);
        *(GAS u32x4*)(dst(n0 + n) + k0 + 8 * c) = o; }
    LDS_WAIT(); asm volatile("" ::: "memory");
}

template <class DstF>
__device__ __forceinline__ void transpose_item_f8(const float* W, int N, int k0, int n0, LAS float* scr, int lane, const float* ksc, float mult, DstF dst8) {
    const int kk = lane >> 3, n4 = (lane & 7) * 4;
    f32x4 v[8];
#pragma unroll
    for (int j = 0; j < 8; ++j) v[j] = *(const f32x4*)(W + (size_t)(k0 + kk + 8 * j) * N + n0 + n4);
#pragma unroll
    for (int j = 0; j < 8; ++j) { LAS float* d = scr + (kk + 8 * j) * 33 + n4; d[0] = v[j][0]; d[1] = v[j][1]; d[2] = v[j][2]; d[3] = v[j][3]; }
    LDS_WAIT(); asm volatile("" ::: "memory");
    const int c = lane & 7;
    f32x4 s0 = {mult, mult, mult, mult}, s1 = s0;
    if (ksc) { s0 = s0 * *(const f32x4*)(ksc + k0 + 8 * c); s1 = s1 * *(const f32x4*)(ksc + k0 + 8 * c + 4); }
#pragma unroll
    for (int j = 0; j < 4; ++j) { const int n = (lane >> 3) + 8 * j; const LAS float* s = scr + (8 * c) * 33 + n;
        u32x2 o; o.x = pk4_f8(s[0 * 33] * s0[0], s[1 * 33] * s0[1], s[2 * 33] * s0[2], s[3 * 33] * s0[3]); o.y = pk4_f8(s[4 * 33] * s1[0], s[5 * 33] * s1[1], s[6 * 33] * s1[2], s[7 * 33] * s1[3]);
        *(GAS u32x2*)(dst8(n0 + n) + k0 + 8 * c) = o; }
    LDS_WAIT(); asm volatile("" ::: "memory");
}

#define PH_BEGIN() unsigned char* ws = args.ws; asm volatile("" : "+s"(ws)); int tid = threadIdx.x; asm volatile("" : "+v"(tid)); \
    const int lane = tid & 63, wave = __builtin_amdgcn_readfirstlane(tid >> 6); const int G = gridDim.x, bx = blockIdx.x; \
    const int vcu = (G % 8 == 0) ? (bx % 8) * (G / 8) + bx / 8 : bx; const int gw = vcu * NWAVES + wave, NGW = G * NWAVES; \
    gu32* ctl = (gu32*)(ws + WS_CTL); (void)lane; (void)wave; (void)gw; (void)NGW; (void)ctl; (void)vcu
#define WSP(T, off) ((T*)(ws + (off)))

#ifndef DEPHASE3
#define DEPHASE3 0
#endif
#ifndef DEPHASE4
#define DEPHASE4 0
#endif
#ifndef DEPHASE8
#define DEPHASE8 0
#endif
__device__ __forceinline__ void dephase(int vcu, unsigned ticks) {
    if ((vcu & 1) && ticks) { const unsigned long long t0 = __builtin_amdgcn_s_memrealtime(); while (__builtin_amdgcn_s_memrealtime() - t0 < ticks) __builtin_amdgcn_s_sleep(16); }
}
__global__ void __launch_bounds__(NWAVES * 64, 2) hybrid_fwd(Args args) {
    extern __shared__ __attribute__((aligned(16))) unsigned char lds[];
    LAS unsigned char* L = (LAS unsigned char*)lds;
    volatile LAS unsigned* MISC = (volatile LAS unsigned*)(L + MISC_OFF);
    for (int u = threadIdx.x; u < (LDS_BYTES - LDSCTL_OFF) / 4; u += NWAVES * 64) ((LAS unsigned*)(L + LDSCTL_OFF))[u] = 0u;
    __syncthreads();
    XcdBarrier bar = xcd_barrier_post((unsigned*)((gu32*)(args.ws + WS_CTL) + CW_BAR), MISC + 8);
    TP_DECL();

    TP_BEGIN(10);
    if (PHASE_MASK & 1) REPS(1) {
        PH_BEGIN();
        bf16_t* WinT = WSP(bf16_t, WS_WIN); bf16_t* WmT = WSP(bf16_t, WS_WM); bf16_t* WoT = WSP(bf16_t, WS_WO); unsigned char* Wgu8 = WSP(unsigned char, WS_WGU); bf16_t* WdT = WSP(bf16_t, WS_WD);
        bf16_t* WrH = WSP(bf16_t, WS_WRH); bf16_t* WrL = WSP(bf16_t, WS_WRL); bf16_t* Hb = WSP(bf16_t, WS_H);
        LAS float* scr = (LAS float*)(L + wave * 16384);
        constexpr int I_IN = 16 * 128, I_AU = 8 * 32, I_OUT = 16 * 32, I_G = 32 * 256, I_U = 32 * 256, I_D = 32 * 256;
        constexpr int NITEMS = I_IN + I_AU + I_OUT + I_G + I_U + I_D;
        TP_BEGIN(30);
        for (int it = gw; it < NITEMS; it += NGW) {
            int r = it;
            if (r < I_IN) { const int kb = r / 128, nb = r % 128;
                transpose_item(args.in[2], 4096, kb * 64, nb * 32, scr, lane, nullptr, [&](int n) -> bf16_t* {
                    int v = n; if (n >= 512 && n < 1536) { const int l = n & 255; v = (n & ~255) + 128 * ((l >> 5) & 1) + 32 * (l >> 6) + (l & 31); }
                    else if (n >= 2048) { const int c = (n - 2048) & 1023; v = 2048 + 256 * (c >> 7) + (c & 127) + ((n >= 3072) ? 128 : 0); }
                    return WinT + (size_t)v * 1024; });
                continue; } r -= I_IN;
            if (r < I_AU) { const int kb = r / 32, nb = r % 32;
                transpose_item(args.in[13], 1024, kb * 64, nb * 32, scr, lane, nullptr, [&](int n) -> bf16_t* { return WmT + (size_t)n * 1024 + 512; }); continue; } r -= I_AU;
            if (r < I_OUT) { const int kb = r / 32, nb = r % 32;
                transpose_item(args.in[14], 1024, kb * 64, nb * 32, scr, lane, nullptr, [&](int n) -> bf16_t* { return WoT + (size_t)n * 1024; }); continue; } r -= I_OUT;
            if (r < I_G) { const int e = r / 256, q = r % 256, kb = q / 16, nb = q % 16;
                transpose_item_f8(args.in[20] + (size_t)e * 1024 * 512, 512, kb * 64, nb * 32, scr, lane, args.in[15], F8_WSCALE, [&](int n) -> unsigned char* { return Wgu8 + (size_t)e * 1024 * 1024 + (size_t)(256 * (n >> 7) + (n & 127)) * 1024; }); continue; } r -= I_G;
            if (r < I_U) { const int e = r / 256, q = r % 256, kb = q / 16, nb = q % 16;
                transpose_item_f8(args.in[21] + (size_t)e * 1024 * 512, 512, kb * 64, nb * 32, scr, lane, args.in[15], F8_WSCALE, [&](int n) -> unsigned char* { return Wgu8 + (size_t)e * 1024 * 1024 + (size_t)(256 * (n >> 7) + 128 + (n & 127)) * 1024; }); continue; } r -= I_U;
            { const int e = r / 256, q = r % 256, kb = q / 32, nb = q % 32;
                transpose_item(args.in[22] + (size_t)e * 512 * 1024, 1024, kb * 64, nb * 32, scr, lane, nullptr, [&](int n) -> bf16_t* { return WdT + ((size_t)e * 1024 + n) * 512; }); }
        }
        TP_END(30); TP_BEGIN(31);
        for (int it = gw; it < 2048; it += NGW) {
            const int kq = it >> 4, nb = it & 15, n = 64 * nb + lane, k = 4 * kq, g = k >> 7, kl = k & 127;
            const float* pw = args.in[3] + (size_t)(g * 128 + kl) * 128; const float* sc = args.in[4] + g * 128; const float* wu = args.in[5] + (size_t)(g * 128) * 1024 + n;
            float a0 = 0.f, a1 = 0.f, a2 = 0.f, a3 = 0.f;
            for (int c0 = 0; c0 < 128; c0 += 16) { float wv[16];
#pragma unroll
                for (int c = 0; c < 16; ++c) wv[c] = wu[(size_t)(c0 + c) * 1024];
#pragma unroll
                for (int c = 0; c < 16; ++c) { const float w2 = wv[c] * sc[c0 + c]; a0 += pw[c0 + c] * w2; a1 += pw[128 + c0 + c] * w2; a2 += pw[256 + c0 + c] * w2; a3 += pw[384 + c0 + c] * w2; } }
            u32x2 o; o.x = pk2(a0, a1); o.y = pk2(a2, a3);
            *(u32x2*)(WmT + (size_t)n * 1024 + k) = o;
        }
        TP_END(31); TP_BEGIN(32);
        for (int it = gw * 64 + lane; it < 48 * 1024; it += NGW * 64) {
            const int n = it >> 10, k = it & 1023; float w = 0.f;
            if (n < 4) w = args.in[16][k * 4 + n]; else if (n < 36) w = args.in[18][k * 32 + (n - 4)];
            w *= args.in[15][k];
            const unsigned hb = f2bf(w); const float lo = w - __builtin_bit_cast(float, hb << 16);
            WrH[it] = (bf16_t)hb; WrL[it] = (bf16_t)f2bf(lo);
        }
        TP_END(32); TP_BEGIN(33);
        { const float* x = args.in[0]; const GAS f32x4* g4 = (const GAS f32x4*)args.in[1] + lane; f32x4 gg[4];
#pragma unroll
          for (int j = 0; j < 4; ++j) gg[j] = g4[64 * j];
          for (int m = gw * 2; m < NTOK; m += NGW * 2) {
            const GAS f32x4* xr = (const GAS f32x4*)(x + (size_t)m * DM) + lane;
            f32x4 v[8]; float s0 = 0.f, s1 = 0.f;
#pragma unroll
            for (int j = 0; j < 8; ++j) v[j] = xr[64 * j];
#pragma unroll
            for (int j = 0; j < 4; ++j) { s0 += (v[j].x * v[j].x + v[j].y * v[j].y) + (v[j].z * v[j].z + v[j].w * v[j].w); s1 += (v[4 + j].x * v[4 + j].x + v[4 + j].y * v[4 + j].y) + (v[4 + j].z * v[4 + j].z + v[4 + j].w * v[4 + j].w); }
            const float r0 = __builtin_amdgcn_rsqf(wave_sum(s0) * (1.f / DM) + EPS), r1 = __builtin_amdgcn_rsqf(wave_sum(s1) * (1.f / DM) + EPS);
            GAS unsigned long long* o8 = (GAS unsigned long long*)(Hb + (size_t)m * DM) + lane;
#pragma unroll
            for (int j = 0; j < 8; ++j) { const f32x4 y = v[j] * (j < 4 ? r0 : r1) * gg[j & 3]; o8[64 * j] = (unsigned long long)pk2(y.x, y.y) | ((unsigned long long)pk2(y.z, y.w) << 32); }
          } }
        TP_END(33);
    }
    xcd_barrier(bar);
    TP_END(10);

    TP_BEGIN(11);
    if (PHASE_MASK & 2) REPS(2) {
        PH_BEGIN();
        gm::StaticOrder S; S.init(WSP(bf16_t, WS_H), WSP(bf16_t, WS_WIN), 1024, 1024, NTOK, 4096, G, bx);
        gm::EpiProj E{WSP(bf16_t, WS_U), WSP(bf16_t, WS_Q), WSP(bf16_t, WS_K), WSP(bf16_t, WS_V), WSP(bf16_t, WS_GP), WSP(bf16_t, WS_GA), args.in[6], args.in[7]};
        gm::gemm_phase<1, gm::EpiProj, gm::StaticOrder, gm::NT, false, false>(L, S, E, 1024, 1024 TP_ARGS);
    }
    xcd_barrier(bar);
    TP_END(11);

    TP_BEGIN(12);
    if (PHASE_MASK & 4) REPS(4) {
        PH_BEGIN();
        bf16_t* Ub = WSP(bf16_t, WS_U); bf16_t* DOb = WSP(bf16_t, WS_DO);
        float lam, B2;
        { const float a1 = args.in[8][lane] * args.in[9][lane], a2 = args.in[10][lane] * args.in[11][lane];
          lam = __expf(wave_sum(a1)) - __expf(wave_sum(a2)) + 0.2f;
          const float mq = wave_max(fabsf(args.in[6][lane])), mk = wave_max(fabsf(args.in[7][lane]));
          B2 = 8.0f * mq * mk * LOG2E * 1.02f + 0.5f; }
        TP_BEGIN(20);
        { LAS int* tick = (LAS int*)(L + LDSCTL_OFF + 512);
          const int bq = vcu >> 3; unsigned* qh = (unsigned*)(ctl + CW_ATTQ) + bq * 16;
          if (tid == 0) tick[0] = (int)atomicAdd(qh, 1u);
          __syncthreads();
          int idx = tick[0];
          while (idx < 64) {
              __syncthreads();
              if (tid == 0) tick[0] = (int)atomicAdd(qh, 1u);
              int h, qb; if (idx < 32) { h = 3 - (idx & 1); qb = 15 - (idx >> 1); } else if (idx < 48) { h = 1; qb = 47 - idx; } else { h = 0; qb = 63 - idx; }
              att::attn_unit(bq, h, qb, WSP(bf16_t, WS_Q), WSP(bf16_t, WS_K), WSP(bf16_t, WS_V), DOb, (char*)lds, B2, lam, args.in[12] TP_ARGS);
              __syncthreads();
              idx = tick[0];
          } }
        TP_END(20);
        { const int w = 2 << (lane >> 4);
          const bf16_t* Ul = Ub + lane * 8;
          for (int blk = gw; blk < NTOK / 8; blk += NGW) {
            const int tok0 = blk * 8, t0 = tok0 & (SEQ - 1);
            u32x4 hist[15], curv[8], oldv[8];
#pragma unroll
            for (int s = 1; s <= 15; ++s) { const int ok = (s < w) && (t0 - s >= 0); hist[s - 1] = *(const u32x4*)(Ul + (size_t)(ok ? tok0 - s : tok0) * 512); if (!ok) hist[s - 1] = (u32x4){0u, 0u, 0u, 0u}; }
#pragma unroll
            for (int tt = 0; tt < 8; ++tt) { curv[tt] = *(const u32x4*)(Ul + (size_t)(tok0 + tt) * 512);
                const int ok = (t0 + tt - w + 1 >= 0); oldv[tt] = *(const u32x4*)(Ul + (size_t)(ok ? tok0 + tt - w + 1 : tok0) * 512); if (!ok) oldv[tt] = (u32x4){0u, 0u, 0u, 0u}; }
            float S[8];
#pragma unroll
            for (int c = 0; c < 8; ++c) S[c] = 0.f;
#pragma unroll
            for (int s = 0; s < 15; ++s) { const u32x4 v = hist[s];
                S[0] += bflo(v.x); S[1] += bfhi(v.x); S[2] += bflo(v.y); S[3] += bfhi(v.y); S[4] += bflo(v.z); S[5] += bfhi(v.z); S[6] += bflo(v.w); S[7] += bfhi(v.w); }
#pragma unroll
            for (int tt = 0; tt < 8; ++tt) { const u32x4 v = curv[tt], q = oldv[tt]; const int t = t0 + tt;
                const float c0 = bflo(v.x), c1 = bfhi(v.x), c2 = bflo(v.y), c3 = bfhi(v.y), c4 = bflo(v.z), c5 = bfhi(v.z), c6 = bflo(v.w), c7 = bfhi(v.w);
                S[0] += c0; S[1] += c1; S[2] += c2; S[3] += c3; S[4] += c4; S[5] += c5; S[6] += c6; S[7] += c7;
                const float inv = 1.0f / (float)((t + 1 < w) ? t + 1 : w);
                u32x4 o; o.x = pk2(S[0] * inv - c0, S[1] * inv - c1); o.y = pk2(S[2] * inv - c2, S[3] * inv - c3); o.z = pk2(S[4] * inv - c4, S[5] * inv - c5); o.w = pk2(S[6] * inv - c6, S[7] * inv - c7);
                *(u32x4*)(DOb + (size_t)(tok0 + tt) * 1024 + lane * 8) = o;
                S[0] -= bflo(q.x); S[1] -= bfhi(q.x); S[2] -= bflo(q.y); S[3] -= bfhi(q.y); S[4] -= bflo(q.z); S[5] -= bfhi(q.z); S[6] -= bflo(q.w); S[7] -= bfhi(q.w); }
          } }
    }
    xcd_barrier(bar);
    TP_END(12);

    TP_BEGIN(13);
    if (PHASE_MASK & 8) REPS(8) {
        PH_BEGIN();
        gm::StaticOrder S; S.init(WSP(bf16_t, WS_DO), WSP(bf16_t, WS_WM), 1024, 1024, NTOK, 1024, G, bx);
        gm::EpiMerge E{WSP(bf16_t, WS_GP), WSP(bf16_t, WS_GA), WSP(bf16_t, WS_MERGED)};
        dephase(vcu, DEPHASE3);
        gm::gemm_phase<3, gm::EpiMerge, gm::StaticOrder, gm::NT, false, true>(L, S, E, 1024, 1024 TP_ARGS);
    }
    xcd_barrier(bar);
    TP_END(13);

    TP_BEGIN(14);
    if (PHASE_MASK & 16) REPS(16) {
        PH_BEGIN();
        gm::StaticOrder S; S.init(WSP(bf16_t, WS_MERGED), WSP(bf16_t, WS_WO), 1024, 1024, NTOK, 1024, G, bx);
        gm::EpiRes E{args.in[0], WSP(bf16_t, WS_X1)};
        dephase(vcu, DEPHASE4);
        gm::gemm_phase<4, gm::EpiRes, gm::StaticOrder, gm::NT, false, false>(L, S, E, 1024, 1024 TP_ARGS);
    }
    xcd_barrier(bar);
    TP_END(14);

    TP_BEGIN(15);
    if (PHASE_MASK & 32) {
        PH_BEGIN();
        float* rstd2 = WSP(float, WS_RSTD); int* tcls = WSP(int, WS_TCLS); float* twlo = WSP(float, WS_TWLO); float* twhi = WSP(float, WS_TWHI);
        int* stok = WSP(int, WS_STOK); float* swlo = WSP(float, WS_SWLO); float* swhi = WSP(float, WS_SWHI); float* srstd = WSP(float, WS_SRSTD);
        const bf16_t* X1 = WSP(bf16_t, WS_X1); const bf16_t* WrH = WSP(bf16_t, WS_WRH); const bf16_t* WrL = WSP(bf16_t, WS_WRL); unsigned char* X1F = WSP(unsigned char, WS_X1F8);
        for (int i = gw * 64 + lane; i < MAXT * 256; i += NGW * 64) { stok[i] = -1; swlo[i] = 0.f; swhi[i] = 0.f; srstd[i] = 0.f; }
        constexpr int TROW = 1040, LG_OFF = 96 * TROW;
        const int row = lane & 15, kg = lane >> 4;
        const int tok0 = gw * 32;
        f32x4 acc[2][3];
#pragma unroll
        for (int rg = 0; rg < 2; ++rg)
#pragma unroll
            for (int nf = 0; nf < 3; ++nf) acc[rg][nf] = (f32x4){0.f, 0.f, 0.f, 0.f};
        float ss[2] = {0.f, 0.f};
        for (int blk0 = 0; blk0 < NTOK; blk0 += NGW * 32) {
          const int tb = blk0 + tok0; const bool live = tb < NTOK;
          for (int half = 0; half < 2; ++half) {
            __syncthreads();
            for (int i = tid; i < 96 * 64; i += NWAVES * 64) { const int r = i >> 6, c = i & 63;
                const bf16_t* src = (r < 48 ? WrH + (size_t)r * 1024 : WrL + (size_t)(r - 48) * 1024) + half * 512 + c * 8;
                *(LAS u32x4*)(L + r * TROW + c * 16) = *(const u32x4*)src; }
            __syncthreads();
            if (live) {
                const bf16_t* xa = X1 + (size_t)(tb + row) * 1024 + half * 512 + kg * 16;
#pragma unroll 4
                for (int sp = 0; sp < 8; ++sp) {
                    u32x4 A[2][2];
#pragma unroll
                    for (int rg = 0; rg < 2; ++rg) { A[rg][0] = *(const u32x4*)(xa + (size_t)rg * 16 * 1024 + sp * 64); A[rg][1] = *(const u32x4*)(xa + (size_t)rg * 16 * 1024 + sp * 64 + 8); }
#pragma unroll
                    for (int rg = 0; rg < 2; ++rg) {
                        const u32x4 a0 = A[rg][0], a1 = A[rg][1]; u32x4 w;
                        w.x = pk4_f8(bflo(a0.x), bfhi(a0.x), bflo(a0.y), bfhi(a0.y)); w.y = pk4_f8(bflo(a0.z), bfhi(a0.z), bflo(a0.w), bfhi(a0.w));
                        w.z = pk4_f8(bflo(a1.x), bfhi(a1.x), bflo(a1.y), bfhi(a1.y)); w.w = pk4_f8(bflo(a1.z), bfhi(a1.z), bflo(a1.w), bfhi(a1.w));
                        *(u32x4*)(X1F + (size_t)(tb + rg * 16 + row) * 1024 + half * 512 + sp * 64 + kg * 16) = w; }
#pragma unroll
                    for (int rg = 0; rg < 2; ++rg)
#pragma unroll
                        for (int hh = 0; hh < 2; ++hh) { const u32x4 v = A[rg][hh];
                            const float f0 = bflo(v.x), f1 = bfhi(v.x), f2 = bflo(v.y), f3 = bfhi(v.y), f4 = bflo(v.z), f5 = bfhi(v.z), f6 = bflo(v.w), f7 = bfhi(v.w);
                            ss[rg] += (f0 * f0 + f1 * f1) + (f2 * f2 + f3 * f3) + (f4 * f4 + f5 * f5) + (f6 * f6 + f7 * f7); }
#pragma unroll
                    for (int hh = 0; hh < 2; ++hh)
#pragma unroll
                        for (int nf = 0; nf < 3; ++nf) {
                            const bf16x8 Bh = *(const LAS bf16x8*)(L + (nf * 16 + row) * TROW + (sp * 64 + kg * 16 + hh * 8) * 2);
                            const bf16x8 Bl = *(const LAS bf16x8*)(L + (48 + nf * 16 + row) * TROW + (sp * 64 + kg * 16 + hh * 8) * 2);
#pragma unroll
                            for (int rg = 0; rg < 2; ++rg) { const bf16x8 Af = __builtin_bit_cast(bf16x8, A[rg][hh]);
                                acc[rg][nf] = __builtin_amdgcn_mfma_f32_16x16x32_bf16(Af, Bh, acc[rg][nf], 0, 0, 0);
                                acc[rg][nf] = __builtin_amdgcn_mfma_f32_16x16x32_bf16(Af, Bl, acc[rg][nf], 0, 0, 0); }
                        }
                }
            }
          }
          if (live) {
            LAS float* lg = (LAS float*)(L + LG_OFF + wave * 3072);
#pragma unroll
            for (int rg = 0; rg < 2; ++rg) {
                float s2 = ss[rg]; s2 += __shfl_xor(s2, 16); s2 += __shfl_xor(s2, 32);
                const float rstd = __builtin_amdgcn_rsqf(s2 * (1.0f / 1024.0f) + EPS);
#pragma unroll
                for (int nf = 0; nf < 3; ++nf)
#pragma unroll
                    for (int r = 0; r < 4; ++r) lg[(4 * kg + r) * 48 + 16 * nf + row] = acc[rg][nf][r];
                LDS_WAIT(); asm volatile("" ::: "memory");
                if (lane < 16) {
                    const int tok = tb + rg * 16 + lane;
                    const LAS float* my = lg + lane * 48;
                    float gl[4]; int g = 0;
#pragma unroll
                    for (int j = 0; j < 4; ++j) gl[j] = rstd * my[j] + args.in[17][j];
                    float gmx = gl[0];
#pragma unroll
                    for (int j = 1; j < 4; ++j) if (gl[j] > gmx) { gmx = gl[j]; g = j; }
                    float den = 0.f;
#pragma unroll
                    for (int j = 0; j < 4; ++j) den += __expf(gl[j] - gmx);
                    const float ptop = 1.0f / den;
                    float le[8];
#pragma unroll
                    for (int e = 0; e < 8; ++e) le[e] = rstd * my[4 + g * 8 + e] + args.in[19][g * 8 + e];
                    int e1 = 0; float v1 = le[0];
#pragma unroll
                    for (int e = 1; e < 8; ++e) if (le[e] > v1) { v1 = le[e]; e1 = e; }
                    int e2 = -1; float v2 = -3.0e38f;
#pragma unroll
                    for (int e = 0; e < 8; ++e) if (e != e1 && le[e] > v2) { v2 = le[e]; e2 = e; }
                    const float rr = __expf(v2 - v1), w1 = ptop / (1.0f + rr), w2 = ptop * rr / (1.0f + rr);
                    const int lo = e1 < e2 ? e1 : e2, hi2 = e1 < e2 ? e2 : e1;
                    const float wlo = e1 < e2 ? w1 : w2, whi = e1 < e2 ? w2 : w1;
                    const int cls = g * 28 + lo * 8 - (lo * (lo + 1)) / 2 + (hi2 - lo - 1);
                    const unsigned pos = atomicAdd((unsigned*)(ctl + CW_CNT) + cls * 16, 1u);
                    tcls[tok] = cls | ((int)pos << 8); twlo[tok] = wlo; twhi[tok] = whi; rstd2[tok] = rstd;
                }
                LDS_WAIT(); asm volatile("" ::: "memory");
                ss[rg] = 0.f;
#pragma unroll
                for (int nf = 0; nf < 3; ++nf) acc[rg][nf] = (f32x4){0.f, 0.f, 0.f, 0.f};
            }
          }
        }
    }
    xcd_barrier(bar);
    TP_END(15);

    TP_BEGIN(16);
    if (PHASE_MASK & 64) {
        PH_BEGIN();
        float* rstd2 = WSP(float, WS_RSTD); int* tcls = WSP(int, WS_TCLS); float* twlo = WSP(float, WS_TWLO); float* twhi = WSP(float, WS_TWHI);
        int* stok = WSP(int, WS_STOK); float* swlo = WSP(float, WS_SWLO); float* swhi = WSP(float, WS_SWHI); float* srstd = WSP(float, WS_SRSTD);
        int* tilecls = WSP(int, WS_TILECLS);
        LAS int* fstart = (LAS int*)(L);
        LAS int* hidx = (LAS int*)(L + 512);
        LAS int* nfull = (LAS int*)(L + 1024);
        LAS int* cntl = (LAS int*)(L + 1536);
        LAS int* tot = (LAS int*)(L + 2048);
        if (tid < NCLS) cntl[tid] = (int)__hip_atomic_load((unsigned*)(ctl + CW_CNT) + tid * 16, RLX_AGENT);
        __syncthreads();
        if (tid == 0) { int f = 0, h = 0;
            for (int c = 0; c < NCLS; ++c) { const int n = cntl[c], nt = (n + 255) >> 8, lr = n - 256 * (nt - 1); const int hf = (nt > 0 && lr <= 128) ? 1 : 0; nfull[c] = nt - hf; fstart[c] = f; f += nt - hf; hidx[c] = hf ? h : -1; h += hf; }
            for (int c = 0; c < NCLS; ++c) if (hidx[c] >= 0) hidx[c] += f;
            tot[0] = f; tot[1] = f + h; }
        __syncthreads();
        if (bx == 0) {
            if (tid < NCLS) { const int t0 = fstart[tid], nf = nfull[tid]; for (int t = 0; t < nf; ++t) tilecls[t0 + t] = tid; if (hidx[tid] >= 0) tilecls[hidx[tid]] = tid; }
            if (tid == 0) { __hip_atomic_store((unsigned*)(ctl + CW_NTILES), (unsigned)tot[1], RLX_AGENT); __hip_atomic_store((unsigned*)(ctl + CW_NTILES) + 1, (unsigned)tot[0], RLX_AGENT); }
        }
        for (int tok = bx * 512 + tid; tok < NTOK; tok += G * 512) {
            const int cp = tcls[tok]; const int c = cp & 255; const unsigned pos = (unsigned)cp >> 8;
            const int j = (int)(pos >> 8); const int tile = (j < nfull[c]) ? fstart[c] + j : hidx[c];
            const int slot = tile * 256 + (int)(pos & 255u);
            stok[slot] = tok; swlo[slot] = twlo[tok]; swhi[slot] = twhi[tok]; srstd[slot] = rstd2[tok];
        }
    }
    xcd_barrier(bar);
    TP_END(16);

    TP_BEGIN(17);
    if (PHASE_MASK & 128) REPS(128) {
        PH_BEGIN();
        LAS int* utab = (LAS int*)(L + UTAB_OFF); const int* tilecls = WSP(int, WS_TILECLS);
        const int ntiles = (int)__hip_atomic_load((unsigned*)(ctl + CW_NTILES), RLX_AGENT);
        const int nfullt = (int)__hip_atomic_load((unsigned*)(ctl + CW_NTILES) + 1, RLX_AGENT);
        if (tid < 16) { const int Lx = tid * G + vcu; const int tile = Lx >> 3, pn = Lx & 7; int e0 = 0, e1 = 0, tl = -1;
            if (tile < ntiles) { const int cls = tilecls[tile]; const int g = cls / 28; int rem = cls % 28, lo = 0; while (rem >= 7 - lo) { rem -= 7 - lo; ++lo; } e0 = g * 8 + lo; e1 = g * 8 + lo + 1 + rem; tl = tile; }
            utab[tid * 8 + 0] = tl; utab[tid * 8 + 1] = pn; utab[tid * 8 + 2] = e0; utab[tid * 8 + 3] = e1; utab[tid * 8 + 4] = (tile >= nfullt) ? 1 : 0; }
        __syncthreads();
        gm::MoeSched S{utab, (const char*)WSP(unsigned char, WS_X1F8), (const char*)WSP(unsigned char, WS_WGU), WSP(int, WS_STOK), 1};
        gm::EpiMoe1 E{WSP(float, WS_SRSTD), WSP(float, WS_SWLO), WSP(float, WS_SWHI), WSP(bf16_t, WS_HDN)};
        gm::gemm_phase<7, gm::EpiMoe1, gm::MoeSched, 8, true, false, true, 8>(L, S, E, 512, 512 TP_ARGS);
    }
    xcd_barrier(bar);
    TP_END(17);
    TP_BEGIN(18);
    if (PHASE_MASK & 256) {
        PH_BEGIN();
        LAS int* utab = (LAS int*)(L + UTAB_OFF); const int* tilecls = WSP(int, WS_TILECLS);
        const int ntiles = (int)__hip_atomic_load((unsigned*)(ctl + CW_NTILES), RLX_AGENT);
        const int nfullt = (int)__hip_atomic_load((unsigned*)(ctl + CW_NTILES) + 1, RLX_AGENT);
        if (tid < 16) { const int Lx = tid * G + vcu; const int tile = Lx >> 2, pn = Lx & 3; int e0 = 0, e1 = 0, tl = -1;
            if (tile < ntiles) { const int cls = tilecls[tile]; const int g = cls / 28; int rem = cls % 28, lo = 0; while (rem >= 7 - lo) { rem -= 7 - lo; ++lo; } e0 = g * 8 + lo; e1 = g * 8 + lo + 1 + rem; tl = tile; }
            utab[tid * 8 + 0] = tl; utab[tid * 8 + 1] = pn; utab[tid * 8 + 2] = e0; utab[tid * 8 + 3] = e1; utab[tid * 8 + 4] = (tile >= nfullt) ? 1 : 0; }
        __syncthreads();
        gm::MoeSched S{utab, (const char*)WSP(bf16_t, WS_HDN), (const char*)WSP(bf16_t, WS_WD), WSP(int, WS_STOK), 2};
        gm::EpiMoe2 E{WSP(int, WS_STOK), WSP(bf16_t, WS_X1), args.out};
        dephase(vcu, DEPHASE8);
        gm::gemm_phase<8, gm::EpiMoe2, gm::MoeSched, 8, false, false>(L, S, E, 1024, 512 TP_ARGS);
    }
    TP_END(18);
    TP_FINISH();
}

extern "C" void kernel_launch(void* const* d_in, const int* in_sizes, int n_in, void* d_out, int out_size, void* d_ws, size_t ws_size, hipStream_t stream) {
    static int grid = 0;
    if (grid == 0) {
        if (n_in != 23 || out_size != NTOK * DM || ws_size < WS_END) { fprintf(stderr, "kernel_launch: unexpected shapes (n_in %d, out %d, ws %zu)\n", n_in, out_size, ws_size); grid = -1; return; }
        int dev = 0, cus = 0;
        if (hipGetDevice(&dev) != hipSuccess || hipDeviceGetAttribute(&cus, hipDeviceAttributeMultiprocessorCount, dev) != hipSuccess) { grid = -1; return; }
        if (hipFuncSetAttribute((const void*)hybrid_fwd, hipFuncAttributeMaxDynamicSharedMemorySize, LDS_BYTES) != hipSuccess) { fprintf(stderr, "kernel_launch: hipFuncSetAttribute failed\n"); grid = -1; return; }
        int per_cu = 0;
        if (hipOccupancyMaxActiveBlocksPerMultiprocessor(&per_cu, (const void*)hybrid_fwd, NWAVES * 64, LDS_BYTES) != hipSuccess || per_cu < 1) fprintf(stderr, "kernel_launch: occupancy query says %d\n", per_cu);
        (void)hipGetLastError();
        grid = cus;
        if (grid != 256) fprintf(stderr, "kernel_launch: %d CUs (built for 256)\n", grid);
    }
    if (grid < 0) return;
    if (hipMemsetAsync((char*)d_ws + WS_CTL, 0, CTL_ZERO_BYTES, stream) != hipSuccess) return;
    Args a{};
    for (int i = 0; i < 23; ++i) a.in[i] = (const float*)d_in[i];
    a.out = (float*)d_out; a.ws = (unsigned char*)d_ws;
    hipLaunchKernelGGL(hybrid_fwd, dim3(grid), dim3(NWAVES * 64), LDS_BYTES, stream, a);
}
```

```cpp
#include <hip/hip_runtime.h>
#include <hip/hip_bf16.h>
#include <cstdio>
#include <cstdint>
#include <type_traits>

#define LAS __attribute__((address_space(3)))
#define GAS __attribute__((address_space(1)))
typedef unsigned short bf16_t;
typedef short bf16x8 __attribute__((ext_vector_type(8)));
typedef short s16x4 __attribute__((ext_vector_type(4)));
typedef float f32x2 __attribute__((ext_vector_type(2)));
typedef float f32x4 __attribute__((ext_vector_type(4)));
typedef float f32x16 __attribute__((ext_vector_type(16)));
typedef unsigned u32x4 __attribute__((ext_vector_type(4)));
typedef unsigned u32x2 __attribute__((ext_vector_type(2)));
typedef GAS unsigned gu32;
typedef int i32x4 __attribute__((ext_vector_type(4)));
typedef int i32x8 __attribute__((ext_vector_type(8)));
#define RLX_AGENT __ATOMIC_RELAXED, __HIP_MEMORY_SCOPE_AGENT
#define LDS_WAIT() asm volatile("s_waitcnt lgkmcnt(0)" ::: "memory")
#define VM_WAIT() asm volatile("s_waitcnt vmcnt(0)" ::: "memory")

#ifndef PHASE_MASK
#define PHASE_MASK 0x1ff
#endif
#ifndef DUP_MASK
#define DUP_MASK 0
#endif
#ifdef TPROBE
#ifndef TP_AMP
#define TP_AMP 4
#endif
#ifndef TP_WAVE
#define TP_WAVE 0
#endif
__device__ __forceinline__ unsigned long long tp_now() { unsigned long long t; __builtin_amdgcn_sched_barrier(0); asm volatile("s_memrealtime %0\n\ts_waitcnt lgkmcnt(0)" : "=s"(t) :: "memory"); __builtin_amdgcn_sched_barrier(0); return t; }
#ifdef TP_CLK
__device__ __forceinline__ unsigned long long tp_seg() { unsigned long long t; __builtin_amdgcn_sched_barrier(0); asm volatile("s_memtime %0\n\ts_waitcnt lgkmcnt(0)" : "=s"(t) :: "memory"); __builtin_amdgcn_sched_barrier(0); return t; }
#else
#define tp_seg tp_now
#endif
#ifndef TP_DIV
#define TP_DIV 1
#endif
#define TP_DECL() unsigned long long tp_t0 = 0, tp_acc = 0; (void)tp_t0
#define TP_PARAMS , unsigned long long& tp_t0, unsigned long long& tp_acc
#define TP_ARGS , tp_t0, tp_acc
#define TP_BEGIN(k) do { if ((k) == TPROBE) tp_t0 = tp_seg(); } while (0)
#define TP_END(k) do { if ((k) == TPROBE) tp_acc += tp_seg() - tp_t0; } while (0)
#define TP_FINISH() do { if (blockIdx.x == 0 && threadIdx.x == TP_WAVE * 64) { const unsigned long long s0 = tp_now(); while (tp_now() - s0 < tp_acc * TP_AMP / TP_DIV) __builtin_amdgcn_s_sleep(8); } } while (0)
#else
#define TP_DECL()
#define TP_PARAMS
#define TP_ARGS
#define TP_BEGIN(k)
#define TP_END(k)
#define TP_FINISH()
#endif
#define REPS(bit) for (int rep_ = 0; rep_ < ((DUP_MASK & (bit)) ? 2 : 1); ++rep_)

constexpr int NTOK = 65536, DM = 1024, SEQ = 2048;
constexpr float LOG2E = 1.4426950408889634f;
constexpr float EPS = 1e-6f;
constexpr int NCLS = 112, MAXT = 368;
constexpr int NWAVES = 8;

constexpr size_t MiB = 1u << 20;
constexpr size_t WS_CTL = 0, CTL_ZERO_BYTES = 64 * 1024;
constexpr size_t WS_RSTD = 1 * MiB, WS_TCLS = WS_RSTD + 256 * 1024, WS_TWLO = WS_TCLS + 256 * 1024, WS_TWHI = WS_TWLO + 256 * 1024;
constexpr size_t WS_STOK = 2 * MiB, WS_SWLO = WS_STOK + 512 * 1024, WS_SWHI = WS_SWLO + 512 * 1024, WS_SRSTD = WS_SWHI + 512 * 1024;
constexpr size_t WS_TILECLS = 4 * MiB;
constexpr size_t WS_WRH = 5 * MiB, WS_WRL = WS_WRH + 128 * 1024;
constexpr size_t WS_RSTD1 = 6 * MiB;
constexpr size_t WS_WIN = 16 * MiB, WS_WM = 24 * MiB, WS_WO = 26 * MiB;
constexpr size_t WS_WGU = 32 * MiB, WS_WD = 96 * MiB;
constexpr size_t WS_H = 128 * MiB;
constexpr size_t WS_U = 256 * MiB, WS_Q = 320 * MiB, WS_K = 384 * MiB, WS_V = 448 * MiB;
constexpr size_t WS_GP = 512 * MiB, WS_GA = 640 * MiB;
constexpr size_t WS_DO = 768 * MiB;
constexpr size_t WS_MG = 896 * MiB;
constexpr size_t WS_END = 1024 * MiB;
constexpr int SCAP = 65536;
constexpr size_t WS_S2TOK = 768 * MiB, WS_S2RSTD = 796 * MiB, WS_S2WLO = 824 * MiB, WS_S2WHI = 852 * MiB;
constexpr size_t WS_MERGED = WS_MG, WS_X1 = WS_U, WS_HDN = WS_GP, WS_X1F8 = WS_K;
constexpr int CW_TMO = 0, CW_NTILES = 16, CW_BAR = 4096, CW_CNT = 8192, CW_CUR = 10240, CW_ATTQ = 12288;
static_assert((CW_ATTQ + 32 * 16) * 4 <= (int)CTL_ZERO_BYTES && (CW_BAR + 3456) <= CW_CNT, "control words inside the per-call memset");

constexpr int RING_BYTES = 131072;
constexpr int LDSCTL_OFF = RING_BYTES, MISC_OFF = LDSCTL_OFF + 320, UTAB_OFF = LDSCTL_OFF + 1024;
constexpr int JUNK_OFF = LDSCTL_OFF + 8192;
constexpr int TKL_OFF = LDSCTL_OFF + 10240;
constexpr int LDS_BYTES = 147456;

__device__ __forceinline__ unsigned f2bf(float f) { unsigned u = __builtin_bit_cast(unsigned, f); return (u + 0x7fffu + ((u >> 16) & 1u)) >> 16; }
__device__ __forceinline__ unsigned pk2(float lo, float hi) { return f2bf(lo) | (f2bf(hi) << 16); }
__device__ __forceinline__ float bf2f(unsigned short b) { return __builtin_bit_cast(float, (unsigned)b << 16); }
__device__ __forceinline__ float bflo(unsigned w) { return __builtin_bit_cast(float, w << 16); }
__device__ __forceinline__ float bfhi(unsigned w) { return __builtin_bit_cast(float, w & 0xffff0000u); }
__device__ __forceinline__ unsigned cvt_pk_bf16(float lo, float hi) { unsigned r; asm("v_cvt_pk_bf16_f32 %0, %1, %2" : "=v"(r) : "v"(lo), "v"(hi)); return r; }

__device__ __forceinline__ unsigned pk4_f8(float a, float b, float c, float d) { int w = 0; w = __builtin_amdgcn_cvt_pk_fp8_f32(a, b, w, false); w = __builtin_amdgcn_cvt_pk_fp8_f32(c, d, w, true); return (unsigned)w; }
constexpr float F8_WSCALE = 32.0f, F8_HSCALE = 16.0f;

#define XB_TMO      128
#define XB_XCNT(j)  (256  + 64 * (j))
#define XB_XSUB(j)  (1280 + 64 * (j))
#define XB_XGEN(j)  (2304 + 64 * (j))
#define XB_TOP      3328
#define XB_TOPGEN   3392
#define XCD_BAR_WORDS 3456
#define XB_SPIN_CAP (1u << 18)
__device__ __forceinline__ unsigned xb_ld(unsigned* p)              { return __hip_atomic_load(p, __ATOMIC_RELAXED, __HIP_MEMORY_SCOPE_AGENT); }
__device__ __forceinline__ unsigned xb_add(unsigned* p, unsigned v) { return __hip_atomic_fetch_add(p, v, __ATOMIC_RELAXED, __HIP_MEMORY_SCOPE_AGENT); }
__device__ __forceinline__ unsigned xb_xcc_id() { return (unsigned)__builtin_amdgcn_s_getreg((3 << 11) | 20) & 0xFu; }
#define XB_SPIN(cond, bar) do { unsigned _sp = 0; while (cond) { __builtin_amdgcn_s_sleep(1); \
    if ((++_sp & 255u) == 0u) { if (xb_ld(&(bar)[XB_TMO])) break; if (_sp > XB_SPIN_CAP) { atomicAdd(&(bar)[XB_TMO], 1u); break; } } } } while (0)
struct XcdBarrier { unsigned* bar; unsigned x; volatile LAS unsigned* st; };
__device__ __forceinline__ XcdBarrier xcd_barrier_post(unsigned* bar, volatile LAS unsigned* st) {
    XcdBarrier b; b.bar = bar; b.x = xb_xcc_id(); b.st = st;
    if (threadIdx.x == 0) (void)xb_add(&bar[XB_XCNT(b.x)], 1u);
    return b;
}
__device__ __forceinline__ void xcd_barrier_complete(unsigned* bar, unsigned x, unsigned& nloc, unsigned& nx) {
    const unsigned G = gridDim.x * gridDim.y * gridDim.z;
    unsigned sum, cnt, mine, sp = 0u;
    for (;;) {
        sum = 0u; cnt = 0u; mine = 0u;
#pragma unroll
        for (unsigned j = 0; j < 16; ++j) { const unsigned c = xb_ld(&bar[XB_XCNT(j)]); sum += c; cnt += (c > 0u) ? 1u : 0u; mine = (j == x) ? c : mine; }
        if (sum == G) break;
        __builtin_amdgcn_s_sleep(1);
        if ((++sp & 255u) == 0u) { if (xb_ld(&bar[XB_TMO])) break; if (sp > XB_SPIN_CAP) { atomicAdd(&bar[XB_TMO], 1u); break; } }
    }
    nloc = mine > 0u ? mine : 1u; nx = cnt > 0u ? cnt : 1u;
}
__device__ __forceinline__ void xcd_barrier(const XcdBarrier& b) {
    asm volatile("s_waitcnt vmcnt(0)" ::: "memory");
    __syncthreads();
    if (threadIdx.x == 0) {
        unsigned* bar = b.bar;
        __builtin_amdgcn_s_waitcnt(0);
        unsigned nloc = b.st[0], nx = b.st[1];
        if (nloc == 0u) { xcd_barrier_complete(bar, b.x, nloc, nx); b.st[0] = nloc; b.st[1] = nx; }
        const unsigned old = xb_add(&bar[XB_XSUB(b.x)], 1u);
        const unsigned gen = old / nloc;
        if (old + 1u == (gen + 1u) * nloc) {
            __builtin_amdgcn_fence(__ATOMIC_RELEASE, "agent");
            asm volatile("s_waitcnt vmcnt(0)" ::: "memory");
            const unsigned og = xb_add(&bar[XB_TOP], 1u);
            const unsigned tg = og / nx;
            if (og + 1u == (tg + 1u) * nx) xb_add(&bar[XB_TOPGEN], 1u);
            else XB_SPIN(xb_ld(&bar[XB_TOPGEN]) == tg, bar);
            __builtin_amdgcn_fence(__ATOMIC_ACQUIRE, "agent");
            xb_add(&bar[XB_XGEN(b.x)], 1u);
            asm volatile("s_waitcnt vmcnt(0)" ::: "memory");
        } else {
            XB_SPIN(xb_ld(&bar[XB_XGEN(b.x)]) == gen, bar);
            __builtin_amdgcn_fence(__ATOMIC_ACQUIRE, "agent");
            asm volatile("s_waitcnt vmcnt(0)" ::: "memory");
        }
    }
    __syncthreads();
}

namespace gm {
constexpr int BM = 256, BK = 64, HALF = 128, HTB = HALF * BK * 2, NXCD = 8, WGM = 8, NT = 16;
__host__ __device__ __forceinline__ int lds_byte(int r, int c) { const int st = (r >> 4) * 2 + (c >> 5), rr = r & 15, cc = c & 31, ob = rr * 64 + cc * 2; return st * 1024 + (ob ^ (((ob >> 9) & 1) << 5)); }
__host__ __device__ __forceinline__ void stage_rc(int b, int& R, int& C) { const int st = b / 1024, sb = b % 1024, swz = sb ^ (((sb >> 9) & 1) << 5); R = (st >> 1) * 16 + swz / 64; C = (st & 1) * 32 + (swz % 64) / 2; }
__host__ __device__ __forceinline__ int perm32(int rho) { const int n = rho >> 4, i = rho & 15; return 8 * (i >> 2) + 4 * n + (i & 3); }

struct Unit { const char* a; const char* b0; const char* b1; int pm, pn, e0, e1, half, base, rows; };

struct StaticOrder {
    const char* A; const char* Bt; int lda, ldb; int nM, nN, nwg, G, c;
    __device__ void init(const void* A_, const void* Bt_, int lda_, int ldb_, int M, int N, int G_, int c_) { A = (const char*)A_; Bt = (const char*)Bt_; lda = lda_; ldb = ldb_; nM = M / BM; nN = N / BM; nwg = nM * nN; G = G_; c = c_; }
    __device__ __forceinline__ bool next(int i, Unit& u) const {
        const long L = (long)i * G + c; if (L >= nwg) return false;
        int wgid = (int)L; { const int q = nwg / NXCD, r = nwg % NXCD, xcd = wgid % NXCD, off = wgid / NXCD; wgid = (xcd < r ? xcd * (q + 1) : r * (q + 1) + (xcd - r) * q) + off; }
        const int nig = WGM * nN, gid = wgid / nig, fm = gid * WGM, gsz = (nM - fm) < WGM ? (nM - fm) : WGM;
        u.pm = fm + ((wgid % nig) % gsz); u.pn = (wgid % nig) / gsz; u.e0 = 0; u.e1 = 0; u.half = 0; u.base = 0; u.rows = 256;
        u.a = A + (size_t)u.pm * BM * lda * 2; u.b0 = Bt + (size_t)u.pn * BM * ldb * 2; u.b1 = u.b0;
        return true;
    }
    __device__ __forceinline__ void offs(const Unit&, const int (&)[2], const int (&)[2], unsigned (&)[2][2]) const {}
};

template <int PH, class Epi, class Sched, int KS, bool GATHER, bool MID, bool F8 = false, int NTT = 16, bool BASEP = false>
__device__ __forceinline__ void gemm_phase(LAS unsigned char* lds, const Sched& S, const Epi& E, const int lda, const int ldb TP_PARAMS) {
    int tid = threadIdx.x; asm volatile("" : "+v"(tid));
    const int wid = __builtin_amdgcn_readfirstlane(tid >> 6), lane = tid & 63, wr = wid >> 2, wc = wid & 3, fr = lane & 15, fq = lane >> 4;
    int Rr[2], Cc[2]; unsigned offA[2][2], offAn[2][2], voffB[2];
#pragma unroll
    for (int i = 0; i < 2; ++i) { int R, C; stage_rc(tid * 16 + i * 8192, R, C); Rr[i] = R; Cc[i] = C; const int Rb = Epi::PERM ? ((R & ~31) + perm32(R & 31)) : R;
        voffB[i] = (unsigned)(Rb * ldb + C) * 2u;
        offA[0][i] = (unsigned)(R * lda + C) * 2u; offA[1][i] = (unsigned)((R + HALF) * lda + C) * 2u;
        asm volatile("" : "+v"(offA[0][i]), "+v"(offA[1][i]), "+v"(voffB[i]));
        offAn[0][i] = offA[0][i]; offAn[1][i] = offA[1][i]; }
    const size_t kstep = (size_t)(BK * 2);
    const size_t hstepB = (size_t)HALF * ldb * 2;
    const unsigned ldsw = (unsigned)wid * 1024u; const unsigned ldsu = (unsigned)(uintptr_t)lds;
    const int aoff = lds_byte(wr * 64 + fr, fq * 8), boff = lds_byte(wc * 32 + fr, fq * 8);
    const LAS unsigned char* abase = lds + aoff; const LAS unsigned char* bbase = lds + 65536 + boff;
    if constexpr (BASEP) asm volatile("" : "+v"(abase), "+v"(bbase));
#define G_SA(b, h) (((b) * 2 + (h)) * HTB)
#define G_SB(b, h) ((4 + (b) * 2 + (h)) * HTB)
#define G_DMA(gbase, voff32, ldsdst) do { unsigned _keep; asm volatile("s_mov_b32 %0, m0\n\ts_mov_b32 m0, %3\n\ts_nop 0\n\tglobal_load_lds_dwordx4 %1, %2\n\ts_mov_b32 m0, %0" \
        : "=&s"(_keep) : "v"(voff32), "s"(gbase), "s"(ldsdst) : "memory"); } while (0)
#define G_STAGE_A(bufoff, gbase, OFF, h) do { _Pragma("unroll") for (int _i = 0; _i < 2; ++_i) { if constexpr (F8) G_DMA((const char*)(gbase), (OFF)[h][_i], ldsu + (unsigned)(bufoff) + ldsw + _i * 8192u); \
        else __builtin_amdgcn_global_load_lds((const unsigned*)((const char*)(gbase) + (OFF)[h][_i]), (LAS unsigned*)(lds + (bufoff) + ldsw + _i * 8192), 16, 0, 0); } } while (0)
#define G_STAGE_B(bufoff, gbase) do { _Pragma("unroll") for (int _i = 0; _i < 2; ++_i) { if constexpr (F8) G_DMA((const char*)(gbase), voffB[_i], ldsu + (unsigned)(bufoff) + ldsw + _i * 8192u); \
        else __builtin_amdgcn_global_load_lds((const unsigned*)((const char*)(gbase) + voffB[_i]), (LAS unsigned*)(lds + (bufoff) + ldsw + _i * 8192), 16, 0, 0); } } while (0)
#define G_LDP(p) (*(const LAS bf16x8*)(p))
#define G_AP(b, h, o) (BASEP ? (abase + (G_SA(b, h) + (o))) : (lds + (G_SA(b, h) + aoff + (o))))
#define G_BPTR(b, h, o) (BASEP ? (bbase + (G_SB(b, h) - 65536 + (o))) : (lds + (G_SB(b, h) + boff + (o))))
#define G_CAT2(x, y) __builtin_shufflevector(__builtin_bit_cast(i32x4, x), __builtin_bit_cast(i32x4, y), 0, 1, 2, 3, 4, 5, 6, 7)
#define G_LDA(dst, b, h) do { _Pragma("unroll") for (int m = 0; m < 4; ++m) { if constexpr (F8) { dst##8[m] = G_CAT2(G_LDP(G_AP(b, h, m * 2048)), G_LDP(G_AP(b, h, m * 2048 + 1024))); } \
        else { _Pragma("unroll") for (int k = 0; k < 2; ++k) dst[m][k] = G_LDP(G_AP(b, h, m * 2048 + k * 1024)); } } } while (0)
#define G_LDB(dst, b, h) do { _Pragma("unroll") for (int n = 0; n < 2; ++n) { if constexpr (F8) { dst##8[n] = G_CAT2(G_LDP(G_BPTR(b, h, n * 2048)), G_LDP(G_BPTR(b, h, n * 2048 + 1024))); } \
        else { _Pragma("unroll") for (int k = 0; k < 2; ++k) dst[n][k] = G_LDP(G_BPTR(b, h, n * 2048 + k * 1024)); } } } while (0)
#define G_MMA(ai, bj, At, Bt) do { __builtin_amdgcn_s_setprio(1); \
        if constexpr (F8) { _Pragma("unroll") for (int m = 0; m < 4; ++m) _Pragma("unroll") for (int n = 0; n < 2; ++n) \
            acc[ai][bj][m][n] = __builtin_amdgcn_mfma_scale_f32_16x16x128_f8f6f4(Bt##8[n], At##8[m], acc[ai][bj][m][n], 0, 0, 0, 0x7F7F7F7F, 0, 0x7F7F7F7F); } \
        else { _Pragma("unroll") for (int m = 0; m < 4; ++m) _Pragma("unroll") for (int n = 0; n < 2; ++n) _Pragma("unroll") for (int k = 0; k < 2; ++k) \
            acc[ai][bj][m][n] = __builtin_amdgcn_mfma_f32_16x16x32_bf16(Bt[n][k], At[m][k], acc[ai][bj][m][n], 0, 0, 0); } \
        __builtin_amdgcn_s_setprio(0); } while (0)
#define G_WAIT_V(n) asm volatile("s_waitcnt vmcnt(" #n ")" ::: "memory")
#define G_WAIT_L(n) asm volatile("s_waitcnt lgkmcnt(" #n ")" ::: "memory")
#define G_BAR __builtin_amdgcn_s_barrier()
#define G_SCHED __builtin_amdgcn_sched_barrier(0)
#define G_BP(u, t) ((t) < KS ? (u).b0 + (size_t)(t) * kstep : (u).b1 + (size_t)((t) - KS) * kstep)
    Unit cur, nxt; int ui = 0;
    if (!S.next(0, cur)) return;
    if constexpr (GATHER) S.offs(cur, Rr, Cc, offA);
    if constexpr (Epi::NEXT_AWARE) E.pre(cur, wr, wc, lane);
    f32x4 acc[2][2][4][2];
#pragma unroll
    for (int a = 0; a < 2; ++a)
#pragma unroll
        for (int b = 0; b < 2; ++b)
#pragma unroll
            for (int m = 0; m < 4; ++m)
#pragma unroll
                for (int n = 0; n < 2; ++n) acc[a][b][m][n] = (f32x4){0.f, 0.f, 0.f, 0.f};
    bf16x8 At[4][2], B0[2][2], B1[2][2]; i32x8 At8[4], B08[2], B18[2];
    {
        const char* cA = cur.a; const char* cB = cur.b0; const char* cB1 = G_BP(cur, 1);
        G_STAGE_B(G_SB(0, 0), cB); G_STAGE_B(G_SB(0, 1), cB + hstepB); G_STAGE_A(G_SA(0, 0), cA, offA, 0); G_STAGE_A(G_SA(0, 1), cA, offA, 1);
        if (wr == 1) G_BAR;
        G_WAIT_V(2); G_BAR;
        G_STAGE_B(G_SB(1, 0), cB1); G_STAGE_A(G_SA(1, 0), cA + kstep, offA, 0); G_STAGE_B(G_SB(1, 1), cB1 + hstepB);
        G_WAIT_V(6); G_BAR;
    }
    for (;;) {
        const bool has_next = S.next(ui + 1, nxt);
#if defined(EPI_PREFETCH)
        E.prefetch(cur, wr, wc, lane, (LAS unsigned*)(lds + JUNK_OFF + wid * 256));
#endif
        TP_BEGIN(100 + PH * 10);
#pragma nounroll
        for (int t = 0; t < NTT; t += 2) {
            const bool last = (t == NTT - 2);
            if constexpr (MID) { if (t == NTT / 2) { TP_BEGIN(102 + PH * 10); E.mid(acc, cur, wr, wc, fr, fq); TP_END(102 + PH * 10); } }
            if constexpr (GATHER) { if (t == NTT - 4 && has_next) S.offs(nxt, Rr, Cc, offAn); }
            const char* a1 = cur.a + (size_t)(t + 1) * kstep;
            const bool sw = last && has_next;
            const int t2 = last ? 0 : t + 2;
            const char* ua = sw ? nxt.a : cur.a; const char* ub0 = sw ? nxt.b0 : cur.b0; const char* ub1 = sw ? nxt.b1 : cur.b1;
            const char* a2 = ua + (size_t)t2 * kstep; const char* a3 = a2 + kstep;
            const char* b2 = (t2 < KS) ? ub0 + (size_t)t2 * kstep : ub1 + (size_t)(t2 - KS) * kstep;
            const char* b3 = (t2 + 1 < KS) ? ub0 + (size_t)(t2 + 1) * kstep : ub1 + (size_t)(t2 + 1 - KS) * kstep;
            G_LDB(B0, 0, 0); G_LDB(B1, 0, 1); G_SCHED; G_LDA(At, 0, 0); G_STAGE_A(G_SA(1, 1), a1, offA, 1);
            G_WAIT_V(8); G_WAIT_L(0); G_BAR; G_MMA(0, 0, At, B0); G_MMA(0, 1, At, B1); G_BAR; G_SCHED;
            if constexpr (GATHER) { if (sw) {
#pragma unroll
                for (int h = 0; h < 2; ++h)
#pragma unroll
                    for (int i = 0; i < 2; ++i) offA[h][i] = offAn[h][i]; } }
            G_LDA(At, 0, 1); G_STAGE_B(G_SB(0, 0), b2); G_STAGE_B(G_SB(0, 1), b2 + hstepB); G_STAGE_A(G_SA(0, 0), a2, offA, 0);
            G_WAIT_V(8); G_WAIT_L(0); G_BAR; if (F8 || !cur.half) { G_MMA(1, 0, At, B0); G_MMA(1, 1, At, B1); } G_BAR; G_SCHED;
            G_LDB(B0, 1, 0); G_LDB(B1, 1, 1); G_SCHED; G_LDA(At, 1, 0); G_STAGE_A(G_SA(0, 1), a2, offA, 1);
            G_WAIT_V(8); G_WAIT_L(0); G_BAR; G_MMA(0, 0, At, B0); G_MMA(0, 1, At, B1); G_BAR; G_SCHED;
            G_LDA(At, 1, 1); G_STAGE_B(G_SB(1, 0), b3); G_STAGE_B(G_SB(1, 1), b3 + hstepB); G_STAGE_A(G_SA(1, 0), a3, offA, 0);
            G_WAIT_V(8); G_WAIT_L(0); G_BAR; if (F8 || !cur.half) { G_MMA(1, 0, At, B0); G_MMA(1, 1, At, B1); } G_BAR; G_SCHED;
        }
        TP_END(100 + PH * 10); TP_BEGIN(101 + PH * 10);
        if (wr == 0) G_BAR;
        { int t2 = threadIdx.x; asm volatile("" : "+v"(t2)); const int l2 = t2 & 63;
          if constexpr (Epi::NEXT_AWARE) E.run2(acc, cur, nxt, has_next, wr, wc, l2 & 15, l2 >> 4); else E(acc, cur, wr, wc, l2 & 15, l2 >> 4); }
        TP_END(101 + PH * 10);
        if (!has_next) break;
#pragma unroll
        for (int a = 0; a < 2; ++a)
#pragma unroll
            for (int b = 0; b < 2; ++b)
#pragma unroll
                for (int m = 0; m < 4; ++m)
#pragma unroll
                    for (int n = 0; n < 2; ++n) acc[a][b][m][n] = (f32x4){0.f, 0.f, 0.f, 0.f};
        cur = nxt; ++ui;
        if (wr == 1) G_BAR;
    }
    G_WAIT_V(0);
    G_BAR;
#undef G_SA
#undef G_SB
#undef G_STAGE_A
#undef G_DMA
#undef G_STAGE_B
#undef G_LDA
#undef G_LDB
#undef G_MMA
#undef G_CAT2
#undef G_LDP
#undef G_AP
#undef G_BPTR
#undef G_WAIT_V
#undef G_WAIT_L
#undef G_BAR
#undef G_SCHED
#undef G_BP
}

__device__ __forceinline__ void st8(bf16_t* p, f32x4 v0, f32x4 v1) { u32x4 w; w.x = cvt_pk_bf16(v0[0], v0[1]); w.y = cvt_pk_bf16(v0[2], v0[3]); w.z = cvt_pk_bf16(v1[0], v1[1]); w.w = cvt_pk_bf16(v1[2], v1[3]); *(u32x4*)p = w; }
__device__ __forceinline__ void st8_wt(bf16_t* p, f32x4 v0, f32x4 v1) { u32x4 w; w.x = cvt_pk_bf16(v0[0], v0[1]); w.y = cvt_pk_bf16(v0[2], v0[3]); w.z = cvt_pk_bf16(v1[0], v1[1]); w.w = cvt_pk_bf16(v1[2], v1[3]);
    asm volatile("global_store_dwordx4 %0, %1, off sc0 sc1\n\ts_nop 1" :: "v"(p), "v"(w) : "memory"); }
__device__ __forceinline__ float sigm(float z) { return __builtin_amdgcn_rcpf(1.0f + __builtin_amdgcn_exp2f(-z * LOG2E)); }

__device__ __forceinline__ void touch(const void* p, LAS unsigned* junk) { __builtin_amdgcn_global_load_lds((const unsigned*)p, junk, 4, 0, 0); }

struct EpiProj {
    static constexpr bool PERM = true; static constexpr bool NEXT_AWARE = false;
    __device__ __forceinline__ void prefetch(const Unit&, int, int, int, LAS unsigned*) const {}
    bf16_t *U, *Q, *K, *V, *GP, *GA; const float *gq, *gk;
    __device__ __forceinline__ void mid(f32x4 (&)[2][2][4][2], const Unit&, int, int, int, int) const {}
    __device__ __forceinline__ void operator()(const f32x4 (&acc)[2][2][4][2], const Unit& u, int wr, int wc, int fr, int fq) const {
        const int pn = u.pn; const int row0 = u.pm * BM + wr * 64 + fr;
        if (pn < 2) {
            const int col0 = (pn & 1) * 256 + wc * 32 + 8 * fq;
#pragma unroll
            for (int ai = 0; ai < 2; ++ai)
#pragma unroll
                for (int m = 0; m < 4; ++m) { bf16_t* rowp = U + (size_t)(row0 + ai * HALF + m * 16) * 512 + col0;
#pragma unroll
                    for (int bj = 0; bj < 2; ++bj) st8(rowp + bj * HALF, acc[ai][bj][m][0], acc[ai][bj][m][1]); }
        } else if (pn == 6 || pn == 7) {
#pragma unroll
            for (int ai = 0; ai < 2; ++ai)
#pragma unroll
                for (int m = 0; m < 4; ++m) { const int row = row0 + ai * HALF + m * 16, b = row >> 11, t = row & 2047;
#pragma unroll
                    for (int bj = 0; bj < 2; ++bj) { const int bh = b * 4 + 2 * (pn - 6) + bj;
                        st8(V + ((((size_t)bh * 32 + (t >> 6)) * 16 + (wc * 4 + ((t >> 4) & 3))) * 16 + (t & 15)) * 32 + 8 * fq, acc[ai][bj][m][0], acc[ai][bj][m][1]); } }
        } else if (pn < 6) {
            const bool isq = pn < 4; bf16_t* base = isq ? Q : K; const float* g = isq ? gq : gk; const float sc = isq ? (0.125f * LOG2E) : 1.0f;
            f32x4 gv[2][2];
#pragma unroll
            for (int bj = 0; bj < 2; ++bj) { gv[bj][0] = *(const f32x4*)(g + 32 * bj + 8 * fq); gv[bj][1] = *(const f32x4*)(g + 32 * bj + 8 * fq + 4); }
            const int col0 = (pn & 1) * 256 + 64 * wc + 8 * fq;
#pragma unroll
            for (int ai = 0; ai < 2; ++ai)
#pragma unroll
                for (int m = 0; m < 4; ++m) {
                    float ss = 0.f;
#pragma unroll
                    for (int bj = 0; bj < 2; ++bj)
#pragma unroll
                        for (int n = 0; n < 2; ++n) { const f32x4 x = acc[ai][bj][m][n]; ss += (x[0] * x[0] + x[1] * x[1]) + (x[2] * x[2] + x[3] * x[3]); }
                    ss += __shfl_xor(ss, 16); ss += __shfl_xor(ss, 32);
                    const float rinv = __builtin_amdgcn_rsqf(ss * (1.0f / 64.0f) + EPS) * sc;
                    const int row = row0 + ai * HALF + m * 16;
                    if (isq) { bf16_t* rowp = base + (size_t)row * 512 + col0;
#pragma unroll
                        for (int bj = 0; bj < 2; ++bj) st8(rowp + 32 * bj, acc[ai][bj][m][0] * rinv * gv[bj][0], acc[ai][bj][m][1] * rinv * gv[bj][1]);
                    } else {
                        const int b = row >> 11, t = row & 2047, sh = (pn - 4) * 4 + wc, bh = b * 4 + (sh >> 1), mm = sh & 1;
#pragma unroll
                        for (int bj = 0; bj < 2; ++bj) st8(base + (((((size_t)bh * 2 + mm) * 32 + (t >> 6)) * 8 + (4 * bj + fq)) * 64 + (t & 63)) * 8, acc[ai][bj][m][0] * rinv * gv[bj][0], acc[ai][bj][m][1] * rinv * gv[bj][1]);
                    }
                }
        } else {
            const int col0 = (pn - 8) * 128 + wc * 32 + 8 * fq;
#pragma unroll
            for (int ai = 0; ai < 2; ++ai)
#pragma unroll
                for (int m = 0; m < 4; ++m) { const size_t off = (size_t)(row0 + ai * HALF + m * 16) * 1024 + col0;
                    f32x4 r0, r1, a0, a1;
#pragma unroll
                    for (int i = 0; i < 4; ++i) {
                        const float ea0 = __builtin_amdgcn_exp2f(-acc[ai][1][m][0][i] * LOG2E), ea1 = __builtin_amdgcn_exp2f(-acc[ai][1][m][1][i] * LOG2E);
                        a0[i] = __builtin_amdgcn_rcpf(1.0f + ea0); a1[i] = __builtin_amdgcn_rcpf(1.0f + ea1);
                        r0[i] = sigm(acc[ai][0][m][0][i]) * (1.0f + ea0); r1[i] = sigm(acc[ai][0][m][1][i]) * (1.0f + ea1); }
                    st8(GP + off, r0, r1); st8(GA + off, a0, a1); }
        }
    }
};

struct EpiMerge {
    static constexpr bool PERM = true; static constexpr bool NEXT_AWARE = false;
    const bf16_t *GP, *GA; bf16_t* O;
    __device__ __forceinline__ void prefetch(const Unit& u, int wr, int wc, int lane, LAS unsigned* junk) const {
#pragma unroll
        for (int q = 0; q < 4; ++q) { const int idx = q * 64 + lane, ri = idx >> 1, bj = idx & 1; const int row = u.pm * BM + 128 * (ri >> 6) + 64 * wr + (ri & 63);
            const size_t off = (size_t)row * 1024 + u.pn * BM + wc * 32 + bj * HALF; touch(GP + off, junk); touch(GA + off, junk); }
    }
    __device__ __forceinline__ void mid(f32x4 (&acc)[2][2][4][2], const Unit& u, int wr, int wc, int fr, int fq) const {
        int row0 = u.pm * BM + wr * 64 + fr; const int col0 = u.pn * BM + wc * 32 + 8 * fq;
        asm volatile("" : "+v"(row0));
#pragma unroll
        for (int ai = 0; ai < 2; ++ai) {
            u32x4 pv[4][2];
#pragma unroll
            for (int m = 0; m < 4; ++m) { const size_t off = (size_t)(row0 + ai * HALF + m * 16) * 1024 + col0;
#pragma unroll
                for (int bj = 0; bj < 2; ++bj) pv[m][bj] = __builtin_nontemporal_load((const u32x4*)(GP + off + bj * HALF)); }
#pragma unroll
            for (int m = 0; m < 4; ++m)
#pragma unroll
                for (int bj = 0; bj < 2; ++bj) { const u32x4 p = pv[m][bj];
                    const f32x4 r0 = {bflo(p.x), bfhi(p.x), bflo(p.y), bfhi(p.y)}, r1 = {bflo(p.z), bfhi(p.z), bflo(p.w), bfhi(p.w)};
                    acc[ai][bj][m][0] *= r0; acc[ai][bj][m][1] *= r1; }
            asm volatile("" ::: "memory");
        }
    }
    __device__ __forceinline__ void operator()(const f32x4 (&acc)[2][2][4][2], const Unit& u, int wr, int wc, int fr, int fq) const {
        const int row0 = u.pm * BM + wr * 64 + fr, col0 = u.pn * BM + wc * 32 + 8 * fq;
#pragma unroll
        for (int ai = 0; ai < 2; ++ai) {
            u32x4 av[4][2];
#pragma unroll
            for (int m = 0; m < 4; ++m)
#pragma unroll
                for (int bj = 0; bj < 2; ++bj) av[m][bj] = __builtin_nontemporal_load((const u32x4*)(GA + (size_t)(row0 + ai * HALF + m * 16) * 1024 + col0 + bj * HALF));
#pragma unroll
            for (int m = 0; m < 4; ++m)
#pragma unroll
                for (int bj = 0; bj < 2; ++bj) { const u32x4 a = av[m][bj];
                    const f32x4 g0 = {bflo(a.x), bfhi(a.x), bflo(a.y), bfhi(a.y)}, g1 = {bflo(a.z), bfhi(a.z), bflo(a.w), bfhi(a.w)};
                    st8(O + (size_t)(row0 + ai * HALF + m * 16) * 1024 + col0 + bj * HALF, acc[ai][bj][m][0] * g0, acc[ai][bj][m][1] * g1); }
            asm volatile("" ::: "memory");
        }
    }
};

struct EpiRes {
    static constexpr bool PERM = true; static constexpr bool NEXT_AWARE = false;
    const bf16_t* Hh; const float* rstd1; const float* g1; bf16_t* O;
    __device__ __forceinline__ void mid(f32x4 (&)[2][2][4][2], const Unit&, int, int, int, int) const {}
    __device__ __forceinline__ void operator()(const f32x4 (&acc)[2][2][4][2], const Unit& u, int wr, int wc, int fr, int fq) const {
        const int row0 = u.pm * BM + wr * 64 + fr, col0 = u.pn * BM + wc * 32 + 8 * fq;
        f32x4 ig[2][2];
#pragma unroll
        for (int bj = 0; bj < 2; ++bj)
#pragma unroll
            for (int n = 0; n < 2; ++n) { const f32x4 g = *(const f32x4*)(g1 + col0 + bj * HALF + 4 * n);
#pragma unroll
                for (int i = 0; i < 4; ++i) ig[bj][n][i] = __builtin_amdgcn_rcpf(g[i]); }
#pragma unroll
        for (int ai = 0; ai < 2; ++ai) {
            u32x4 hv[4][2]; float rr[4];
#pragma unroll
            for (int m = 0; m < 4; ++m) { const int row = row0 + ai * HALF + m * 16; rr[m] = rstd1[row];
#pragma unroll
                for (int bj = 0; bj < 2; ++bj) hv[m][bj] = __builtin_nontemporal_load((const u32x4*)(Hh + (size_t)row * 1024 + col0 + bj * HALF)); }
#pragma unroll
            for (int m = 0; m < 4; ++m) { const float ir = __builtin_amdgcn_rcpf(rr[m]);
#pragma unroll
                for (int bj = 0; bj < 2; ++bj) { const u32x4 h = hv[m][bj];
                    const f32x4 x0 = (f32x4){bflo(h.x), bfhi(h.x), bflo(h.y), bfhi(h.y)} * ig[bj][0] * ir, x1 = (f32x4){bflo(h.z), bfhi(h.z), bflo(h.w), bfhi(h.w)} * ig[bj][1] * ir;
                    st8_wt(O + (size_t)(row0 + ai * HALF + m * 16) * 1024 + col0 + bj * HALF, x0 + acc[ai][bj][m][0], x1 + acc[ai][bj][m][1]); } }
            asm volatile("" ::: "memory");
        }
    }
};

struct EpiMoe1 {
    static constexpr bool PERM = true; static constexpr bool NEXT_AWARE = false;
    __device__ __forceinline__ void prefetch(const Unit&, int, int, int, LAS unsigned*) const {}
    const float *SR, *SWLO, *SWHI; unsigned char* HDN;
    __device__ __forceinline__ void mid(f32x4 (&)[2][2][4][2], const Unit&, int, int, int, int) const {}
    __device__ __forceinline__ void operator()(const f32x4 (&acc)[2][2][4][2], const Unit& u, int wr, int wc, int fr, int fq) const {
        const int slot0 = u.pm * BM + wr * 64 + fr; const float* SW = (u.pn < 4) ? SWLO : SWHI;
        const int col0 = (u.pn >> 2) * 512 + (u.pn & 3) * 128 + wc * 32 + 8 * fq;
        float rsv[2][4], wv[2][4];
#pragma unroll
        for (int ai = 0; ai < 2; ++ai)
#pragma unroll
            for (int m = 0; m < 4; ++m) { const int r = wr * 64 + fr + ai * HALF + m * 16; rsv[ai][m] = SR[u.base + r]; wv[ai][m] = SW[u.base + r]; }
#pragma unroll
        for (int ai = 0; ai < 2; ++ai) { if (ai == 1 && u.half) break;
#pragma unroll
            for (int m = 0; m < 4; ++m) { const int slot = slot0 + ai * HALF + m * 16; const float rs = rsv[ai][m] * (1.0f / F8_WSCALE), w = wv[ai][m] * F8_HSCALE;
                f32x4 h0, h1;
#pragma unroll
                for (int i = 0; i < 4; ++i) { const float g0 = acc[ai][0][m][0][i] * rs, u0 = acc[ai][1][m][0][i] * rs, g1 = acc[ai][0][m][1][i] * rs, u1 = acc[ai][1][m][1][i] * rs;
                    h0[i] = g0 * sigm(g0) * u0 * w; h1[i] = g1 * sigm(g1) * u1 * w; }
                u32x2 w8; w8.x = pk4_f8(h0[0], h0[1], h0[2], h0[3]); w8.y = pk4_f8(h1[0], h1[1], h1[2], h1[3]); *(u32x2*)(HDN + (size_t)slot * 1024 + col0) = w8; } }
    }
};

struct EpiMoe2 {
    static constexpr bool PERM = true; static constexpr bool NEXT_AWARE = true;
    const int* STOK; const bf16_t* X1; float* O; LAS int* TKL;
    __device__ __forceinline__ void prefetch(const Unit& u, int wr, int wc, int lane, LAS unsigned* junk) const {
#pragma unroll
        for (int q = 0; q < 4; ++q) { const int idx = q * 64 + lane, ri = idx >> 1, bj = idx & 1; int tok = STOK[u.pm * BM + 128 * (ri >> 6) + 64 * wr + (ri & 63)]; tok = tok < 0 ? 0 : tok;
            touch(X1 + (size_t)tok * 1024 + u.pn * BM + wc * 32 + bj * HALF, junk); }
    }
    __device__ __forceinline__ void mid(f32x4 (&)[2][2][4][2], const Unit&, int, int, int, int) const {}
    __device__ __forceinline__ void pre(const Unit& u, int wr, int wc, int lane) const {
        LAS int* z = TKL + (wr * 4 + wc) * 128 + lane;
        const int a = STOK[u.base + wr * 64 + lane], b = STOK[u.base + wr * 64 + HALF + lane];
        z[0] = a; z[64] = b;
        asm volatile("s_waitcnt lgkmcnt(0)" ::: "memory");
    }
    __device__ __forceinline__ void run2(const f32x4 (&acc)[2][2][4][2], const Unit& u, const Unit& nx, bool has_next, int wr, int wc, int fr, int fq) const {
        int fr_ = fr, fq_ = fq; asm volatile("" : "+v"(fr_), "+v"(fq_));
        const int slot0 = u.pm * BM + wr * 64 + fr_, col0 = u.pn * BM + wc * 32 + 8 * fq_;
        int tk[2][4];
        { const LAS int* z = TKL + (wr * 4 + wc) * 128 + fr_;
#pragma unroll
          for (int ai = 0; ai < 2; ++ai)
#pragma unroll
            for (int m = 0; m < 4; ++m) { const int r = wr * 64 + fr_ + ai * HALF + m * 16; const int v = z[ai * 64 + m * 16]; tk[ai][m] = (r < u.rows) ? v : -1; } }
        asm volatile("s_waitcnt lgkmcnt(0)" ::: "memory");
        int na = 0, nb = 0;
        if (has_next) { const int ln = fr_ + 16 * fq_; na = STOK[nx.base + wr * 64 + ln]; nb = STOK[nx.base + wr * 64 + HALF + ln]; }
#pragma unroll
        for (int ai = 0; ai < 2; ++ai) { if (ai == 1 && u.half) break;
#pragma unroll
            for (int mp = 0; mp < 1; ++mp) {
                u32x4 xv[4][2];
#pragma unroll
                for (int mi = 0; mi < 4; ++mi) { const int m = mp * 4 + mi; const int tok = tk[ai][m] < 0 ? 0 : tk[ai][m];
#pragma unroll
                    for (int bj = 0; bj < 2; ++bj) xv[mi][bj] = *(const u32x4*)(X1 + (size_t)tok * 1024 + col0 + bj * HALF); }
#pragma unroll
                for (int mi = 0; mi < 4; ++mi) { const int m = mp * 4 + mi; const int tok = tk[ai][m];
                    if (tok >= 0) { const size_t off = (size_t)tok * 1024 + col0;
#pragma unroll
                        for (int bj = 0; bj < 2; ++bj) { const u32x4 x = xv[mi][bj];
                            const f32x4 x0 = {bflo(x.x), bfhi(x.x), bflo(x.y), bfhi(x.y)}, x1 = {bflo(x.z), bfhi(x.z), bflo(x.w), bfhi(x.w)};
                            constexpr float SC = 1.0f / (F8_WSCALE * F8_HSCALE);
                            *(f32x4*)(O + off + bj * HALF) = x0 + acc[ai][bj][m][0] * SC; *(f32x4*)(O + off + bj * HALF + 4) = x1 + acc[ai][bj][m][1] * SC; } } }
                asm volatile("" ::: "memory");
            }
        }
        if (has_next) { LAS int* zn = TKL + (wr * 4 + wc) * 128 + fr_ + 16 * fq_; zn[0] = na; zn[64] = nb; asm volatile("s_waitcnt lgkmcnt(0)" ::: "memory"); }
    }
};

struct MoeSched {
    const LAS int* tab; const char* A; const char* B; const int* STOK; int mode;
    __device__ __forceinline__ bool next(int i, Unit& u) const {
        if (i >= 16) return false;
        const int tile = __builtin_amdgcn_readfirstlane(tab[i * 8 + 0]); if (tile < 0) return false;
        const int pn = __builtin_amdgcn_readfirstlane(tab[i * 8 + 1]), e0 = __builtin_amdgcn_readfirstlane(tab[i * 8 + 2]), e1 = __builtin_amdgcn_readfirstlane(tab[i * 8 + 3]);
        u.pm = tile; u.pn = pn; u.e0 = e0; u.e1 = e1; u.half = __builtin_amdgcn_readfirstlane(tab[i * 8 + 4]); u.base = __builtin_amdgcn_readfirstlane(tab[i * 8 + 5]); u.rows = __builtin_amdgcn_readfirstlane(tab[i * 8 + 6]);
        if (mode == 1) { const int e = (pn < 4) ? e0 : e1; u.a = A; u.b0 = B + ((size_t)e * 1024 * 1024 + (size_t)(pn & 3) * 256 * 1024); u.b1 = u.b0; }
        else { u.a = A + (size_t)tile * 256 * 1024; u.b0 = B + ((size_t)e0 * 1024 + (size_t)pn * 256) * 512; u.b1 = B + ((size_t)e1 * 1024 + (size_t)pn * 256) * 512; }
        return true;
    }
    __device__ __forceinline__ void offs(const Unit& u, const int (&Rr)[2], const int (&Cc)[2], unsigned (&off)[2][2]) const {
#pragma unroll
        for (int h = 0; h < 2; ++h)
#pragma unroll
            for (int i = 0; i < 2; ++i) { const int r = h * 128 + Rr[i]; const int tok = (r < u.rows) ? STOK[u.base + r] : 0; off[h][i] = (unsigned)tok * 1024u + (unsigned)Cc[i] * 2u; }
    }
};
}

namespace att {
__device__ __forceinline__ int crow(int r, int hi) { return (r & 3) + 8 * (r >> 2) + 4 * hi; }
__device__ __forceinline__ void glds16(const void* gsrc, unsigned lds_dst) { unsigned keep;
    asm volatile("s_mov_b32 %0, m0\n\ts_mov_b32 m0, %2\n\ts_nop 0\n\tglobal_load_lds_dwordx4 %1, off\n\ts_mov_b32 m0, %0" : "=&s"(keep) : "v"(gsrc), "s"(lds_dst) : "memory"); }
typedef __attribute__((address_space(3))) const char* lds_cptr;
typedef short v4i16_t __attribute__((ext_vector_type(4)));
__device__ __forceinline__ s16x4 vtr(lds_cptr p) { return __builtin_bit_cast(s16x4, __builtin_amdgcn_ds_read_tr16_b64_v4i16((__attribute__((address_space(3))) v4i16_t*)p)); }
#if defined(ATT_SETPRIO)
#define ATT_PRIO(p) __builtin_amdgcn_s_setprio(p)
#else
#define ATT_PRIO(p)
#endif
#define ATT_WAIT_BAR() asm volatile("s_waitcnt vmcnt(0) lgkmcnt(0)\n\ts_barrier" ::: "memory")
constexpr int SLOT = 32768;
constexpr int WSF_OFF = LDSCTL_OFF + 2048;
constexpr int XCH_OFF = 0;

__device__ __forceinline__ void unit_of(int idx, int& h, int& qb) { if (idx < 32) { h = 3 - (idx & 1); qb = 15 - (idx >> 1); } else if (idx < 48) { h = 1; qb = 47 - idx; } else { h = 0; qb = 63 - idx; } }
__device__ __forceinline__ float slope_of(int h) { return LOG2E * __builtin_amdgcn_exp2f(-2.0f * (float)(h + 1)); }
__device__ __forceinline__ int first_tile(int q0, float aslope, float B2) { const int Dk = (int)((2.0f * B2 + 30.2f) / aslope) + 1; const int ts = q0 - Dk; return ts < 0 ? 0 : (ts >> 6); }

__device__ __forceinline__ void attn_batch(int b, unsigned* qh, LAS int* tick, const bf16_t* Q, const bf16_t* K, const bf16_t* V, bf16_t* DO, char* shm, float B2, float lam, const float* subg TP_PARAMS) {
    const int tid = threadIdx.x, lane = tid & 63, r32 = lane & 31, hi = lane >> 5; const int wid = __builtin_amdgcn_readfirstlane(tid >> 6);
    const int mm = wid >> 2, wq = wid & 3;
    const long rowbase = (long)b * SEQ;
    const unsigned lds0 = (unsigned)(uintptr_t)shm; const lds_cptr shm3 = (lds_cptr)shm;
    float* wsf = (float*)(shm + WSF_OFF) + wid * 64;
    const bf16_t* Qb = Q + (rowbase + wq * 32 + r32) * 512 + mm * 64 + hi * 8;
    const bf16_t* Kb = K + (((size_t)(b * 4) * 2) * 32 * 8 + wid) * 512 + lane * 8;
    const bf16_t* Vb = V + ((size_t)(b * 4) * 32 * 16 + 2 * wid) * 512 + lane * 8;
    const int p0i = 2 * wid, p1i = 2 * wid + 1;
#define ATT_DMA4(k0, k1, v0, t, slot) do { const unsigned _s = lds0 + (unsigned)(slot) * SLOT; \
        glds16((k0) + (size_t)(t) * 4096, (unsigned)__builtin_amdgcn_readfirstlane(_s + wid * 1024)); glds16((k1) + (size_t)(t) * 4096, (unsigned)__builtin_amdgcn_readfirstlane(_s + 8192 + wid * 1024)); \
        glds16((v0) + (size_t)(t) * 8192, (unsigned)__builtin_amdgcn_readfirstlane(_s + 16384 + p0i * 1024)); glds16((v0) + 512 + (size_t)(t) * 8192, (unsigned)__builtin_amdgcn_readfirstlane(_s + 16384 + p1i * 1024)); } while (0)
    int cur, nxt;
    if (tid == 0) { tick[0] = (int)atomicAdd(qh, 1u); tick[1] = (int)atomicAdd(qh, 1u); }
    __syncthreads();
    cur = tick[0]; nxt = tick[1];
    __syncthreads();
    bf16x8 qr[4];
    int sofs = 0;
#pragma unroll
    for (int ks = 0; ks < 4; ++ks) qr[ks] = bf16x8{};
    if (cur < 64) { int h, qb; unit_of(cur, h, qb);
        const bf16_t* Qw = Qb + (size_t)(qb * 128) * 512 + h * 128;
#pragma unroll
        for (int ks = 0; ks < 4; ++ks) qr[ks] = *(const bf16x8*)(Qw + ks * 16);
        const int ts = first_tile(qb * 128, slope_of(h), B2);
        const bf16_t* k0 = Kb + (size_t)h * 262144, *v0 = Vb + (size_t)h * 262144;
        ATT_DMA4(k0, k0 + 131072, v0, ts, 3); ATT_DMA4(k0, k0 + 131072, v0, ts + 1, 0); sofs = (3 - ts) & 3; }
    __builtin_amdgcn_s_waitcnt(0x0F70);
    const int vlane = ((lane >> 4) & 1) * 32 + (lane & 3) * 8 + (4 * hi + ((lane & 15) >> 2)) * 64;
    u32x4 kbias0, kbias1;
    { const unsigned j0b = f2bf((float)r32), j1b = f2bf((float)(r32 + 32));
      kbias0 = hi ? (u32x4){0u, 0u, 0u, 0u} : (u32x4){j0b | (j0b << 16), j0b, 0u, 0u};
      kbias1 = hi ? (u32x4){0u, 0u, 0u, 0u} : (u32x4){j1b | (j1b << 16), j1b, 0u, 0u}; }
    while (cur < 64) {
    TP_BEGIN(25);
    int h, qb; unit_of(cur, h, qb);
    const int q0 = qb * 128, i0 = q0 + wq * 32;
    const float aslope = slope_of(h);
    const bf16_t* ksrc0 = Kb + (size_t)h * 262144; const bf16_t* ksrc1 = ksrc0 + 131072; const bf16_t* vsrc0 = Vb + (size_t)h * 262144;
    const int NTL = 2 * qb + 2;
    const int ts = first_tile(q0, aslope, B2);
    const int Ls = (NTL - 1 + sofs) & 3;
    int sofs_n = 0;
#define ATT_DMA(t, slot) ATT_DMA4(ksrc0, ksrc1, vsrc0, t, slot)
    f32x16 o[4]; o[0] = f32x16{}; o[1] = f32x16{}; o[2] = f32x16{}; o[3] = f32x16{};
    float l_reg = 0.f;
    const int irow = i0 + r32;
    u32x4 qbias;
    { const float a_h = bf2f((unsigned short)f2bf(aslope)), r1 = aslope - a_h, a_m = bf2f((unsigned short)f2bf(r1)), a_l = bf2f((unsigned short)f2bf(r1 - a_m));
      qbias  = hi ? (u32x4){0u, 0u, 0u, 0u} : (u32x4){f2bf(a_h) | (f2bf(a_m) << 16), f2bf(a_l), 0u, 0u}; }
    TP_END(25);
    f32x16 cini; { const float c0 = aslope * (float)(64 * ts - irow) - B2; _Pragma("unroll") for (int r = 0; r < 16; ++r) cini[r] = c0; }
    const float cstep = 64.0f * aslope;
#define ATT_VRD(g) vtr(vp + ((g) >> 2) * 4096 + ((g) & 3) * 1024), vtr(vp + ((g) >> 2) * 4096 + ((g) & 3) * 1024 + 512)
#define ATT_VG(n) (4 * ((n) & 3) + ((n) >> 2))
#define ATT_KF(s) (*(const bf16x8*)(kb + (((s) & 3)) * 2048 + ((s) >> 2) * 512))
#define ATT_EXP2(MASKED, q, i) do { _Pragma("unroll") for (int e_ = 0; e_ < 2; ++e_) { const int r_ = 8 * ((q) & 1) + 2 * (i) + e_; \
            if (MASKED) { const int j_ = j0 + 4 * hi + (r_ & 3) + 8 * (r_ >> 2) + 32 * ((q) >> 1); if (j_ > irow) p[(q) >> 1][r_] = -1.0e30f; } \
            p[(q) >> 1][r_] = __builtin_amdgcn_exp2f(p[(q) >> 1][r_]); sacc += p[(q) >> 1][r_]; } } while (0)
#define ATT_PACK(q) do { const int b_ = 8 * ((q) & 1);          \
        asm("s_nop 0\n\tv_cvt_pk_bf16_f32 %0, %4, %5\n\tv_cvt_pk_bf16_f32 %1, %6, %7\n\tv_cvt_pk_bf16_f32 %2, %8, %9\n\tv_cvt_pk_bf16_f32 %3, %10, %11\n\ts_nop 1" \
            : "=&v"(pw[q].x), "=&v"(pw[q].y), "=&v"(pw[q].z), "=&v"(pw[q].w) \
            : "v"(p[(q) >> 1][b_ + 0]), "v"(p[(q) >> 1][b_ + 1]), "v"(p[(q) >> 1][b_ + 2]), "v"(p[(q) >> 1][b_ + 3]), "v"(p[(q) >> 1][b_ + 4]), "v"(p[(q) >> 1][b_ + 5]), "v"(p[(q) >> 1][b_ + 6]), "v"(p[(q) >> 1][b_ + 7])); } while (0)
#define ATT_TILE(MASKED) do { \
        TP_BEGIN(21); \
        if (t + 1 < NTL) asm volatile("s_waitcnt vmcnt(4) lgkmcnt(0)\n\ts_barrier" ::: "memory"); else ATT_WAIT_BAR(); \
        TP_END(21); \
        if ((MASKED) && t == NTL - 1) {                              \
            int nx_ = nxt; asm volatile("" : "+v"(nx_));            \
            if (nx_ < 64) { int hn, qbn; unit_of(nx_, hn, qbn); \
                const int tsn = first_tile(qbn * 128, slope_of(hn), B2); \
                const bf16_t* kn = Kb + (size_t)hn * 262144; const bf16_t* vn = Vb + (size_t)hn * 262144; \
                ATT_DMA4(kn, kn + 131072, vn, tsn, (Ls + 1) & 3); ATT_DMA4(kn, kn + 131072, vn, tsn + 1, (Ls + 2) & 3); \
                sofs_n = (Ls + 1 - tsn) & 3; } } \
        const bool dm = (t + 2 < NTL); const unsigned dsl = lds0 + (unsigned)((t + 2 + sofs) & 3) * SLOT; (void)dsl; \
        TP_BEGIN(23); \
        const int j0 = 64 * t; \
        if (!(MASKED) || j0 <= i0 + 31) { \
            const int sl = (t + sofs) & 3; \
            const char* kb = shm + sl * SLOT + mm * 8192 + hi * 1024 + r32 * 16; \
            const lds_cptr vp = shm3 + sl * SLOT + 16384 + vlane; \
            bf16x8 kf[2]; kf[0] = ATT_KF(0); kf[1] = ATT_KF(1); \
            f32x16 p[2]; u32x4 pw[4]; s16x4 vf[2][2]; float sacc = 0.f; \
            __builtin_amdgcn_sched_barrier(0); ATT_PRIO(1); \
            p[0] = __builtin_amdgcn_mfma_f32_32x32x16_bf16(__builtin_bit_cast(bf16x8, kbias0), __builtin_bit_cast(bf16x8, qbias), cini, 0, 0, 0); \
            __builtin_amdgcn_sched_barrier(0); \
            _Pragma("unroll") for (int s = 0; s < 4; ++s) { \
                p[0] = __builtin_amdgcn_mfma_f32_32x32x16_bf16(kf[s & 1], qr[s], p[0], 0, 0, 0); \
                kf[s & 1] = ATT_KF(s + 2); \
                __builtin_amdgcn_sched_barrier(0); } \
            p[1] = __builtin_amdgcn_mfma_f32_32x32x16_bf16(__builtin_bit_cast(bf16x8, kbias1), __builtin_bit_cast(bf16x8, qbias), cini, 0, 0, 0); \
            __builtin_amdgcn_sched_barrier(0); \
            _Pragma("unroll") for (int s = 4; s < 8; ++s) { \
                p[1] = __builtin_amdgcn_mfma_f32_32x32x16_bf16(kf[s & 1], qr[s - 4], p[1], 0, 0, 0); \
                if (s + 2 < 8) kf[s & 1] = ATT_KF(s + 2); \
                if (s >= 6) { const s16x4 a3[2] = {ATT_VRD(ATT_VG(s - 6))}; vf[s - 6][0] = a3[0]; vf[s - 6][1] = a3[1]; } \
                ATT_EXP2(MASKED, 0, s - 4); \
                __builtin_amdgcn_sched_barrier(0); } \
            ATT_PACK(0); \
            __builtin_amdgcn_sched_barrier(0); \
            TP_END(23); TP_BEGIN(24); \
            _Pragma("unroll") for (int n = 0; n < 16; ++n) { \
                const s16x4 lo = vf[n & 1][0], hh = vf[n & 1][1]; \
                const bf16x8 vfr = (bf16x8){lo[0], lo[1], lo[2], lo[3], hh[0], hh[1], hh[2], hh[3]}; \
                o[n & 3] = __builtin_amdgcn_mfma_f32_32x32x16_bf16(__builtin_bit_cast(bf16x8, pw[n >> 2]), vfr, o[n & 3], 0, 0, 0); \
                if (n + 2 < 16) { const s16x4 a3[2] = {ATT_VRD(ATT_VG(n + 2))}; vf[n & 1][0] = a3[0]; vf[n & 1][1] = a3[1]; } \
                if (n < 12) { ATT_EXP2(MASKED, (n >> 2) + 1, n & 3); if ((n & 3) == 3) ATT_PACK((n >> 2) + 1); } \
                if (dm) { \
                    if (n == 1) glds16(ksrc0 + (size_t)(t + 2) * 4096, (unsigned)__builtin_amdgcn_readfirstlane(dsl + wid * 1024)); \
                    if (n == 5) glds16(ksrc1 + (size_t)(t + 2) * 4096, (unsigned)__builtin_amdgcn_readfirstlane(dsl + 8192 + wid * 1024)); \
                    if (n == 9) glds16(vsrc0 + (size_t)(t + 2) * 8192, (unsigned)__builtin_amdgcn_readfirstlane(dsl + 16384 + p0i * 1024)); \
                    if (n == 13) glds16(vsrc0 + 512 + (size_t)(t + 2) * 8192, (unsigned)__builtin_amdgcn_readfirstlane(dsl + 16384 + p1i * 1024)); } \
                __builtin_amdgcn_sched_barrier(0); } \
            ATT_PRIO(0); \
            l_reg += sacc; \
            TP_END(24); TP_BEGIN(23); \
        } TP_END(23); \
        _Pragma("unroll") for (int r = 0; r < 16; ++r) cini[r] += cstep; } while (0)
    int t = ts;
    for (; t < NTL - 2; ++t) ATT_TILE(false);
    for (; t < NTL; ++t) ATT_TILE(true);
    TP_BEGIN(26);
    int tk = 64; if (tid == 0) tk = (int)atomicAdd(qh, 1u);
    bf16x8 qn[4];
#pragma unroll
    for (int ks = 0; ks < 4; ++ks) qn[ks] = qr[ks];
    if (nxt < 64) { int hn, qbn; unit_of(nxt, hn, qbn);
        const bf16_t* Qn_ = Qb + (size_t)(qbn * 128) * 512 + hn * 128;
#pragma unroll
        for (int ks = 0; ks < 4; ++ks) qn[ks] = *(const bf16x8*)(Qn_ + ks * 16); }
    { auto rr = __builtin_amdgcn_permlane32_swap(__float_as_uint(l_reg), __float_as_uint(l_reg), false, false); l_reg = __uint_as_float(rr[0]) + __uint_as_float(rr[1]); }
    if (hi == 0) wsf[r32] = l_reg;
    asm volatile("s_waitcnt lgkmcnt(0)" ::: "memory");
    const float fac = (mm == 0) ? 1.0f : lam;
#pragma unroll
    for (int r = 0; r < 16; ++r) { const float rl = fac * __builtin_amdgcn_rcpf(wsf[crow(r, hi)]);
#pragma unroll
        for (int d0 = 0; d0 < 4; ++d0) o[d0][r] *= rl; }
    TP_BEGIN(27);
    asm volatile("s_waitcnt lgkmcnt(0)\n\ts_barrier" ::: "memory");
    TP_END(27); TP_BEGIN(28);
    char* xbase = shm + ((wq < 2) ? Ls : ((Ls + 3) & 3)) * SLOT + (wq & 1) * 16384;
    float* xs = (float*)(xbase + mm * 8192);
    float* xr = (float*)(xbase + (mm ^ 1) * 8192);
    const int rk0 = mm ? 8 : 0;
#pragma unroll
    for (int rr = 0; rr < 8; ++rr)
#pragma unroll
        for (int d0 = 0; d0 < 4; ++d0) { const int r = rr + 8; const float vs = mm ? o[d0][rr] : o[d0][r];
            xs[(crow(rr, hi)) * 128 + 32 * d0 + r32] = vs; }
    asm volatile("s_waitcnt lgkmcnt(0)\n\ts_barrier" ::: "memory");
    { float gsub[4], oth[4][4];
#pragma unroll
      for (int d0 = 0; d0 < 4; ++d0) gsub[d0] = subg[32 * d0 + r32] * 0.8f;
#pragma unroll
      for (int rr = 0; rr < 4; ++rr)
#pragma unroll
          for (int d0 = 0; d0 < 4; ++d0) oth[rr][d0] = xr[crow(rr, hi) * 128 + 32 * d0 + r32];
      asm volatile("s_waitcnt lgkmcnt(0)" ::: "memory");
#pragma unroll
      for (int rr = 0; rr < 8; ++rr) {
          float ov[4], ss = 0.f;
#pragma unroll
          for (int d0 = 0; d0 < 4; ++d0) { const float other = (rr < 4) ? oth[rr & 3][d0] : xr[crow(rr, hi) * 128 + 32 * d0 + r32]; const float mine = mm ? o[d0][rr + 8] : o[d0][rr];
              ov[d0] = mm ? (other - mine) : (mine - other); ss += ov[d0] * ov[d0]; }
          ss += __shfl_xor(ss, 1); ss += __shfl_xor(ss, 2); ss += __shfl_xor(ss, 4); ss += __shfl_xor(ss, 8); ss += __shfl_xor(ss, 16);
          const float rinv = __builtin_amdgcn_rsqf(ss * (1.0f / 128.0f) + EPS);
          bf16_t* srow = (bf16_t*)xr + crow(rr, hi) * 128 + r32;
#pragma unroll
          for (int d0 = 0; d0 < 4; ++d0) srow[32 * d0] = (bf16_t)f2bf(ov[d0] * rinv * gsub[d0]);
      } }
    (void)rk0;
    __builtin_amdgcn_s_waitcnt(0x0F70);
    if (tid == 0) tick[0] = tk;
    asm volatile("s_waitcnt lgkmcnt(0)\n\ts_barrier" ::: "memory");
    const int nn = tick[0];
    { const int row = tid >> 2, q4 = tid & 3;
      const int wr_ = row >> 5, mr_ = (row >> 4) & 1;
      const bf16_t* sp = (const bf16_t*)(shm + ((wr_ < 2) ? Ls : ((Ls + 3) & 3)) * SLOT + (wr_ & 1) * 16384 + (mr_ ^ 1) * 8192) + (row & 15) * 128 + q4 * 32;
      bf16_t* gp = DO + (size_t)(rowbase + q0 + row) * 1024 + 512 + h * 128 + q4 * 32;
      u32x4 v[4];
#pragma unroll
      for (int i = 0; i < 4; ++i) v[i] = *(const u32x4*)(sp + i * 8);
#pragma unroll
      for (int i = 0; i < 4; ++i) *(u32x4*)(gp + i * 8) = v[i]; }
    asm volatile("s_waitcnt lgkmcnt(0)" ::: "memory");
    TP_END(28);
    TP_END(26);
#pragma unroll
    for (int ks = 0; ks < 4; ++ks) qr[ks] = qn[ks];
    cur = nxt; nxt = nn; sofs = sofs_n;
#undef ATT_DMA
    }
    asm volatile("s_waitcnt vmcnt(0)" ::: "memory");
    __syncthreads();
#undef ATT_TILE
#undef ATT_VG
#undef ATT_KF
#undef ATT_EXP2
#undef ATT_PACK
#undef ATT_VRD
#undef ATT_DMA4
}
}

struct Args { const float* in[23]; float* out; unsigned char* ws; };

__device__ __forceinline__ float wave_sum(float v) {
#pragma unroll
    for (int o = 1; o < 64; o <<= 1) v += __shfl_xor(v, o);
    return v;
}
__device__ __forceinline__ float wave_max(float v) {
#pragma unroll
    for (int o = 1; o < 64; o <<= 1) v = fmaxf(v, __shfl_xor(v, o));
    return v;
}

template <class DstF>
__device__ __forceinline__ void transpose_item(const float* W, int N, int k0, int n0, LAS float* scr, int lane, const float* ksc, DstF dst) {
    const int kk = lane >> 3, n4 = (lane & 7) * 4;
    f32x4 v[8];
#pragma unroll
    for (int j = 0; j < 8; ++j) v[j] = __builtin_nontemporal_load((const f32x4*)(W + (size_t)(k0 + kk + 8 * j) * N + n0 + n4));
#pragma unroll
    for (int j = 0; j < 8; ++j) { LAS float* d = scr + (kk + 8 * j) * 33 + n4; d[0] = v[j][0]; d[1] = v[j][1]; d[2] = v[j][2]; d[3] = v[j][3]; }
    LDS_WAIT(); asm volatile("" ::: "memory");
    const int c = lane & 7;
    f32x4 s0 = {1.f, 1.f, 1.f, 1.f}, s1 = s0;
    if (ksc) { s0 = *(const f32x4*)(ksc + k0 + 8 * c); s1 = *(const f32x4*)(ksc + k0 + 8 * c + 4); }
#pragma unroll
    for (int j = 0; j < 4; ++j) { const int n = (lane >> 3) + 8 * j; const LAS float* s = scr + (8 * c) * 33 + n;
        u32x4 o; o.x = pk2(s[0 * 33] * s0[0], s[1 * 33] * s0[1]); o.y = pk2(s[2 * 33] * s0[2], s[3 * 33] * s0[3]); o.z = pk2(s[4 * 33] * s1[0], s[5 * 33] * s1[1]); o.w = pk2(s[6 * 33] * s1[2], s[7 * 33] * s1[3]);
        *(GAS u32x4*)(dst(n0 + n) + k0 + 8 * c) = o; }
    LDS_WAIT(); asm volatile("" ::: "memory");
}

template <class DstF>
__device__ __forceinline__ void transpose_item_f8(const float* W, int N, int k0, int n0, LAS float* scr, int lane, const float* ksc, float mult, DstF dst8) {
    const int kk = lane >> 3, n4 = (lane & 7) * 4;
    f32x4 v[8];
#pragma unroll
    for (int j = 0; j < 8; ++j) v[j] = __builtin_nontemporal_load((const f32x4*)(W + (size_t)(k0 + kk + 8 * j) * N + n0 + n4));
#pragma unroll
    for (int j = 0; j < 8; ++j) { LAS float* d = scr + (kk + 8 * j) * 33 + n4; d[0] = v[j][0]; d[1] = v[j][1]; d[2] = v[j][2]; d[3] = v[j][3]; }
    LDS_WAIT(); asm volatile("" ::: "memory");
    const int c = lane & 7;
    f32x4 s0 = {mult, mult, mult, mult}, s1 = s0;
    if (ksc) { s0 = s0 * *(const f32x4*)(ksc + k0 + 8 * c); s1 = s1 * *(const f32x4*)(ksc + k0 + 8 * c + 4); }
#pragma unroll
    for (int j = 0; j < 4; ++j) { const int n = (lane >> 3) + 8 * j; const LAS float* s = scr + (8 * c) * 33 + n;
        u32x2 o; o.x = pk4_f8(s[0 * 33] * s0[0], s[1 * 33] * s0[1], s[2 * 33] * s0[2], s[3 * 33] * s0[3]); o.y = pk4_f8(s[4 * 33] * s1[0], s[5 * 33] * s1[1], s[6 * 33] * s1[2], s[7 * 33] * s1[3]);
        *(GAS u32x2*)(dst8(n0 + n) + k0 + 8 * c) = o; }
    LDS_WAIT(); asm volatile("" ::: "memory");
}

#define PH_BEGIN() unsigned char* ws = args.ws; asm volatile("" : "+s"(ws)); int tid = threadIdx.x; asm volatile("" : "+v"(tid)); \
    const int lane = tid & 63, wave = __builtin_amdgcn_readfirstlane(tid >> 6); const int G = gridDim.x, bx = blockIdx.x; \
    const int vcu = (G % 8 == 0) ? (bx % 8) * (G / 8) + bx / 8 : bx; const int gw = vcu * NWAVES + wave, NGW = G * NWAVES; \
    gu32* ctl = (gu32*)(ws + WS_CTL); (void)lane; (void)wave; (void)gw; (void)NGW; (void)ctl; (void)vcu
#define WSP(T, off) ((T*)(ws + (off)))

#ifndef DEPHASE3
#define DEPHASE3 0
#endif
#ifndef DEPHASE4
#define DEPHASE4 0
#endif
#ifndef DEPHASE8
#define DEPHASE8 0
#endif
__device__ __forceinline__ void dephase(int vcu, unsigned ticks) {
    if ((vcu & 1) && ticks) { const unsigned long long t0 = __builtin_amdgcn_s_memrealtime(); while (__builtin_amdgcn_s_memrealtime() - t0 < ticks) __builtin_amdgcn_s_sleep(16); }
}
__global__ void __launch_bounds__(NWAVES * 64, 2) hybrid_fwd(Args args) {
    extern __shared__ __attribute__((aligned(16))) unsigned char lds[];
    LAS unsigned char* L = (LAS unsigned char*)lds;
    volatile LAS unsigned* MISC = (volatile LAS unsigned*)(L + MISC_OFF);
    for (int u = threadIdx.x; u < (LDS_BYTES - LDSCTL_OFF) / 4; u += NWAVES * 64) ((LAS unsigned*)(L + LDSCTL_OFF))[u] = 0u;
    __syncthreads();
    XcdBarrier bar = xcd_barrier_post((unsigned*)((gu32*)(args.ws + WS_CTL) + CW_BAR), MISC + 8);
    TP_DECL();

    TP_BEGIN(10);
    if (PHASE_MASK & 1) REPS(1) {
        PH_BEGIN();
        bf16_t* WinT = WSP(bf16_t, WS_WIN); bf16_t* WmT = WSP(bf16_t, WS_WM); bf16_t* WoT = WSP(bf16_t, WS_WO); unsigned char* Wgu8 = WSP(unsigned char, WS_WGU); unsigned char* Wd8 = WSP(unsigned char, WS_WD);
        bf16_t* WrH = WSP(bf16_t, WS_WRH); bf16_t* WrL = WSP(bf16_t, WS_WRL); bf16_t* Hb = WSP(bf16_t, WS_H);
        LAS float* scr = (LAS float*)(L + wave * 16384);
        constexpr int I_IN = 16 * 128, I_AU = 8 * 32, I_OUT = 16 * 32, I_G = 32 * 256, I_U = 32 * 256, I_D = 32 * 256;
        constexpr int NITEMS = I_IN + I_AU + I_OUT + I_G + I_U + I_D;
        TP_BEGIN(30);
        for (int it = gw; it < NITEMS; it += NGW) {
            int r = it;
            if (r < I_IN) { const int kb = r / 128, nb = r % 128;
                transpose_item(args.in[2], 4096, kb * 64, nb * 32, scr, lane, nullptr, [&](int n) -> bf16_t* {
                    int v = n; if (n >= 512 && n < 1536) { const int l = n & 255; v = (n & ~255) + 128 * ((l >> 5) & 1) + 32 * (l >> 6) + (l & 31); }
                    else if (n >= 2048) { const int c = (n - 2048) & 1023; v = 2048 + 256 * (c >> 7) + (c & 127) + ((n >= 3072) ? 128 : 0); }
                    return WinT + (size_t)v * 1024; });
                continue; } r -= I_IN;
            if (r < I_AU) { const int kb = r / 32, nb = r % 32;
                transpose_item(args.in[13], 1024, kb * 64, nb * 32, scr, lane, nullptr, [&](int n) -> bf16_t* { return WmT + (size_t)n * 1024 + 512; }); continue; } r -= I_AU;
            if (r < I_OUT) { const int kb = r / 32, nb = r % 32;
                transpose_item(args.in[14], 1024, kb * 64, nb * 32, scr, lane, nullptr, [&](int n) -> bf16_t* { return WoT + (size_t)n * 1024; }); continue; } r -= I_OUT;
            if (r < I_G) { const int e = r / 256, q = r % 256, kb = q / 16, nb = q % 16;
                transpose_item_f8(args.in[20] + (size_t)e * 1024 * 512, 512, kb * 64, nb * 32, scr, lane, args.in[15], F8_WSCALE, [&](int n) -> unsigned char* { return Wgu8 + (size_t)e * 1024 * 1024 + (size_t)(256 * (n >> 7) + (n & 127)) * 1024; }); continue; } r -= I_G;
            if (r < I_U) { const int e = r / 256, q = r % 256, kb = q / 16, nb = q % 16;
                transpose_item_f8(args.in[21] + (size_t)e * 1024 * 512, 512, kb * 64, nb * 32, scr, lane, args.in[15], F8_WSCALE, [&](int n) -> unsigned char* { return Wgu8 + (size_t)e * 1024 * 1024 + (size_t)(256 * (n >> 7) + 128 + (n & 127)) * 1024; }); continue; } r -= I_U;
            { const int e = r / 256, q = r % 256, kb = q / 32, nb = q % 32;
                transpose_item_f8(args.in[22] + (size_t)e * 512 * 1024, 1024, kb * 64, nb * 32, scr, lane, nullptr, F8_WSCALE, [&](int n) -> unsigned char* { return Wd8 + ((size_t)e * 1024 + n) * 512; }); }
        }
        TP_END(30); TP_BEGIN(31);
        for (int it = gw; it < 2048; it += NGW) {
            const int kq = it >> 4, nb = it & 15, n = 64 * nb + lane, k = 4 * kq, g = k >> 7, kl = k & 127;
            const float* pw = args.in[3] + (size_t)(g * 128 + kl) * 128; const float* sc = args.in[4] + g * 128; const float* wu = args.in[5] + (size_t)(g * 128) * 1024 + n;
            float a0 = 0.f, a1 = 0.f, a2 = 0.f, a3 = 0.f;
            for (int c0 = 0; c0 < 128; c0 += 16) { float wv[16];
#pragma unroll
                for (int c = 0; c < 16; ++c) wv[c] = wu[(size_t)(c0 + c) * 1024];
#pragma unroll
                for (int c = 0; c < 16; ++c) { const float w2 = wv[c] * sc[c0 + c]; a0 += pw[c0 + c] * w2; a1 += pw[128 + c0 + c] * w2; a2 += pw[256 + c0 + c] * w2; a3 += pw[384 + c0 + c] * w2; } }
            u32x2 o; o.x = pk2(a0, a1); o.y = pk2(a2, a3);
            *(u32x2*)(WmT + (size_t)n * 1024 + k) = o;
        }
        TP_END(31); TP_BEGIN(32);
        for (int it = gw * 64 + lane; it < 48 * 1024; it += NGW * 64) {
            const int n = it >> 10, k = it & 1023; float w = 0.f;
            if (n < 4) w = args.in[16][k * 4 + n]; else if (n < 36) w = args.in[18][k * 32 + (n - 4)];
            w *= args.in[15][k];
            const unsigned hb = f2bf(w); const float lo = w - __builtin_bit_cast(float, hb << 16);
            WrH[it] = (bf16_t)hb; WrL[it] = (bf16_t)f2bf(lo);
        }
        TP_END(32); TP_BEGIN(33);
        { const float* x = args.in[0]; float* rstd1 = WSP(float, WS_RSTD1); const GAS f32x4* g4 = (const GAS f32x4*)args.in[1] + lane; f32x4 gg[4];
#pragma unroll
          for (int j = 0; j < 4; ++j) gg[j] = g4[64 * j];
          auto body = [&](int m) {
            const GAS f32x4* xr = (const GAS f32x4*)(x + (size_t)m * DM) + lane;
            f32x4 v[8]; float s0 = 0.f, s1 = 0.f;
#pragma unroll
            for (int j = 0; j < 8; ++j) v[j] = __builtin_nontemporal_load(xr + 64 * j);
#pragma unroll
            for (int j = 0; j < 4; ++j) { s0 += (v[j].x * v[j].x + v[j].y * v[j].y) + (v[j].z * v[j].z + v[j].w * v[j].w); s1 += (v[4 + j].x * v[4 + j].x + v[4 + j].y * v[4 + j].y) + (v[4 + j].z * v[4 + j].z + v[4 + j].w * v[4 + j].w); }
            const float r0 = __builtin_amdgcn_rsqf(wave_sum(s0) * (1.f / DM) + EPS), r1 = __builtin_amdgcn_rsqf(wave_sum(s1) * (1.f / DM) + EPS);
            if (lane == 0) { rstd1[m] = r0; rstd1[m + 1] = r1; }
            GAS unsigned long long* o8 = (GAS unsigned long long*)(Hb + (size_t)m * DM) + lane;
#pragma unroll
            for (int j = 0; j < 8; ++j) { const f32x4 y = v[j] * (j < 4 ? r0 : r1) * gg[j & 3]; o8[64 * j] = (unsigned long long)pk2(y.x, y.y) | ((unsigned long long)pk2(y.z, y.w) << 32); }
          };
          constexpr int STAT_ROWS = (NTOK / 4) * 3, CH_ROWS = 8, NCH = (NTOK - STAT_ROWS) / CH_ROWS;
          for (int m = gw * 2; m < STAT_ROWS; m += NGW * 2) body(m);
          const int grp = vcu >> 5, ngrp = (G + 31) >> 5, chlo = (NCH * grp) / ngrp, chhi = (NCH * (grp + 1)) / ngrp;
          unsigned* hq = (unsigned*)(ctl + CW_CUR) + grp * 16;
          auto draw = [&]() -> int { unsigned t = 0u; if (lane == 0) t = atomicAdd(hq, 1u); return chlo + __builtin_amdgcn_readfirstlane((int)t); };
          int ticket = draw();
          while (ticket < chhi) { const int tnext = draw();
            for (int sub = 0; sub < CH_ROWS; sub += 2) body(STAT_ROWS + ticket * CH_ROWS + sub);
            ticket = tnext; }
          }
        TP_END(33);
    }
    xcd_barrier(bar);
    TP_END(10);

    TP_BEGIN(11);
    if (PHASE_MASK & 2) REPS(2) {
        PH_BEGIN();
        gm::StaticOrder S; S.init(WSP(bf16_t, WS_H), WSP(bf16_t, WS_WIN), 1024, 1024, NTOK, 4096, G, bx);
        gm::EpiProj E{WSP(bf16_t, WS_U), WSP(bf16_t, WS_Q), WSP(bf16_t, WS_K), WSP(bf16_t, WS_V), WSP(bf16_t, WS_GP), WSP(bf16_t, WS_GA), args.in[6], args.in[7]};
        gm::gemm_phase<1, gm::EpiProj, gm::StaticOrder, gm::NT, false, false>(L, S, E, 1024, 1024 TP_ARGS);
    }
    xcd_barrier(bar);
    TP_END(11);

    TP_BEGIN(12);
    if (PHASE_MASK & 4) REPS(4) {
        PH_BEGIN();
        bf16_t* Ub = WSP(bf16_t, WS_U); bf16_t* DOb = WSP(bf16_t, WS_DO);
        float lam, B2;
        { const float a1 = args.in[8][lane] * args.in[9][lane], a2 = args.in[10][lane] * args.in[11][lane];
          lam = __expf(wave_sum(a1)) - __expf(wave_sum(a2)) + 0.2f;
          const float mq = wave_max(fabsf(args.in[6][lane])), mk = wave_max(fabsf(args.in[7][lane]));
          B2 = 8.0f * mq * mk * LOG2E * 1.02f + 0.5f; }
        TP_BEGIN(20);
        { const int bq = vcu >> 3; unsigned* qh = (unsigned*)(ctl + CW_ATTQ) + bq * 16;
          att::attn_batch(bq, qh, (LAS int*)(L + LDSCTL_OFF + 512), WSP(bf16_t, WS_Q), WSP(bf16_t, WS_K), WSP(bf16_t, WS_V), DOb, (char*)lds, B2, lam, args.in[12] TP_ARGS); }
        TP_END(20);
        { const int q = lane >> 4, l16 = lane & 15;
          for (int it = gw; it < NTOK / 8; it += NGW) {
            const int gidx = (it + it / NGW) & 3, blk = (it >> 2) * 4 + q;
            const int tok0 = blk * 8, t0 = tok0 & (SEQ - 1);
            const bf16_t* Ul = Ub + gidx * 128 + l16 * 8;
            bf16_t* Dl = DOb + gidx * 128 + l16 * 8;
            auto run = [&](auto wc) { constexpr int W = decltype(wc)::value;
                u32x4 v[W + 7];
#pragma unroll
                for (int i = 0; i < W + 7; ++i) { const int ok = (t0 - (W - 1) + i >= 0); v[i] = *(const u32x4*)(Ul + (size_t)(ok ? tok0 - (W - 1) + i : tok0) * 512); if (!ok) v[i] = (u32x4){0u, 0u, 0u, 0u}; }
                float S[8];
#pragma unroll
                for (int c = 0; c < 8; ++c) S[c] = 0.f;
#pragma unroll
                for (int i = 0; i < W - 1; ++i) { const u32x4 h = v[i];
                    S[0] += bflo(h.x); S[1] += bfhi(h.x); S[2] += bflo(h.y); S[3] += bfhi(h.y); S[4] += bflo(h.z); S[5] += bfhi(h.z); S[6] += bflo(h.w); S[7] += bfhi(h.w); }
#pragma unroll
                for (int tt = 0; tt < 8; ++tt) { const u32x4 cv = v[W - 1 + tt], ov = v[tt]; const int t = t0 + tt;
                    const float c0 = bflo(cv.x), c1 = bfhi(cv.x), c2 = bflo(cv.y), c3 = bfhi(cv.y), c4 = bflo(cv.z), c5 = bfhi(cv.z), c6 = bflo(cv.w), c7 = bfhi(cv.w);
                    S[0] += c0; S[1] += c1; S[2] += c2; S[3] += c3; S[4] += c4; S[5] += c5; S[6] += c6; S[7] += c7;
                    const float inv = 1.0f / (float)((t + 1 < W) ? t + 1 : W);
                    u32x4 o; o.x = pk2(S[0] * inv - c0, S[1] * inv - c1); o.y = pk2(S[2] * inv - c2, S[3] * inv - c3); o.z = pk2(S[4] * inv - c4, S[5] * inv - c5); o.w = pk2(S[6] * inv - c6, S[7] * inv - c7);
                    *(u32x4*)(Dl + (size_t)(tok0 + tt) * 1024) = o;
                    S[0] -= bflo(ov.x); S[1] -= bfhi(ov.x); S[2] -= bflo(ov.y); S[3] -= bfhi(ov.y); S[4] -= bflo(ov.z); S[5] -= bfhi(ov.z); S[6] -= bflo(ov.w); S[7] -= bfhi(ov.w); } };
            if (gidx == 0) run(std::integral_constant<int, 2>{}); else if (gidx == 1) run(std::integral_constant<int, 4>{});
            else if (gidx == 2) run(std::integral_constant<int, 8>{}); else run(std::integral_constant<int, 16>{});
          } }
    }
    xcd_barrier(bar);
    TP_END(12);

    TP_BEGIN(13);
    if (PHASE_MASK & 8) REPS(8) {
        PH_BEGIN();
        gm::StaticOrder S; S.init(WSP(bf16_t, WS_DO), WSP(bf16_t, WS_WM), 1024, 1024, NTOK, 1024, G, bx);
        gm::EpiMerge E{WSP(bf16_t, WS_GP), WSP(bf16_t, WS_GA), WSP(bf16_t, WS_MERGED)};
        dephase(vcu, DEPHASE3);
        gm::gemm_phase<3, gm::EpiMerge, gm::StaticOrder, gm::NT, false, true>(L, S, E, 1024, 1024 TP_ARGS);
    }
    xcd_barrier(bar);
    TP_END(13);

    TP_BEGIN(14);
    if (PHASE_MASK & 16) REPS(16) {
        PH_BEGIN();
        gm::StaticOrder S; S.init(WSP(bf16_t, WS_MERGED), WSP(bf16_t, WS_WO), 1024, 1024, NTOK, 1024, G, bx);
        gm::EpiRes E{WSP(bf16_t, WS_H), WSP(float, WS_RSTD1), args.in[1], WSP(bf16_t, WS_X1)};
        dephase(vcu, DEPHASE4);
        gm::gemm_phase<4, gm::EpiRes, gm::StaticOrder, gm::NT, false, false>(L, S, E, 1024, 1024 TP_ARGS);
    }
    xcd_barrier(bar);
    TP_END(14);

    TP_BEGIN(15);
    if (PHASE_MASK & 32) {
        PH_BEGIN();
        int* s2tok = WSP(int, WS_S2TOK); float* s2rstd = WSP(float, WS_S2RSTD); float* s2wlo = WSP(float, WS_S2WLO); float* s2whi = WSP(float, WS_S2WHI);
        const bf16_t* X1 = WSP(bf16_t, WS_X1); const bf16_t* WrH = WSP(bf16_t, WS_WRH); const bf16_t* WrL = WSP(bf16_t, WS_WRL); unsigned char* X1F = WSP(unsigned char, WS_X1F8);
        constexpr int TROW = 1040, LG_OFF = 96 * TROW;
        const int row = lane & 15, kg = lane >> 4;
        const int tok0 = gw * 32;
        f32x4 acc[2][3];
#pragma unroll
        for (int rg = 0; rg < 2; ++rg)
#pragma unroll
            for (int nf = 0; nf < 3; ++nf) acc[rg][nf] = (f32x4){0.f, 0.f, 0.f, 0.f};
        float ss[2] = {0.f, 0.f};
        for (int blk0 = 0; blk0 < NTOK; blk0 += NGW * 32) {
          const int tb = blk0 + tok0; const bool live = tb < NTOK;
          for (int half = 0; half < 2; ++half) {
            __syncthreads();
            for (int i = tid; i < 96 * 64; i += NWAVES * 64) { const int r = i >> 6, c = i & 63;
                const bf16_t* src = (r < 48 ? WrH + (size_t)r * 1024 : WrL + (size_t)(r - 48) * 1024) + half * 512 + c * 8;
                *(LAS u32x4*)(L + r * TROW + c * 16) = *(const u32x4*)src; }
            __syncthreads();
            if (live) {
                const bf16_t* xa = X1 + (size_t)(tb + row) * 1024 + half * 512 + kg * 16;
#pragma unroll 4
                for (int sp = 0; sp < 8; ++sp) {
                    u32x4 A[2][2];
#pragma unroll
                    for (int rg = 0; rg < 2; ++rg) { A[rg][0] = __builtin_nontemporal_load((const u32x4*)(xa + (size_t)rg * 16 * 1024 + sp * 64)); A[rg][1] = __builtin_nontemporal_load((const u32x4*)(xa + (size_t)rg * 16 * 1024 + sp * 64 + 8)); }
#pragma unroll
                    for (int rg = 0; rg < 2; ++rg) {
                        const u32x4 a0 = A[rg][0], a1 = A[rg][1]; u32x4 w;
                        w.x = pk4_f8(bflo(a0.x), bfhi(a0.x), bflo(a0.y), bfhi(a0.y)); w.y = pk4_f8(bflo(a0.z), bfhi(a0.z), bflo(a0.w), bfhi(a0.w));
                        w.z = pk4_f8(bflo(a1.x), bfhi(a1.x), bflo(a1.y), bfhi(a1.y)); w.w = pk4_f8(bflo(a1.z), bfhi(a1.z), bflo(a1.w), bfhi(a1.w));
                        *(u32x4*)(X1F + (size_t)(tb + rg * 16 + row) * 1024 + half * 512 + sp * 64 + kg * 16) = w; }
#pragma unroll
                    for (int rg = 0; rg < 2; ++rg)
#pragma unroll
                        for (int hh = 0; hh < 2; ++hh) { const u32x4 v = A[rg][hh];
                            const float f0 = bflo(v.x), f1 = bfhi(v.x), f2 = bflo(v.y), f3 = bfhi(v.y), f4 = bflo(v.z), f5 = bfhi(v.z), f6 = bflo(v.w), f7 = bfhi(v.w);
                            ss[rg] += (f0 * f0 + f1 * f1) + (f2 * f2 + f3 * f3) + (f4 * f4 + f5 * f5) + (f6 * f6 + f7 * f7); }
#pragma unroll
                    for (int hh = 0; hh < 2; ++hh)
#pragma unroll
                        for (int nf = 0; nf < 3; ++nf) {
                            const bf16x8 Bh = *(const LAS bf16x8*)(L + (nf * 16 + row) * TROW + (sp * 64 + kg * 16 + hh * 8) * 2);
                            const bf16x8 Bl = *(const LAS bf16x8*)(L + (48 + nf * 16 + row) * TROW + (sp * 64 + kg * 16 + hh * 8) * 2);
#pragma unroll
                            for (int rg = 0; rg < 2; ++rg) { const bf16x8 Af = __builtin_bit_cast(bf16x8, A[rg][hh]);
                                acc[rg][nf] = __builtin_amdgcn_mfma_f32_16x16x32_bf16(Af, Bh, acc[rg][nf], 0, 0, 0);
                                acc[rg][nf] = __builtin_amdgcn_mfma_f32_16x16x32_bf16(Af, Bl, acc[rg][nf], 0, 0, 0); }
                        }
                }
            }
          }
          if (live) {
            LAS float* lg = (LAS float*)(L + LG_OFF + wave * 3072);
#pragma unroll
            for (int rg = 0; rg < 2; ++rg) {
                float s2 = ss[rg]; s2 += __shfl_xor(s2, 16); s2 += __shfl_xor(s2, 32);
                const float rstd = __builtin_amdgcn_rsqf(s2 * (1.0f / 1024.0f) + EPS);
#pragma unroll
                for (int nf = 0; nf < 3; ++nf)
#pragma unroll
                    for (int r = 0; r < 4; ++r) lg[(4 * kg + r) * 48 + 16 * nf + row] = acc[rg][nf][r];
                LDS_WAIT(); asm volatile("" ::: "memory");
                if (lane < 16) {
                    const int tok = tb + rg * 16 + lane;
                    const LAS float* my = lg + lane * 48;
                    float gl[4]; int g = 0;
#pragma unroll
                    for (int j = 0; j < 4; ++j) gl[j] = rstd * my[j] + args.in[17][j];
                    float gmx = gl[0];
#pragma unroll
                    for (int j = 1; j < 4; ++j) if (gl[j] > gmx) { gmx = gl[j]; g = j; }
                    float den = 0.f;
#pragma unroll
                    for (int j = 0; j < 4; ++j) den += __expf(gl[j] - gmx);
                    const float ptop = 1.0f / den;
                    float le[8];
#pragma unroll
                    for (int e = 0; e < 8; ++e) le[e] = rstd * my[4 + g * 8 + e] + args.in[19][g * 8 + e];
                    int e1 = 0; float v1 = le[0];
#pragma unroll
                    for (int e = 1; e < 8; ++e) if (le[e] > v1) { v1 = le[e]; e1 = e; }
                    int e2 = -1; float v2 = -3.0e38f;
#pragma unroll
                    for (int e = 0; e < 8; ++e) if (e != e1 && le[e] > v2) { v2 = le[e]; e2 = e; }
                    const float rr = __expf(v2 - v1), w1 = ptop / (1.0f + rr), w2 = ptop * rr / (1.0f + rr);
                    const int lo = e1 < e2 ? e1 : e2, hi2 = e1 < e2 ? e2 : e1;
                    const float wlo = e1 < e2 ? w1 : w2, whi = e1 < e2 ? w2 : w1;
                    const int cls = g * 28 + lo * 8 - (lo * (lo + 1)) / 2 + (hi2 - lo - 1);
                    const unsigned pos = atomicAdd((unsigned*)(ctl + CW_CNT) + cls * 16, 1u);
                    const int sidx = cls * SCAP + (int)pos; s2tok[sidx] = tok; s2rstd[sidx] = rstd; s2wlo[sidx] = wlo; s2whi[sidx] = whi;
                }
                LDS_WAIT(); asm volatile("" ::: "memory");
                ss[rg] = 0.f;
#pragma unroll
                for (int nf = 0; nf < 3; ++nf) acc[rg][nf] = (f32x4){0.f, 0.f, 0.f, 0.f};
            }
          }
        }
    }
    xcd_barrier(bar);
    TP_END(15);

    TP_BEGIN(17);
    if (PHASE_MASK & 128) REPS(128) {
        PH_BEGIN();
        LAS int* utab = (LAS int*)(L + UTAB_OFF); constexpr int PNSH = 3;
        LAS int* cntl = (LAS int*)(L); LAS int* tot = (LAS int*)(L + 1024); LAS int* tmap = (LAS int*)(L + 4096);
        if (wave == 0) {
            int nfv[2], hfv[2], nv[2];
#pragma unroll
            for (int q = 0; q < 2; ++q) { const int c = lane + 64 * q; const int n = (c < NCLS) ? (int)__hip_atomic_load((unsigned*)(ctl + CW_CNT) + c * 16, RLX_AGENT) : 0;
                const int nt = (n + 255) >> 8, lr = n - 256 * (nt - 1); hfv[q] = (nt > 0 && lr <= 128) ? 1 : 0; nfv[q] = nt - hfv[q]; nv[q] = n; cntl[c] = n; }
            int fi[2], hi_[2], fbase = 0, hbase = 0;
#pragma unroll
            for (int q = 0; q < 2; ++q) { int f = nfv[q], h = hfv[q];
#pragma unroll
                for (int dd = 1; dd < 64; dd <<= 1) { const int tf = __shfl_up(f, dd), th = __shfl_up(h, dd); if (lane >= dd) { f += tf; h += th; } }
                fi[q] = f + fbase; hi_[q] = h + hbase; fbase = __shfl(fi[q], 63); hbase = __shfl(hi_[q], 63); }
            const int F = fbase, H = hbase;
#pragma unroll
            for (int q = 0; q < 2; ++q) { const int c = lane + 64 * q; if (c < NCLS) { const int f0 = fi[q] - nfv[q];
                for (int t = 0; t < nfv[q]; ++t) tmap[f0 + t] = c | (t << 8);
                if (hfv[q]) tmap[F + hi_[q] - 1] = c | (nfv[q] << 8); } }
            if (lane == 0) { tot[0] = F; tot[1] = F + H; }
            (void)nv;
        }
        __syncthreads();
        if (tid < 16) { const int Lx = tid * G + vcu; const int tile = Lx >> PNSH, pn = Lx & ((1 << PNSH) - 1); int e0 = 0, e1 = 0, tl = -1, half = 0, base = 0, rows = 0;
            if (tile < tot[1]) { const int tm = tmap[tile]; const int cls = tm & 255, j = tm >> 8; rows = cntl[cls] - 256 * j; if (rows > 256) rows = 256; half = (tile >= tot[0]) ? 1 : 0;
                const int g = cls / 28; int rem = cls % 28, lo = 0; while (rem >= 7 - lo) { rem -= 7 - lo; ++lo; } e0 = g * 8 + lo; e1 = g * 8 + lo + 1 + rem; tl = tile; base = cls * SCAP + 256 * j; }
            utab[tid * 8 + 0] = tl; utab[tid * 8 + 1] = pn; utab[tid * 8 + 2] = e0; utab[tid * 8 + 3] = e1; utab[tid * 8 + 4] = half; utab[tid * 8 + 5] = base; utab[tid * 8 + 6] = rows; }
        __syncthreads();
        gm::MoeSched S{utab, (const char*)WSP(unsigned char, WS_X1F8), (const char*)WSP(unsigned char, WS_WGU), WSP(int, WS_S2TOK), 1};
        gm::EpiMoe1 E{WSP(float, WS_S2RSTD), WSP(float, WS_S2WLO), WSP(float, WS_S2WHI), WSP(unsigned char, WS_HDN)};
        gm::gemm_phase<7, gm::EpiMoe1, gm::MoeSched, 8, true, false, true, 8, true>(L, S, E, 512, 512 TP_ARGS);
    }
    xcd_barrier(bar);
    TP_END(17);
    TP_BEGIN(18);
    if (PHASE_MASK & 256) {
        PH_BEGIN();
        LAS int* utab = (LAS int*)(L + UTAB_OFF); constexpr int PNSH = 2;
        LAS int* cntl = (LAS int*)(L); LAS int* tot = (LAS int*)(L + 1024); LAS int* tmap = (LAS int*)(L + 4096);
        if (wave == 0) {
            int nfv[2], hfv[2], nv[2];
#pragma unroll
            for (int q = 0; q < 2; ++q) { const int c = lane + 64 * q; const int n = (c < NCLS) ? (int)__hip_atomic_load((unsigned*)(ctl + CW_CNT) + c * 16, RLX_AGENT) : 0;
                const int nt = (n + 255) >> 8, lr = n - 256 * (nt - 1); hfv[q] = (nt > 0 && lr <= 128) ? 1 : 0; nfv[q] = nt - hfv[q]; nv[q] = n; cntl[c] = n; }
            int fi[2], hi_[2], fbase = 0, hbase = 0;
#pragma unroll
            for (int q = 0; q < 2; ++q) { int f = nfv[q], h = hfv[q];
#pragma unroll
                for (int dd = 1; dd < 64; dd <<= 1) { const int tf = __shfl_up(f, dd), th = __shfl_up(h, dd); if (lane >= dd) { f += tf; h += th; } }
                fi[q] = f + fbase; hi_[q] = h + hbase; fbase = __shfl(fi[q], 63); hbase = __shfl(hi_[q], 63); }
            const int F = fbase, H = hbase;
#pragma unroll
            for (int q = 0; q < 2; ++q) { const int c = lane + 64 * q; if (c < NCLS) { const int f0 = fi[q] - nfv[q];
                for (int t = 0; t < nfv[q]; ++t) tmap[f0 + t] = c | (t << 8);
                if (hfv[q]) tmap[F + hi_[q] - 1] = c | (nfv[q] << 8); } }
            if (lane == 0) { tot[0] = F; tot[1] = F + H; }
            (void)nv;
        }
        __syncthreads();
        if (tid < 16) { const int Lx = tid * G + vcu; const int tile = Lx >> PNSH, pn = Lx & ((1 << PNSH) - 1); int e0 = 0, e1 = 0, tl = -1, half = 0, base = 0, rows = 0;
            if (tile < tot[1]) { const int tm = tmap[tile]; const int cls = tm & 255, j = tm >> 8; rows = cntl[cls] - 256 * j; if (rows > 256) rows = 256; half = (tile >= tot[0]) ? 1 : 0;
                const int g = cls / 28; int rem = cls % 28, lo = 0; while (rem >= 7 - lo) { rem -= 7 - lo; ++lo; } e0 = g * 8 + lo; e1 = g * 8 + lo + 1 + rem; tl = tile; base = cls * SCAP + 256 * j; }
            utab[tid * 8 + 0] = tl; utab[tid * 8 + 1] = pn; utab[tid * 8 + 2] = e0; utab[tid * 8 + 3] = e1; utab[tid * 8 + 4] = half; utab[tid * 8 + 5] = base; utab[tid * 8 + 6] = rows; }
        __syncthreads();
        gm::MoeSched S{utab, (const char*)WSP(unsigned char, WS_HDN), (const char*)WSP(unsigned char, WS_WD), WSP(int, WS_S2TOK), 2};
        gm::EpiMoe2 E{WSP(int, WS_S2TOK), WSP(bf16_t, WS_X1), args.out, (LAS int*)(L + TKL_OFF)};
        dephase(vcu, DEPHASE8);
        gm::gemm_phase<8, gm::EpiMoe2, gm::MoeSched, 4, false, false, true, 8, true>(L, S, E, 512, 256 TP_ARGS);
    }
    TP_END(18);
    TP_FINISH();
}

extern "C" void kernel_launch(void* const* d_in, const int* in_sizes, int n_in, void* d_out, int out_size, void* d_ws, size_t ws_size, hipStream_t stream) {
    static int grid = 0;
    if (grid == 0) {
        if (n_in != 23 || out_size != NTOK * DM || ws_size < WS_END) { fprintf(stderr, "kernel_launch: unexpected shapes (n_in %d, out %d, ws %zu)\n", n_in, out_size, ws_size); grid = -1; return; }
        int dev = 0, cus = 0;
        if (hipGetDevice(&dev) != hipSuccess || hipDeviceGetAttribute(&cus, hipDeviceAttributeMultiprocessorCount, dev) != hipSuccess) { grid = -1; return; }
        if (hipFuncSetAttribute((const void*)hybrid_fwd, hipFuncAttributeMaxDynamicSharedMemorySize, LDS_BYTES) != hipSuccess) { fprintf(stderr, "kernel_launch: hipFuncSetAttribute failed\n"); grid = -1; return; }
        int per_cu = 0;
        if (hipOccupancyMaxActiveBlocksPerMultiprocessor(&per_cu, (const void*)hybrid_fwd, NWAVES * 64, LDS_BYTES) != hipSuccess || per_cu < 1) fprintf(stderr, "kernel_launch: occupancy query says %d\n", per_cu);
        (void)hipGetLastError();
        grid = cus;
        if (grid != 256) fprintf(stderr, "kernel_launch: %d CUs (built for 256)\n", grid);
    }
    if (grid < 0) return;
    if (hipMemsetAsync((char*)d_ws + WS_CTL, 0, CTL_ZERO_BYTES, stream) != hipSuccess) return;
    Args a{};
    for (int i = 0; i < 23; ++i) a.in[i] = (const float*)d_in[i];
    a.out = (float*)d_out; a.ws = (unsigned char*)d_ws;
    hipLaunchKernelGGL(hybrid_fwd, dim3(grid), dim3(NWAVES * 64), LDS_BYTES, stream, a);
}
```
